# Optimizing an MI355X kernel written in HIP

```python
import jax, jax.numpy as jnp
from jax import lax
import numpy as np

D_MODEL = 1024
BATCH = 8
SEQ = 4096
DEPTH = 2
DEC_BATCH = 16
DEC_SEQ = 16
PAST_LEN = 2048

CHUNK = 64
MIX_WIDTH = D_MODEL
RET_WIDTH = MIX_WIDTH // 2
CONV_WIDTH = MIX_WIDTH - RET_WIDTH
N_RET_HEADS = 4
RET_HEAD_DIM = RET_WIDTH // N_RET_HEADS
CONV_K = 3
D_FF = 4 * D_MODEL
ROPE_BASE = 10000.0
RMS_EPS = 1e-6
GN_EPS = 1e-5
IN_COLS = 4 * RET_WIDTH + 3 * CONV_WIDTH
SPLITS = [RET_WIDTH, 2 * RET_WIDTH, 3 * RET_WIDTH, 4 * RET_WIDTH,
          4 * RET_WIDTH + CONV_WIDTH, 4 * RET_WIDTH + 2 * CONV_WIDTH]

kernel_name = "hymba_retention_shortconv_stream_step"


def rms_norm(x, w):
    xf = x.astype(jnp.float32)
    y = xf * lax.rsqrt(jnp.mean(xf * xf, axis=-1, keepdims=True) + RMS_EPS)
    return (y * w.astype(jnp.float32)).astype(x.dtype)


def retention_log_decay():
    return jnp.log(1.0 - jnp.exp2(-5.0 - jnp.arange(N_RET_HEADS, dtype=jnp.float32)))


def rope(x, pos):
    half = RET_HEAD_DIM // 2
    inv = ROPE_BASE ** (-jnp.arange(half, dtype=jnp.float32) / half)
    ang = pos.astype(jnp.float32)[:, None] * inv[None, :]
    cos = jnp.cos(ang)[None, :, None, :]
    sin = jnp.sin(ang)[None, :, None, :]
    x1, x2 = x[..., :half], x[..., half:]
    return jnp.concatenate([x1 * cos - x2 * sin, x1 * sin + x2 * cos], axis=-1)


def retention_chunkwise(q, k, v, r0, chunk):
    b, l, h, d = q.shape
    nc = l // chunk

    def to_chunks(t):
        return t.reshape(b, nc, chunk, h, d).transpose(1, 0, 3, 2, 4)

    lg = retention_log_decay()
    idx = jnp.arange(chunk, dtype=jnp.float32)
    diff = idx[:, None] - idx[None, :]
    causal = diff >= 0
    dmat = jnp.where(causal[None], jnp.exp(jnp.where(causal, diff, 0.0)[None] * lg[:, None, None]), 0.0)
    q_dec = jnp.exp((idx[None, :] + 1.0) * lg[:, None])
    k_dec = jnp.exp((chunk - 1.0 - idx[None, :]) * lg[:, None])
    chunk_dec = jnp.exp(chunk * lg)

    def step(r, qkv):
        qc, kc, vc = qkv
        s = jnp.einsum('bhnd,bhmd->bhnm', qc, kc) * dmat[None]
        o = (jnp.einsum('bhnm,bhmv->bhnv', s, vc)
             + jnp.einsum('bhnd,bhdv->bhnv', qc * q_dec[None, :, :, None], r))
        r = (r * chunk_dec[None, :, None, None]
             + jnp.einsum('bhmd,bhmv->bhdv', kc * k_dec[None, :, :, None], vc))
        return r, o

    r_final, o = lax.scan(step, r0, (to_chunks(q), to_chunks(k), to_chunks(v)))
    o = o.transpose(1, 0, 3, 2, 4).reshape(b, l, h, d)
    return o, r_final


def hybrid_layer(x, pos, r0, conv_buf, chunk, ln1_w, w_in, conv_w, ret_norm_w, w_out,
                 ln2_w, w_up, w_down):
    b, l, _ = x.shape
    n = rms_norm(x, ln1_w)
    proj = n @ w_in
    q, k, v, g, gate_b, gate_c, hc = jnp.split(proj, SPLITS, axis=-1)

    shp = (b, l, N_RET_HEADS, RET_HEAD_DIM)
    qf = rope(q.reshape(shp).astype(jnp.float32), pos)
    kf = rope(k.reshape(shp).astype(jnp.float32), pos) * (RET_HEAD_DIM ** -0.5)
    vf = v.reshape(shp).astype(jnp.float32)
    o, r_new = retention_chunkwise(qf, kf, vf, r0.astype(jnp.float32), chunk)
    mu = jnp.mean(o, axis=-1, keepdims=True)
    oc = o - mu
    o = oc * lax.rsqrt(jnp.mean(oc * oc, axis=-1, keepdims=True) + GN_EPS)
    o = o.reshape(b, l, RET_WIDTH) * ret_norm_w.astype(jnp.float32)
    ret_out = (jax.nn.silu(g.astype(jnp.float32)) * o).astype(x.dtype)

    u = gate_c * hc
    padded = jnp.concatenate([conv_buf.astype(u.dtype), u], axis=1)
    z = padded[:, 0:l] * conv_w[:, 0]
    for j in range(1, CONV_K):
        z = z + padded[:, j:j + l] * conv_w[:, j]
    conv_out = gate_b * z
    new_buf = padded[:, l:]

    x = x + jnp.concatenate([ret_out, conv_out], axis=-1) @ w_out

    h2 = rms_norm(x, ln2_w)
    x = x + jnp.square(jax.nn.relu(h2 @ w_up)) @ w_down
    return x, r_new, new_buf


def setup_inputs(seed: int = 0) -> dict:
    key = jax.random.key(seed)
    ks = jax.random.split(key, 13)
    f32 = jnp.float32
    nrm = jax.random.normal
    return {
        "x_prompt": nrm(ks[0], (BATCH, SEQ, D_MODEL), f32),
        "x_sample": nrm(ks[1], (DEC_BATCH, DEC_SEQ, D_MODEL), f32),
        "state_ret": 0.1 * nrm(ks[2], (DEPTH, DEC_BATCH, N_RET_HEADS, RET_HEAD_DIM, RET_HEAD_DIM), f32),
        "state_conv": nrm(ks[3], (DEPTH, DEC_BATCH, CONV_K - 1, CONV_WIDTH), f32),
        "ln1_w": 1.0 + 0.02 * nrm(ks[4], (DEPTH, D_MODEL), f32),
        "w_in": nrm(ks[5], (DEPTH, D_MODEL, IN_COLS), f32) * D_MODEL ** -0.5,
        "conv_w": nrm(ks[6], (DEPTH, CONV_WIDTH, CONV_K), f32) * CONV_K ** -0.5,
        "ret_norm_w": 1.0 + 0.02 * nrm(ks[7], (DEPTH, RET_WIDTH), f32),
        "w_out": nrm(ks[8], (DEPTH, MIX_WIDTH, D_MODEL), f32) * MIX_WIDTH ** -0.5,
        "ln2_w": 1.0 + 0.02 * nrm(ks[9], (DEPTH, D_MODEL), f32),
        "w_mlp_up": nrm(ks[10], (DEPTH, D_MODEL, D_FF), f32) * D_MODEL ** -0.5,
        "w_mlp_down": nrm(ks[11], (DEPTH, D_FF, D_MODEL), f32) * D_FF ** -0.5,
        "ln_f_w": 1.0 + 0.02 * nrm(ks[12], (D_MODEL,), f32),
    }


def reference(x_prompt, x_sample, state_ret, state_conv, ln1_w, w_in, conv_w, ret_norm_w,
              w_out, ln2_w, w_mlp_up, w_mlp_down, ln_f_w):
    b_p, l_p, _ = x_prompt.shape
    b_s, l_s, _ = x_sample.shape
    pos_p = jnp.arange(l_p)
    pos_s = PAST_LEN + jnp.arange(l_s)
    chunk_p = min(CHUNK, l_p)
    chunk_s = l_s

    xp, xs = x_prompt, x_sample
    ret_p, conv_p, ret_s, conv_s = [], [], [], []
    for i in range(DEPTH):
        r0_p = jnp.zeros((b_p, N_RET_HEADS, RET_HEAD_DIM, RET_HEAD_DIM), jnp.float32)
        buf0_p = jnp.zeros((b_p, CONV_K - 1, CONV_WIDTH), x_prompt.dtype)
        xp, rp, bp = hybrid_layer(xp, pos_p, r0_p, buf0_p, chunk_p, ln1_w[i], w_in[i], conv_w[i],
                                  ret_norm_w[i], w_out[i], ln2_w[i], w_mlp_up[i], w_mlp_down[i])
        xs, rs, bs = hybrid_layer(xs, pos_s, state_ret[i], state_conv[i], chunk_s, ln1_w[i], w_in[i],
                                  conv_w[i], ret_norm_w[i], w_out[i], ln2_w[i], w_mlp_up[i],
                                  w_mlp_down[i])
        ret_p.append(rp)
        conv_p.append(bp)
        ret_s.append(rs)
        conv_s.append(bs)

    y_prompt = rms_norm(xp, ln_f_w)
    y_sample = rms_norm(xs, ln_f_w)
    new_ret_prompt = jnp.stack(ret_p).astype(state_ret.dtype)
    new_conv_prompt = jnp.stack(conv_p).astype(state_conv.dtype)
    new_ret_sample = jnp.stack(ret_s).astype(state_ret.dtype)
    new_conv_sample = jnp.stack(conv_s).astype(state_conv.dtype)
    return (y_prompt, y_sample, new_ret_prompt, new_conv_prompt, new_ret_sample, new_conv_sample)
```

```cpp
#include <hip/hip_runtime.h>
#include <hip/hip_cooperative_groups.h>
#include <cstdio>
#include <cstdint>
namespace cg = cooperative_groups;
namespace pg8 {
#define PG8_LAS __attribute__((address_space(3)))
typedef unsigned short bf16_t;
typedef short bf16x8 __attribute__((ext_vector_type(8)));
typedef float f32x4 __attribute__((ext_vector_type(4)));
typedef unsigned u32x4 __attribute__((ext_vector_type(4)));
constexpr int BM = 256, BK = 64, HALF = 128, HTB = HALF * BK * 2  , STAGE_BYTES = 8 * HTB, NXCD = 8, WGM = 8;

__host__ __device__ __forceinline__ int lds_byte(int r, int c) { const int st = (r >> 4) * 2 + (c >> 5), rr = r & 15, cc = c & 31, ob = rr * 64 + cc * 2; return st * 1024 + (ob ^ (((ob >> 9) & 1) << 5)); }
__host__ __device__ __forceinline__ void stage_rc(int b, int& R, int& C) { const int st = b / 1024, sb = b % 1024, swz = sb ^ (((sb >> 9) & 1) << 5); R = (st >> 1) * 16 + swz / 64; C = (st & 1) * 32 + (swz % 64) / 2; }
__host__ __device__ __forceinline__ int perm32(int rho) { const int n = rho >> 4, i = rho & 15; return 8 * (i >> 2) + 4 * n + (i & 3); }

struct Unit { int pm, pn; };
struct Gemm { const bf16_t* A; const bf16_t* Bt; int M, N, K; };

struct StaticOrder {
    int nM, nN, nwg, G, c;
    __host__ __device__ void init(int M, int N, int G_, int c_) { nM = M / BM; nN = N / BM; nwg = nM * nN; G = G_; c = c_; }
    __host__ __device__ bool next(int i, Unit& u) const {
        const long L = (long)i * G + c; if (L >= nwg) return false;
        int wgid = (int)L; { const int q = nwg / NXCD, r = nwg % NXCD, xcd = wgid % NXCD, off = wgid / NXCD; wgid = (xcd < r ? xcd * (q + 1) : r * (q + 1) + (xcd - r) * q) + off; }
        const int nig = WGM * nN, gid = wgid / nig, fm = gid * WGM, gsz = (nM - fm) < WGM ? (nM - fm) : WGM;
        u.pm = fm + ((wgid % nig) % gsz); u.pn = (wgid % nig) / gsz; return true;
    }
    __device__ __forceinline__ void a_ready(const Unit&) const {}
    __device__ __forceinline__ void done(const Unit&) const {}
};

__device__ __forceinline__ unsigned cvt_pk_bf16(float lo, float hi) { unsigned r; asm volatile("v_cvt_pk_bf16_f32 %0, %1, %2" : "=v"(r) : "v"(lo), "v"(hi)); return r; }
typedef float f32x2 __attribute__((ext_vector_type(2)));

constexpr int DM = 1024, NBATCH = 8, SEQ = 4096, DEPTH = 2, DBATCH = 16, DSEQ = 16, PAST = 2048;
constexpr int MP = NBATCH * SEQ, MS = DBATCH * DSEQ, MT = MP + MS;
constexpr int NIN = 3584, DFF = 4096, LDP = 3072;
constexpr float RMS_EPS = 1e-6f, GN_EPS = 1e-5f;

__device__ __forceinline__ void store8bf(bf16_t* p, const f32x4 a, const f32x4 b) {
    u32x4 w; w.x = cvt_pk_bf16(a[0], a[1]); w.y = cvt_pk_bf16(a[2], a[3]); w.z = cvt_pk_bf16(b[0], b[1]); w.w = cvt_pk_bf16(b[2], b[3]);
    *(u32x4*)p = w;
}
__device__ __forceinline__ float row_rstd(const float* ssp, int r) {
    const f32x4* sp = (const f32x4*)(ssp + (size_t)r * 16);
    const f32x4 s0 = sp[0], s1 = sp[1], s2 = sp[2], s3 = sp[3];
    const f32x4 s = (s0 + s1) + (s2 + s3);
    const float tot = (s[0] + s[1]) + (s[2] + s[3]);
    return __builtin_amdgcn_rsqf(tot * (1.0f / DM) + RMS_EPS);
}
__device__ __forceinline__ float silu_f(float x) { return x * __builtin_amdgcn_rcpf(1.0f + __builtin_amdgcn_exp2f(-1.4426950408889634f * x)); }

struct EpiIn {
    static constexpr bool PERM = true, AFTER_DRAIN = false;
    bf16_t* proj; const float* ssp; const float* rcos; const float* rsin; float* nconv_p; float* nconv_s;
    __device__ __forceinline__ void operator()(const f32x4 (&acc)[2][2][4][2], const Unit& u, int wr, int wc, int fr, int fq) const {
        const int pn = u.pn, tcol = wc * 32 + 8 * fq;
#pragma unroll
        for (int ai = 0; ai < 2; ++ai)
#pragma unroll
            for (int m = 0; m < 4; ++m) {
                const int r = u.pm * BM + ai * HALF + wr * 64 + m * 16 + fr;
                const float rs = row_rstd(ssp, r);
                const f32x4 a0 = acc[ai][0][m][0] * rs, a1 = acc[ai][0][m][1] * rs, b0 = acc[ai][1][m][0] * rs, b1 = acc[ai][1][m][1] * rs;
                bf16_t* prow = proj + (size_t)r * LDP;
                if (pn < 4) {
                    const int pos = r < MP ? (r & (SEQ - 1)) : PAST + (r & (DSEQ - 1));
                    const int i0 = 32 * (wc & 1) + 8 * fq;
                    const f32x4 c0 = *(const f32x4*)(rcos + pos * 64 + i0), c1 = *(const f32x4*)(rcos + pos * 64 + i0 + 4);
                    const f32x4 s0 = *(const f32x4*)(rsin + pos * 64 + i0), s1 = *(const f32x4*)(rsin + pos * 64 + i0 + 4);
                    const f32x4 o10 = a0 * c0 - b0 * s0, o11 = a1 * c1 - b1 * s1, o20 = a0 * s0 + b0 * c0, o21 = a1 * s1 + b1 * c1;
                    const int dcol = (pn < 2 ? 0 : 512) + 128 * (2 * (pn & 1) + (wc >> 1)) + i0;
                    store8bf(prow + dcol, o10, o11); store8bf(prow + dcol + 64, o20, o21);
                } else if (pn < 10) {
                    f32x4 x0 = a0, x1 = a1, y0 = b0, y1 = b1;
                    if (pn == 6 || pn == 7) {
#pragma unroll
                        for (int e = 0; e < 4; ++e) { x0[e] = silu_f(x0[e]); x1[e] = silu_f(x1[e]); y0[e] = silu_f(y0[e]); y1[e] = silu_f(y1[e]); }
                    }
                    const int dcol = 256 * pn + tcol;
                    store8bf(prow + dcol, x0, x1); store8bf(prow + dcol + 128, y0, y1);
                } else {
                    const f32x4 u0 = a0 * b0, u1 = a1 * b1;
                    const int cc = 128 * (pn - 10) + tcol;
                    store8bf(prow + 2560 + cc, u0, u1);
                    if (r < MP) { const int t = r & (SEQ - 1); if (t >= SEQ - 2) { float* d = nconv_p + (size_t)((r >> 12) * 2 + (t - (SEQ - 2))) * 512 + cc; *(f32x4*)d = u0; *(f32x4*)(d + 4) = u1; } }
                    else { const int t = r & (DSEQ - 1); if (t >= DSEQ - 2) { float* d = nconv_s + (size_t)(((r - MP) >> 4) * 2 + (t - (DSEQ - 2))) * 512 + cc; *(f32x4*)d = u0; *(f32x4*)(d + 4) = u1; } }
                }
            }
    }
};
struct EpiRes {
    static constexpr bool PERM = false, AFTER_DRAIN = false;
    const float* xs_main; const float* xs_tail; float* X; bf16_t* xb; float* ssp;
    __device__ __forceinline__ void operator()(const f32x4 (&acc)[2][2][4][2], const Unit& u, int wr, int wc, int fr, int fq) const {
        typedef unsigned u32x2v __attribute__((ext_vector_type(2)));
#pragma unroll
        for (int ai = 0; ai < 2; ++ai)
#pragma unroll
            for (int m = 0; m < 4; ++m) {
                const int r = u.pm * BM + ai * HALF + wr * 64 + m * 16 + fr;
                const float* xs = r < MP ? xs_main + (size_t)r * DM : xs_tail + (size_t)(r - MP) * DM;
                float ss = 0.f;
#pragma unroll
                for (int bj = 0; bj < 2; ++bj)
#pragma unroll
                    for (int n = 0; n < 2; ++n) {
                        const int c = u.pn * BM + bj * HALF + wc * 32 + n * 16 + 4 * fq;
                        const f32x4 v = *(const f32x4*)(xs + c) + acc[ai][bj][m][n];
                        *(f32x4*)(X + (size_t)r * DM + c) = v;
                        u32x2v w; w.x = cvt_pk_bf16(v[0], v[1]); w.y = cvt_pk_bf16(v[2], v[3]);
                        *(u32x2v*)(xb + (size_t)r * DM + c) = w;
                        ss += (v[0] * v[0] + v[1] * v[1]) + (v[2] * v[2] + v[3] * v[3]);
                    }
                ss += __shfl_xor(ss, 16); ss += __shfl_xor(ss, 32);
                if (fq == 0) ssp[(size_t)r * 16 + 4 * u.pn + wc] = ss;
            }
    }
};
struct EpiUp {
    static constexpr bool PERM = true, AFTER_DRAIN = false;
    bf16_t* H; const float* ssp;
    __device__ __forceinline__ void operator()(const f32x4 (&acc)[2][2][4][2], const Unit& u, int wr, int wc, int fr, int fq) const {
#pragma unroll
        for (int ai = 0; ai < 2; ++ai)
#pragma unroll
            for (int m = 0; m < 4; ++m) {
                const int r = u.pm * BM + ai * HALF + wr * 64 + m * 16 + fr;
                const float rs = row_rstd(ssp, r);
                bf16_t* hrow = H + (size_t)r * DFF + u.pn * BM + wc * 32 + 8 * fq;
#pragma unroll
                for (int bj = 0; bj < 2; ++bj) {
                    f32x4 v0 = acc[ai][bj][m][0] * rs, v1 = acc[ai][bj][m][1] * rs;
#pragma unroll
                    for (int e = 0; e < 4; ++e) { const float p = fmaxf(v0[e], 0.f), q = fmaxf(v1[e], 0.f); v0[e] = p * p; v1[e] = q * q; }
                    store8bf(hrow + bj * HALF, v0, v1);
                }
            }
    }
};
template <class Epi, class Sched, bool ALIGN_EPI = false, bool SP2 = false>
__device__ __forceinline__ void gemm_phase(PG8_LAS unsigned char* lds, const Gemm g, const Sched& S, const Epi& E) {
    int tid_o = threadIdx.x; asm volatile("" : "+v"(tid_o));
    const int tid = tid_o, wid = __builtin_amdgcn_readfirstlane(tid >> 6), lane = tid & 63, wr = wid >> 2, wc = wid & 3, fr = lane & 15, fq = lane >> 4;
    const int K = g.K, nt = K / BK;
    unsigned voffA[2], voffB[2];
#pragma unroll
    for (int i = 0; i < 2; ++i) { int R, C; stage_rc(tid * 16 + i * 8192, R, C); const int Rb = Epi::PERM ? ((R & ~31) + perm32(R & 31)) : R;
        voffA[i] = (unsigned)(R * K + C) * 2u; voffB[i] = (unsigned)(Rb * K + C) * 2u; }
    const size_t kstep = (size_t)(BK * 2);
    const size_t hstep = (size_t)HALF * K * 2;
    const size_t tstep = 2 * hstep;
    const unsigned ldsw = (unsigned)wid * 1024u;
    const int aoff = lds_byte(wr * 64 + fr, fq * 8), boff = lds_byte(wc * 32 + fr, fq * 8);
#define PG8_SA(b, h) (((b) * 2 + (h)) * HTB)
#define PG8_SB(b, h) ((4 + (b) * 2 + (h)) * HTB)
#define PG8_STAGE(bufoff, gbase, voff) do { _Pragma("unroll") for (int _i = 0; _i < 2; ++_i) \
        __builtin_amdgcn_global_load_lds((const unsigned*)((const char*)(gbase) + (voff)[_i]), (PG8_LAS unsigned*)(lds + (bufoff) + ldsw + _i * 8192), 16, 0, 0); } while (0)
#define PG8_LDA(dst, b, h) do { _Pragma("unroll") for (int m = 0; m < 4; ++m) _Pragma("unroll") for (int k = 0; k < 2; ++k) dst[m][k] = *(const PG8_LAS bf16x8*)(lds + PG8_SA(b, h) + aoff + m * 2048 + k * 1024); } while (0)
#define PG8_LDB(dst, b, h) do { _Pragma("unroll") for (int n = 0; n < 2; ++n) _Pragma("unroll") for (int k = 0; k < 2; ++k) dst[n][k] = *(const PG8_LAS bf16x8*)(lds + PG8_SB(b, h) + boff + n * 2048 + k * 1024); } while (0)
#define PG8_MMA(ai, bj, At, Bt) do { __builtin_amdgcn_s_setprio(1); _Pragma("unroll") for (int m = 0; m < 4; ++m) _Pragma("unroll") for (int n = 0; n < 2; ++n) _Pragma("unroll") for (int k = 0; k < 2; ++k) \
        acc[ai][bj][m][n] = __builtin_amdgcn_mfma_f32_16x16x32_bf16(Bt[n][k], At[m][k], acc[ai][bj][m][n], 0, 0, 0); __builtin_amdgcn_s_setprio(0); } while (0)
#define PG8_WAIT_V(n) asm volatile("s_waitcnt vmcnt(" #n ")" ::: "memory")
#define PG8_WAIT_L(n) asm volatile("s_waitcnt lgkmcnt(" #n ")" ::: "memory")
#define PG8_BAR __builtin_amdgcn_s_barrier()
#define PG8_SCHED __builtin_amdgcn_sched_barrier(0)
    Unit cur, nxt; int ui = 0;
    if (!S.next(0, cur)) return;
    f32x4 acc[2][2][4][2];
#pragma unroll
    for (int a = 0; a < 2; ++a)
#pragma unroll
        for (int b = 0; b < 2; ++b)
#pragma unroll
            for (int m = 0; m < 4; ++m)
#pragma unroll
                for (int n = 0; n < 2; ++n) acc[a][b][m][n] = (f32x4){0.f, 0.f, 0.f, 0.f};
    bf16x8 At[4][2], B0[2][2], B1[2][2];
    const char* cA = (const char*)g.A + (size_t)cur.pm * tstep; const char* cB = (const char*)g.Bt + (size_t)cur.pn * tstep;
    S.a_ready(cur);
    if constexpr (SP2) {
        PG8_STAGE(PG8_SB(0, 0), cB, voffB); PG8_STAGE(PG8_SB(0, 1), cB + hstep, voffB); PG8_STAGE(PG8_SA(0, 0), cA, voffA); PG8_STAGE(PG8_SA(0, 1), cA + hstep, voffA);
        if (wr == 1) PG8_BAR;
        PG8_WAIT_V(2); PG8_BAR;
        PG8_STAGE(PG8_SB(1, 0), cB + kstep, voffB); PG8_STAGE(PG8_SA(1, 0), cA + kstep, voffA); PG8_STAGE(PG8_SB(1, 1), cB + hstep + kstep, voffB);
        PG8_WAIT_V(6); PG8_BAR;
    } else {
        PG8_STAGE(PG8_SB(0, 0), cB, voffB); PG8_STAGE(PG8_SA(0, 0), cA, voffA); PG8_STAGE(PG8_SB(0, 1), cB + hstep, voffB); PG8_STAGE(PG8_SA(0, 1), cA + hstep, voffA);
        if (wr == 1) PG8_BAR;
        PG8_WAIT_V(4); PG8_BAR;
        PG8_STAGE(PG8_SB(1, 0), cB + kstep, voffB); PG8_STAGE(PG8_SA(1, 0), cA + kstep, voffA); PG8_STAGE(PG8_SB(1, 1), cB + hstep + kstep, voffB);
        PG8_WAIT_V(6); PG8_BAR;
    }
    for (;;) {
        const bool has_next = S.next(ui + 1, nxt);
        const char* nA = has_next ? (const char*)g.A + (size_t)nxt.pm * tstep : cA; const char* nB = has_next ? (const char*)g.Bt + (size_t)nxt.pn * tstep : cB;
        for (int t = 0; t < nt; t += 2) {
            const bool last = (t == nt - 2);
            const char* a1 = cA + (size_t)(t + 1) * kstep;
            const char* a2 = last ? nA : cA + (size_t)(t + 2) * kstep; const char* b2 = last ? nB : cB + (size_t)(t + 2) * kstep;
            const char* a3 = a2 + kstep; const char* b3 = b2 + kstep;
            if (last && has_next) S.a_ready(nxt);
            if constexpr (SP2) {
            PG8_LDB(B0, 0, 0); PG8_LDB(B1, 0, 1); PG8_SCHED; PG8_LDA(At, 0, 0); PG8_STAGE(PG8_SA(1, 1), a1 + hstep, voffA);
            PG8_WAIT_V(8); PG8_WAIT_L(0); PG8_BAR; PG8_MMA(0, 0, At, B0); PG8_MMA(0, 1, At, B1); PG8_BAR; PG8_SCHED;
            PG8_LDA(At, 0, 1); PG8_STAGE(PG8_SB(0, 0), b2, voffB); PG8_STAGE(PG8_SB(0, 1), b2 + hstep, voffB); PG8_STAGE(PG8_SA(0, 0), a2, voffA);
            PG8_WAIT_V(8); PG8_WAIT_L(0); PG8_BAR; PG8_MMA(1, 0, At, B0); PG8_MMA(1, 1, At, B1); PG8_BAR; PG8_SCHED;
            PG8_LDB(B0, 1, 0); PG8_LDB(B1, 1, 1); PG8_SCHED; PG8_LDA(At, 1, 0); PG8_STAGE(PG8_SA(0, 1), a2 + hstep, voffA);
            PG8_WAIT_V(8); PG8_WAIT_L(0); PG8_BAR; PG8_MMA(0, 0, At, B0); PG8_MMA(0, 1, At, B1); PG8_BAR; PG8_SCHED;
            PG8_LDA(At, 1, 1); PG8_STAGE(PG8_SB(1, 0), b3, voffB); PG8_STAGE(PG8_SB(1, 1), b3 + hstep, voffB); PG8_STAGE(PG8_SA(1, 0), a3, voffA);
            PG8_WAIT_V(8); PG8_WAIT_L(0); PG8_BAR; PG8_MMA(1, 0, At, B0); PG8_MMA(1, 1, At, B1); PG8_BAR; PG8_SCHED;
            } else {
            PG8_LDB(B0, 0, 0); PG8_SCHED; PG8_LDA(At, 0, 0); PG8_STAGE(PG8_SA(1, 1), a1 + hstep, voffA);
            PG8_WAIT_L(8); PG8_BAR; PG8_WAIT_L(0); PG8_MMA(0, 0, At, B0); PG8_BAR; PG8_SCHED;
            PG8_LDB(B1, 0, 1); PG8_STAGE(PG8_SB(0, 0), b2, voffB);
            PG8_BAR; PG8_WAIT_L(0); PG8_MMA(0, 1, At, B1); PG8_BAR;
            PG8_LDA(At, 0, 1); PG8_STAGE(PG8_SA(0, 0), a2, voffA);
            PG8_BAR; PG8_WAIT_L(0); PG8_MMA(1, 0, At, B0); PG8_BAR; PG8_SCHED;
            PG8_STAGE(PG8_SB(0, 1), b2 + hstep, voffB);
            PG8_WAIT_V(6); PG8_BAR; PG8_MMA(1, 1, At, B1); PG8_BAR;
            PG8_LDB(B0, 1, 0); PG8_SCHED; PG8_LDA(At, 1, 0); PG8_STAGE(PG8_SA(0, 1), a2 + hstep, voffA);
            PG8_WAIT_L(8); PG8_BAR; PG8_WAIT_L(0); PG8_MMA(0, 0, At, B0); PG8_BAR; PG8_SCHED;
            PG8_LDB(B1, 1, 1); PG8_STAGE(PG8_SB(1, 0), b3, voffB);
            PG8_BAR; PG8_WAIT_L(0); PG8_MMA(0, 1, At, B1); PG8_BAR;
            PG8_LDA(At, 1, 1); PG8_STAGE(PG8_SA(1, 0), a3, voffA);
            PG8_BAR; PG8_WAIT_L(0); PG8_MMA(1, 0, At, B0); PG8_BAR; PG8_SCHED;
            PG8_STAGE(PG8_SB(1, 1), b3 + hstep, voffB);
            PG8_WAIT_V(6); PG8_BAR; PG8_MMA(1, 1, At, B1); PG8_BAR;
            }
        }
        if constexpr (ALIGN_EPI) { if (wr == 0) PG8_BAR; }
        if constexpr (!Epi::AFTER_DRAIN) { E(acc, cur, wr, wc, fr, fq); S.done(cur); }
        if (!has_next) break;
#pragma unroll
        for (int a = 0; a < 2; ++a)
#pragma unroll
            for (int b = 0; b < 2; ++b)
#pragma unroll
                for (int m = 0; m < 4; ++m)
#pragma unroll
                    for (int n = 0; n < 2; ++n) acc[a][b][m][n] = (f32x4){0.f, 0.f, 0.f, 0.f};
        cur = nxt; cA = nA; cB = nB; ++ui;
        if constexpr (ALIGN_EPI) { if (wr == 1) PG8_BAR; }
    }
    PG8_WAIT_V(0);
    if constexpr (!ALIGN_EPI) { if (wr == 0) PG8_BAR; }
    PG8_BAR;
    if constexpr (Epi::AFTER_DRAIN) { E.fused(acc, cur, wr, wc, fr, fq, lds, wid, lane); S.done(cur); }
#undef PG8_SA
#undef PG8_SB
#undef PG8_STAGE
#undef PG8_LDA
#undef PG8_LDB
#undef PG8_MMA
#undef PG8_WAIT_V
#undef PG8_WAIT_L
#undef PG8_BAR
#undef PG8_SCHED
}
}

using pg8::bf16_t; using pg8::bf16x8; using pg8::f32x4; using pg8::u32x4;
using pg8::DM; using pg8::MP; using pg8::MS; using pg8::MT; using pg8::NIN; using pg8::DFF; using pg8::LDP; using pg8::SEQ; using pg8::DSEQ;
using pg8::NBATCH; using pg8::DBATCH; using pg8::DEPTH;
#define LAS __attribute__((address_space(3)))
typedef unsigned u32x2 __attribute__((ext_vector_type(2)));
typedef float f32x2 __attribute__((ext_vector_type(2)));

constexpr int NTHR = 512;
constexpr int LDS_BYTES = 147456;
constexpr size_t O_YP = 0, O_YS = (size_t)MP * DM, O_RETP = O_YS + (size_t)MS * DM, O_CONVP = O_RETP + (size_t)DEPTH * NBATCH * 4 * 16384,
                 O_RETS = O_CONVP + (size_t)DEPTH * NBATCH * 2 * 512, O_CONVS = O_RETS + (size_t)DEPTH * DBATCH * 4 * 16384;
constexpr size_t MiB = 1u << 20;
constexpr size_t WS_WIN = 0, WS_WOUT = 14 * MiB, WS_WUP = 18 * MiB, WS_WDN = 34 * MiB;
constexpr size_t WS_COS = 50 * MiB, WS_SIN = 51 * MiB, WS_SSP = 52 * MiB, WS_SSEG = 55 * MiB;
constexpr size_t WS_XB = 71 * MiB;
constexpr size_t WS_PROJ = 136 * MiB;
constexpr size_t WS_MIX = WS_PROJ + (size_t)MT * LDP * 2;
constexpr size_t WS_H = WS_PROJ;
constexpr size_t WS_END = WS_MIX + (size_t)MT * DM * 2;
static_assert(WS_XB + (size_t)MT * DM * 2 <= WS_PROJ && WS_END <= 512 * MiB && WS_H + (size_t)MT * DFF * 2 <= WS_END, "ws map");

__device__ __forceinline__ float bf2f(unsigned b) { return __uint_as_float(b << 16); }
__device__ __forceinline__ unsigned pk2(float lo, float hi) { return pg8::cvt_pk_bf16(lo, hi); }
__device__ __forceinline__ float ex2(float x) { return __builtin_amdgcn_exp2f(x); }
__device__ __forceinline__ f32x4 mma(const bf16x8 x, const bf16x8 y, const f32x4 c) { return __builtin_amdgcn_mfma_f32_16x16x32_bf16(x, y, c, 0, 0, 0); }
__device__ __forceinline__ bf16x8 frag(LAS unsigned char* base, int row, int stride, int kg, int kb) { return *(const LAS bf16x8*)(base + row * stride + 16 * kg + 64 * kb); }

constexpr int R_Q = 0, R_K = 17408, R_KT = 34816, R_VT = 53248, R_SP = 71680, R_RT = 80896, R_ST = 115712;
constexpr int SQ = 272, ST = 144;
__device__ __forceinline__ void ret_item(LAS unsigned char* lds, const bf16_t* proj, bf16_t* mix, int row0, int nchunks, int CL, int h, float lg2, bool full,
                                         int rinit, const float* rsrc, int nprefix, float* rdst, const float* gnw) {
    int tid_o = threadIdx.x; asm volatile("" : "+v"(tid_o));
    const int tid = tid_o, w = __builtin_amdgcn_readfirstlane(tid >> 6), lane = tid & 63, j = lane & 15, ig = lane >> 4;
    f32x4 R[8];
#pragma unroll
    for (int dt = 0; dt < 8; ++dt) {
#pragma unroll
        for (int t = 0; t < 4; ++t) {
            const int idx = (16 * dt + 4 * ig + t) * 128 + 16 * w + j;
            float v = 0.f;
            if (rinit == 2) v = rsrc[idx];
            else if (rinit == 1) { for (int s = 0; s < nprefix; ++s) v += rsrc[(size_t)s * 16384 + idx] * ex2(lg2 * 512.f * (float)(nprefix - 1 - s)); }
            R[dt][t] = v;
        }
    }
    if (full) {
#pragma unroll
        for (int dt = 0; dt < 8; ++dt) { u32x2 p; p.x = pk2(R[dt][0], R[dt][1]); p.y = pk2(R[dt][2], R[dt][3]); *(LAS u32x2*)(lds + R_RT + (16 * w + j) * SQ + (16 * dt + 4 * ig) * 2) = p; }
    }
    const float cdec = ex2(lg2 * (float)CL);
    const float kdec = ex2(lg2 * (float)(CL - 1 - lane));
    u32x4 qreg[2], kreg[2], vreg[2];
    const u32x4 zero4 = (u32x4){0u, 0u, 0u, 0u};
#define RET_LOAD(c) do { _Pragma("unroll") for (int it = 0; it < 2; ++it) { \
        const int qm = (tid + NTHR * it) >> 4, qd = (tid + NTHR * it) & 15, kd = w + 8 * it; \
        const bf16_t* rb = proj + (size_t)(row0 + (c) * 64) * LDP + h * 128; \
        qreg[it] = (full && qm < CL) ? *(const u32x4*)(rb + (size_t)qm * LDP + 8 * qd) : zero4; \
        kreg[it] = (lane < CL) ? *(const u32x4*)(rb + (size_t)lane * LDP + 512 + 8 * kd) : zero4; \
        vreg[it] = (lane < CL) ? *(const u32x4*)(rb + (size_t)lane * LDP + 1024 + 8 * kd) : zero4; } } while (0)
    RET_LOAD(0);
    for (int c = 0; c < nchunks; ++c) {
#pragma unroll
        for (int it = 0; it < 2; ++it) {
            const int qm = (tid + NTHR * it) >> 4, qd = (tid + NTHR * it) & 15, kd = w + 8 * it;
            if (full) { *(LAS u32x4*)(lds + R_Q + qm * SQ + 16 * qd) = qreg[it]; *(LAS u32x4*)(lds + R_K + lane * SQ + 16 * kd) = kreg[it]; }
#pragma unroll
            for (int e = 0; e < 4; ++e) {
                const unsigned kw = kreg[it][e], vw = vreg[it][e];
                const unsigned kp = pk2(bf2f(kw & 0xffffu) * kdec, bf2f(kw >> 16) * kdec);
                *(LAS unsigned short*)(lds + R_KT + (8 * kd + 2 * e) * ST + 2 * lane) = (unsigned short)(kp & 0xffffu);
                *(LAS unsigned short*)(lds + R_KT + (8 * kd + 2 * e + 1) * ST + 2 * lane) = (unsigned short)(kp >> 16);
                *(LAS unsigned short*)(lds + R_VT + (8 * kd + 2 * e) * ST + 2 * lane) = (unsigned short)(vw & 0xffffu);
                *(LAS unsigned short*)(lds + R_VT + (8 * kd + 2 * e + 1) * ST + 2 * lane) = (unsigned short)(vw >> 16);
            }
        }
        if (c + 1 < nchunks) RET_LOAD(c + 1);
        __syncthreads();
        f32x4 o[4];
        if (full) {
            const int mt = w & 3;
#pragma unroll
            for (int q2 = 0; q2 < 2; ++q2) {
                const int nt = 2 * (w >> 2) + q2;
                f32x4 s = (f32x4){0.f, 0.f, 0.f, 0.f};
#pragma unroll
                for (int kb = 0; kb < 4; ++kb) s = mma(frag(lds + R_K, 16 * mt + j, SQ, ig, kb), frag(lds + R_Q, 16 * nt + j, SQ, ig, kb), s);
                const int n = 16 * nt + j, m0 = 16 * mt + 4 * ig;
#pragma unroll
                for (int t = 0; t < 4; ++t) { const int df = n - (m0 + t); s[t] = df >= 0 ? s[t] * ex2(lg2 * (float)df) : 0.f; }
                u32x2 p; p.x = pk2(s[0], s[1]); p.y = pk2(s[2], s[3]);
                *(LAS u32x2*)(lds + R_SP + n * ST + m0 * 2) = p;
            }
            __syncthreads();
            bf16x8 rt[4], vt[2];
#pragma unroll
            for (int kb = 0; kb < 4; ++kb) rt[kb] = frag(lds + R_RT, 16 * w + j, SQ, ig, kb);
#pragma unroll
            for (int kb = 0; kb < 2; ++kb) vt[kb] = frag(lds + R_VT, 16 * w + j, ST, ig, kb);
#pragma unroll
            for (int nt = 0; nt < 4; ++nt) {
                f32x4 a = (f32x4){0.f, 0.f, 0.f, 0.f}, b = (f32x4){0.f, 0.f, 0.f, 0.f};
#pragma unroll
                for (int kb = 0; kb < 4; ++kb) a = mma(rt[kb], frag(lds + R_Q, 16 * nt + j, SQ, ig, kb), a);
#pragma unroll
                for (int kb = 0; kb < 2; ++kb) b = mma(vt[kb], frag(lds + R_SP, 16 * nt + j, ST, ig, kb), b);
                const float qd = ex2(lg2 * (float)(16 * nt + j + 1));
                o[nt] = b + a * qd;
                float s1 = (o[nt][0] + o[nt][1]) + (o[nt][2] + o[nt][3]);
                float s2 = (o[nt][0] * o[nt][0] + o[nt][1] * o[nt][1]) + (o[nt][2] * o[nt][2] + o[nt][3] * o[nt][3]);
                s1 += __shfl_xor(s1, 16); s1 += __shfl_xor(s1, 32); s2 += __shfl_xor(s2, 16); s2 += __shfl_xor(s2, 32);
                if (ig == 0) *(LAS f32x2*)(lds + R_ST + ((16 * nt + j) * 8 + w) * 8) = (f32x2){s1, s2};
            }
        }
        {
            bf16x8 vt[2];
#pragma unroll
            for (int kb = 0; kb < 2; ++kb) vt[kb] = frag(lds + R_VT, 16 * w + j, ST, ig, kb);
#pragma unroll
            for (int dt = 0; dt < 8; ++dt) {
                R[dt] = R[dt] * cdec;
#pragma unroll
                for (int kb = 0; kb < 2; ++kb) R[dt] = mma(frag(lds + R_KT, 16 * dt + j, ST, ig, kb), vt[kb], R[dt]);
            }
        }
        if (full && c + 1 < nchunks) {
#pragma unroll
            for (int dt = 0; dt < 8; ++dt) { u32x2 p; p.x = pk2(R[dt][0], R[dt][1]); p.y = pk2(R[dt][2], R[dt][3]); *(LAS u32x2*)(lds + R_RT + (16 * w + j) * SQ + (16 * dt + 4 * ig) * 2) = p; }
        }
        __syncthreads();
        if (full) {
            const f32x4 gw = *(const f32x4*)(gnw + h * 128 + 16 * w + 4 * ig);
#pragma unroll
            for (int nt = 0; nt < 4; ++nt) {
                const int n = 16 * nt + j;
                if (n < CL) {
                    const LAS f32x4* sp = (const LAS f32x4*)(lds + R_ST + n * 64);
                    const f32x4 p0 = sp[0], p1 = sp[1], p2 = sp[2], p3 = sp[3];
                    const float s1 = (p0[0] + p0[2]) + (p1[0] + p1[2]) + (p2[0] + p2[2]) + (p3[0] + p3[2]);
                    const float s2 = (p0[1] + p0[3]) + (p1[1] + p1[3]) + (p2[1] + p2[3]) + (p3[1] + p3[3]);
                    const float mean = s1 * (1.0f / 128.0f);
                    const float var = fmaxf(s2 * (1.0f / 128.0f) - mean * mean, 0.f);
                    const float rstd = __builtin_amdgcn_rsqf(var + pg8::GN_EPS);
                    const size_t row = (size_t)(row0 + c * 64 + n);
                    const u32x2 sg = *(const u32x2*)(proj + row * LDP + 1536 + h * 128 + 16 * w + 4 * ig);
                    const float g0 = bf2f(sg.x & 0xffffu), g1 = bf2f(sg.x >> 16), g2 = bf2f(sg.y & 0xffffu), g3 = bf2f(sg.y >> 16);
                    u32x2 p;
                    p.x = pk2((o[nt][0] - mean) * rstd * gw[0] * g0, (o[nt][1] - mean) * rstd * gw[1] * g1);
                    p.y = pk2((o[nt][2] - mean) * rstd * gw[2] * g2, (o[nt][3] - mean) * rstd * gw[3] * g3);
                    *(u32x2*)(mix + row * DM + h * 128 + 16 * w + 4 * ig) = p;
                }
            }
        }
    }
#undef RET_LOAD
    if (rdst) {
#pragma unroll
        for (int dt = 0; dt < 8; ++dt)
#pragma unroll
            for (int t = 0; t < 4; ++t) rdst[(16 * dt + 4 * ig + t) * 128 + 16 * w + j] = R[dt][t];
    }
    __syncthreads();
}
__device__ __forceinline__ float head_lg2(int h) { return h == 0 ? -0.04580368961312479f : h == 1 ? -0.02272007650008353f : h == 2 ? -0.011315313227834146f : -0.005646563141142063f; }

__device__ __forceinline__ void conv_phase(const bf16_t* proj, bf16_t* mix, const float* conv_w  , const float* sconv  , int gtid, int nthr) {
    const int nitems = (MT / 16) * 64;
    for (int it = gtid; it < nitems; it += nthr) {
        const int co = it & 63, rb = it >> 6, r0 = rb * 16, c0 = co * 8;
        float w0[8], w1[8], w2[8], um2[8], um1[8];
#pragma unroll
        for (int e = 0; e < 8; ++e) { w0[e] = conv_w[(c0 + e) * 3 + 0]; w1[e] = conv_w[(c0 + e) * 3 + 1]; w2[e] = conv_w[(c0 + e) * 3 + 2]; }
        const bool seq_start = r0 < MP ? ((r0 & (SEQ - 1)) == 0) : true;
        if (seq_start) {
            if (r0 < MP) {
#pragma unroll
                for (int e = 0; e < 8; ++e) { um2[e] = 0.f; um1[e] = 0.f; }
            } else {
                const float* sb = sconv + (size_t)((r0 - MP) >> 4) * 1024 + c0;
#pragma unroll
                for (int e = 0; e < 8; ++e) { um2[e] = sb[e]; um1[e] = sb[512 + e]; }
            }
        } else {
            const u32x4 a = *(const u32x4*)(proj + (size_t)(r0 - 2) * LDP + 2560 + c0), b = *(const u32x4*)(proj + (size_t)(r0 - 1) * LDP + 2560 + c0);
#pragma unroll
            for (int e = 0; e < 4; ++e) { um2[2 * e] = bf2f(a[e] & 0xffffu); um2[2 * e + 1] = bf2f(a[e] >> 16); um1[2 * e] = bf2f(b[e] & 0xffffu); um1[2 * e + 1] = bf2f(b[e] >> 16); }
        }
#pragma unroll 4
        for (int i = 0; i < 16; ++i) {
            const size_t row = (size_t)(r0 + i);
            const u32x4 uu = *(const u32x4*)(proj + row * LDP + 2560 + c0), bb = *(const u32x4*)(proj + row * LDP + 2048 + c0);
            float res[8];
#pragma unroll
            for (int e = 0; e < 4; ++e) {
                const float u0 = bf2f(uu[e] & 0xffffu), u1 = bf2f(uu[e] >> 16), b0 = bf2f(bb[e] & 0xffffu), b1 = bf2f(bb[e] >> 16);
                res[2 * e] = b0 * (w0[2 * e] * um2[2 * e] + w1[2 * e] * um1[2 * e] + w2[2 * e] * u0);
                res[2 * e + 1] = b1 * (w0[2 * e + 1] * um2[2 * e + 1] + w1[2 * e + 1] * um1[2 * e + 1] + w2[2 * e + 1] * u1);
                um2[2 * e] = um1[2 * e]; um1[2 * e] = u0; um2[2 * e + 1] = um1[2 * e + 1]; um1[2 * e + 1] = u1;
            }
            u32x4 o; o.x = pk2(res[0], res[1]); o.y = pk2(res[2], res[3]); o.z = pk2(res[4], res[5]); o.w = pk2(res[6], res[7]);
            *(u32x4*)(mix + row * DM + 512 + c0) = o;
        }
    }
}

__device__ __forceinline__ void conv_weight(const float* W, int K, int N, bf16_t* Wt, const float* ksc, int mode, int gtid, int nthr) {
    const int nitems = (K / 8) * N;
    for (int it = gtid; it < nitems; it += nthr) {
        const int ko = it / N, np = it - ko * N, k0 = ko * 8;
        int col = np; float cs = 1.f;
        if (mode == 1) {
            const int pn = np >> 8, bj = (np >> 7) & 1, t = np & 127;
            if (pn < 4) { col = (pn < 2 ? 0 : 512) + 128 * (2 * (pn & 1) + (t >> 6)) + 64 * bj + (t & 63); if (pn >= 2) cs = 0.08838834764831845f; }
            else if (pn >= 10) col = (bj ? 3072 : 2560) + 128 * (pn - 10) + t;
        }
        float v[8];
#pragma unroll
        for (int e = 0; e < 8; ++e) v[e] = W[(size_t)(k0 + e) * N + col] * (ksc ? ksc[k0 + e] : 1.f) * cs;
        u32x4 o; o.x = pk2(v[0], v[1]); o.y = pk2(v[2], v[3]); o.z = pk2(v[4], v[5]); o.w = pk2(v[6], v[7]);
        *(u32x4*)(Wt + (size_t)np * K + k0) = o;
    }
}
__device__ __forceinline__ float wave_sum(float v) {
#pragma unroll
    for (int o = 1; o < 64; o <<= 1) v += __shfl_xor(v, o);
    return v;
}

struct Args { const float* in[13]; float* out; unsigned char* ws; };

__global__ void __launch_bounds__(NTHR, 2) hymba_fwd(Args args) {
    extern __shared__ __attribute__((aligned(16))) unsigned char lds_raw[];
    LAS unsigned char* lds = (LAS unsigned char*)lds_raw;
    cg::grid_group grid = cg::this_grid();
    const int tid = threadIdx.x, lane = tid & 63, wave = __builtin_amdgcn_readfirstlane(tid >> 6);
    const int G = gridDim.x, bx = blockIdx.x;
    const int gtid = bx * NTHR + tid, nthr = G * NTHR, gw = bx * 8 + wave, ngw = G * 8;
    unsigned char* ws = args.ws;
    const float* x_prompt = args.in[0]; const float* x_sample = args.in[1]; const float* state_ret = args.in[2]; const float* state_conv = args.in[3];
    const float* ln1_w = args.in[4]; const float* w_in = args.in[5]; const float* conv_w = args.in[6]; const float* ret_norm_w = args.in[7];
    const float* w_out = args.in[8]; const float* ln2_w = args.in[9]; const float* w_up = args.in[10]; const float* w_dn = args.in[11]; const float* ln_f_w = args.in[12];
    float* out = args.out;
    bf16_t* WtIn = (bf16_t*)(ws + WS_WIN); bf16_t* WtOut = (bf16_t*)(ws + WS_WOUT); bf16_t* WtUp = (bf16_t*)(ws + WS_WUP); bf16_t* WtDn = (bf16_t*)(ws + WS_WDN);
    float* rcos = (float*)(ws + WS_COS); float* rsin = (float*)(ws + WS_SIN); float* ssp = (float*)(ws + WS_SSP); float* sseg = (float*)(ws + WS_SSEG);
    bf16_t* xb = (bf16_t*)(ws + WS_XB); bf16_t* proj = (bf16_t*)(ws + WS_PROJ); bf16_t* mix = (bf16_t*)(ws + WS_MIX); bf16_t* Hb = (bf16_t*)(ws + WS_H);
    float* X = out;

#pragma unroll 1
    for (int l = 0; l < DEPTH; ++l) {
        conv_weight(w_in + (size_t)l * DM * NIN, DM, NIN, WtIn + (size_t)l * NIN * DM, ln1_w + l * DM, 1, gtid, nthr);
        conv_weight(w_out + (size_t)l * DM * DM, DM, DM, WtOut + (size_t)l * DM * DM, nullptr, 0, gtid, nthr);
        conv_weight(w_up + (size_t)l * DM * DFF, DM, DFF, WtUp + (size_t)l * DFF * DM, ln2_w + l * DM, 0, gtid, nthr);
        conv_weight(w_dn + (size_t)l * DFF * DM, DFF, DM, WtDn + (size_t)l * DM * DFF, nullptr, 0, gtid, nthr);
    }
    for (int it = gtid; it < SEQ * 64; it += nthr) {
        const int pos = it >> 6, i = it & 63;
        const float inv = ex2(-(float)i * (13.287712379549449f / 64.0f));
        const float ang = (float)pos * inv;
        const double rev = (double)ang * 0.15915494309189535;
        const float fr = (float)(rev - __builtin_floor(rev));
        rcos[it] = __builtin_amdgcn_cosf(fr); rsin[it] = __builtin_amdgcn_sinf(fr);
    }
    for (int r = gw; r < MT; r += ngw) {
        const float* xr = r < MP ? x_prompt + (size_t)r * DM : x_sample + (size_t)(r - MP) * DM;
        float s = 0.f;
#pragma unroll
        for (int q = 0; q < 4; ++q) {
            const f32x4 v = *(const f32x4*)(xr + 256 * q + 4 * lane);
            u32x2 p; p.x = pk2(v[0], v[1]); p.y = pk2(v[2], v[3]);
            *(u32x2*)(xb + (size_t)r * DM + 256 * q + 4 * lane) = p;
            s += (v[0] * v[0] + v[1] * v[1]) + (v[2] * v[2] + v[3] * v[3]);
        }
        s = wave_sum(s);
        if (lane < 16) ssp[(size_t)r * 16 + lane] = lane == 0 ? s : 0.f;
    }
    grid.sync();

#pragma unroll 1
    for (int l = 0; l < DEPTH; ++l) {
        {
            pg8::Gemm g{xb, WtIn + (size_t)l * NIN * DM, MT, NIN, DM}; pg8::StaticOrder S; S.init(MT, NIN, G, bx);
            pg8::EpiIn E{proj, ssp, rcos, rsin, out + O_CONVP + (size_t)l * NBATCH * 1024, out + O_CONVS + (size_t)l * DBATCH * 1024};
            pg8::gemm_phase<pg8::EpiIn, pg8::StaticOrder, true, true>(lds, g, S, E);
        }
        grid.sync();
        for (int it = bx; it < 288; it += G) {
            if (it < 224) {
                const int b = it / 28, rem = it - b * 28, h = rem / 7, sg = rem - h * 7;
                ret_item(lds, proj, mix, b * SEQ + sg * 512, 8, 64, h, head_lg2(h), false, 0, nullptr, 0, sseg + (size_t)((b * 4 + h) * 8 + sg) * 16384, nullptr);
            } else {
                const int si = it - 224, b = si >> 2, h = si & 3;
                ret_item(lds, proj, mix, MP + b * DSEQ, 1, DSEQ, h, head_lg2(h), true, 2, state_ret + (size_t)((l * DBATCH + b) * 4 + h) * 16384, 0,
                         out + O_RETS + (size_t)((l * DBATCH + b) * 4 + h) * 16384, ret_norm_w + l * 512);
            }
        }
        conv_phase(proj, mix, conv_w + (size_t)l * 512 * 3, state_conv + (size_t)l * DBATCH * 1024, gtid, nthr);
        grid.sync();
        for (int it = bx; it < 256; it += G) {
            const int b = it >> 5, h = (it >> 3) & 3, sg = it & 7;
            ret_item(lds, proj, mix, b * SEQ + sg * 512, 8, 64, h, head_lg2(h), true, sg > 0 ? 1 : 0, sseg + (size_t)((b * 4 + h) * 8) * 16384, sg,
                     sg == 7 ? out + O_RETP + (size_t)((l * NBATCH + b) * 4 + h) * 16384 : nullptr, ret_norm_w + l * 512);
        }
        grid.sync();
        {
            pg8::Gemm g{mix, WtOut + (size_t)l * DM * DM, MT, DM, DM}; pg8::StaticOrder S; S.init(MT, DM, G, bx);
            pg8::EpiRes E{l == 0 ? x_prompt : X, l == 0 ? x_sample : X + (size_t)MP * DM, X, xb, ssp};
            pg8::gemm_phase<pg8::EpiRes, pg8::StaticOrder, true, true>(lds, g, S, E);
        }
        grid.sync();
        {
            pg8::Gemm g{xb, WtUp + (size_t)l * DFF * DM, MT, DFF, DM}; pg8::StaticOrder S; S.init(MT, DFF, G, bx);
            pg8::EpiUp E{Hb, ssp};
            pg8::gemm_phase<pg8::EpiUp, pg8::StaticOrder, true, true>(lds, g, S, E);
        }
        grid.sync();
        {
            pg8::Gemm g{Hb, WtDn + (size_t)l * DM * DFF, MT, DM, DFF}; pg8::StaticOrder S; S.init(MT, DM, G, bx);
            pg8::EpiRes E{X, X + (size_t)MP * DM, X, xb, ssp};
            pg8::gemm_phase<pg8::EpiRes, pg8::StaticOrder, true, true>(lds, g, S, E);
        }
        grid.sync();
    }
    for (int r = gw; r < MT; r += ngw) {
        const float rs = pg8::row_rstd(ssp, r);
        float* xr = X + (size_t)r * DM;
#pragma unroll
        for (int q = 0; q < 4; ++q) {
            const f32x4 v = *(const f32x4*)(xr + 256 * q + 4 * lane), wv = *(const f32x4*)(ln_f_w + 256 * q + 4 * lane);
            *(f32x4*)(xr + 256 * q + 4 * lane) = v * rs * wv;
        }
    }
}

extern "C" void kernel_launch(void* const* d_in, const int* in_sizes, int n_in, void* d_out, int out_size, void* d_ws, size_t ws_size, hipStream_t stream) {
    static int grid = 0;
    if (grid == 0) {
        int dev = 0, cus = 0, per_cu = 0;
        if (n_in != 13 || ws_size < WS_END) { fprintf(stderr, "kernel_launch: unexpected n_in %d / ws_size %zu (need %zu)\n", n_in, ws_size, (size_t)WS_END); grid = -1; return; }
        hipGetDevice(&dev);
        hipDeviceGetAttribute(&cus, hipDeviceAttributeMultiprocessorCount, dev);
        hipFuncSetAttribute((const void*)hymba_fwd, hipFuncAttributeMaxDynamicSharedMemorySize, LDS_BYTES);
        hipOccupancyMaxActiveBlocksPerMultiprocessor(&per_cu, (const void*)hymba_fwd, NTHR, LDS_BYTES);
        if (per_cu < 1) { fprintf(stderr, "kernel_launch: occupancy query says %d blocks/CU\n", per_cu); per_cu = 1; }
        (void)hipGetLastError();
        grid = cus;
    }
    if (grid < 0) return;
    Args a{};
    for (int i = 0; i < 13; ++i) a.in[i] = (const float*)d_in[i];
    a.out = (float*)d_out; a.ws = (unsigned char*)d_ws;
    void* kargs[] = {&a};
    hipError_t e = hipLaunchCooperativeKernel((const void*)hymba_fwd, dim3(grid), dim3(NTHR), kargs, LDS_BYTES, stream);
    if (e != hipSuccess) fprintf(stderr, "cooperative launch failed: %s (grid %d)\n", hipGetErrorString(e), grid);
}
```

```cpp
#include <hip/hip_runtime.h>
#include <hip/hip_cooperative_groups.h>
#include <cstdio>
#include <cstdint>
namespace cg = cooperative_groups;
namespace pg8 {
#define PG8_LAS __attribute__((address_space(3)))
typedef unsigned short bf16_t;
typedef short bf16x8 __attribute__((ext_vector_type(8)));
typedef float f32x4 __attribute__((ext_vector_type(4)));
typedef unsigned u32x4 __attribute__((ext_vector_type(4)));
constexpr int BM = 256, BK = 64, HALF = 128, HTB = HALF * BK * 2  , STAGE_BYTES = 8 * HTB, NXCD = 8, WGM = 8;

__host__ __device__ __forceinline__ int lds_byte(int r, int c) { const int st = (r >> 4) * 2 + (c >> 5), rr = r & 15, cc = c & 31, ob = rr * 64 + cc * 2; return st * 1024 + (ob ^ (((ob >> 9) & 1) << 5)); }
__host__ __device__ __forceinline__ void stage_rc(int b, int& R, int& C) { const int st = b / 1024, sb = b % 1024, swz = sb ^ (((sb >> 9) & 1) << 5); R = (st >> 1) * 16 + swz / 64; C = (st & 1) * 32 + (swz % 64) / 2; }
__host__ __device__ __forceinline__ int perm32(int rho) { const int n = rho >> 4, i = rho & 15; return 8 * (i >> 2) + 4 * n + (i & 3); }

struct Unit { int pm, pn; };
struct Gemm { const bf16_t* A; const bf16_t* Bt; int M, N, K; };

struct StaticOrder {
    int nM, nN, nwg, G, c;
    __host__ __device__ void init(int M, int N, int G_, int c_) { nM = M / BM; nN = N / BM; nwg = nM * nN; G = G_; c = c_; }
    __host__ __device__ bool next(int i, Unit& u) const {
        const long L = (long)i * G + c; if (L >= nwg) return false;
        int wgid = (int)L; { const int q = nwg / NXCD, r = nwg % NXCD, xcd = wgid % NXCD, off = wgid / NXCD; wgid = (xcd < r ? xcd * (q + 1) : r * (q + 1) + (xcd - r) * q) + off; }
        const int nig = WGM * nN, gid = wgid / nig, fm = gid * WGM, gsz = (nM - fm) < WGM ? (nM - fm) : WGM;
        u.pm = fm + ((wgid % nig) % gsz); u.pn = (wgid % nig) / gsz; return true;
    }
    __device__ __forceinline__ void a_ready(const Unit&) const {}
    __device__ __forceinline__ void done(const Unit&) const {}
};

__device__ __forceinline__ unsigned cvt_pk_bf16(float lo, float hi) { unsigned r; asm volatile("v_cvt_pk_bf16_f32 %0, %1, %2" : "=v"(r) : "v"(lo), "v"(hi)); return r; }
typedef float f32x2 __attribute__((ext_vector_type(2)));

constexpr int DM = 1024, NBATCH = 8, SEQ = 4096, DEPTH = 2, DBATCH = 16, DSEQ = 16, PAST = 2048;
constexpr int MP = NBATCH * SEQ, MS = DBATCH * DSEQ, MT = MP + MS;
constexpr int NIN = 3584, DFF = 4096, LDP = 3072;
constexpr float RMS_EPS = 1e-6f, GN_EPS = 1e-5f;

__device__ __forceinline__ void store8bf(bf16_t* p, const f32x4 a, const f32x4 b) {
    u32x4 w; w.x = cvt_pk_bf16(a[0], a[1]); w.y = cvt_pk_bf16(a[2], a[3]); w.z = cvt_pk_bf16(b[0], b[1]); w.w = cvt_pk_bf16(b[2], b[3]);
    *(u32x4*)p = w;
}
__device__ __forceinline__ float row_rstd(const float* ssp, int r) {
    const f32x4* sp = (const f32x4*)(ssp + (size_t)r * 16);
    const f32x4 s0 = sp[0], s1 = sp[1], s2 = sp[2], s3 = sp[3];
    const f32x4 s = (s0 + s1) + (s2 + s3);
    const float tot = (s[0] + s[1]) + (s[2] + s[3]);
    return __builtin_amdgcn_rsqf(tot * (1.0f / DM) + RMS_EPS);
}
__device__ __forceinline__ float silu_f(float x) { return x * __builtin_amdgcn_rcpf(1.0f + __builtin_amdgcn_exp2f(-1.4426950408889634f * x)); }

struct EpiIn {
    static constexpr bool PERM = true, AFTER_DRAIN = false;
    bf16_t* proj; const float* ssp; const float* rcos; const float* rsin; float* nconv_p; float* nconv_s;
    __device__ __forceinline__ void operator()(const f32x4 (&acc)[2][2][4][2], const Unit& u, int wr, int wc, int fr, int fq) const {
        const int pn = u.pn, tcol = wc * 32 + 8 * fq;
#pragma unroll
        for (int ai = 0; ai < 2; ++ai)
#pragma unroll
            for (int m = 0; m < 4; ++m) {
                const int r = u.pm * BM + ai * HALF + wr * 64 + m * 16 + fr;
                const float rs = row_rstd(ssp, r);
                const f32x4 a0 = acc[ai][0][m][0] * rs, a1 = acc[ai][0][m][1] * rs, b0 = acc[ai][1][m][0] * rs, b1 = acc[ai][1][m][1] * rs;
                bf16_t* prow = proj + (size_t)r * LDP;
                if (pn < 4) {
                    const int pos = r < MP ? (r & (SEQ - 1)) : PAST + (r & (DSEQ - 1));
                    const int i0 = 32 * (wc & 1) + 8 * fq;
                    const f32x4 c0 = *(const f32x4*)(rcos + pos * 64 + i0), c1 = *(const f32x4*)(rcos + pos * 64 + i0 + 4);
                    const f32x4 s0 = *(const f32x4*)(rsin + pos * 64 + i0), s1 = *(const f32x4*)(rsin + pos * 64 + i0 + 4);
                    const f32x4 o10 = a0 * c0 - b0 * s0, o11 = a1 * c1 - b1 * s1, o20 = a0 * s0 + b0 * c0, o21 = a1 * s1 + b1 * c1;
                    const int dcol = (pn < 2 ? 0 : 512) + 128 * (2 * (pn & 1) + (wc >> 1)) + i0;
                    store8bf(prow + dcol, o10, o11); store8bf(prow + dcol + 64, o20, o21);
                } else if (pn < 10) {
                    f32x4 x0 = a0, x1 = a1, y0 = b0, y1 = b1;
                    if (pn == 6 || pn == 7) {
#pragma unroll
                        for (int e = 0; e < 4; ++e) { x0[e] = silu_f(x0[e]); x1[e] = silu_f(x1[e]); y0[e] = silu_f(y0[e]); y1[e] = silu_f(y1[e]); }
                    }
                    const int dcol = 256 * pn + tcol;
                    store8bf(prow + dcol, x0, x1); store8bf(prow + dcol + 128, y0, y1);
                } else {
                    const f32x4 u0 = a0 * b0, u1 = a1 * b1;
                    const int cc = 128 * (pn - 10) + tcol;
                    store8bf(prow + 2560 + cc, u0, u1);
                    if (r < MP) { const int t = r & (SEQ - 1); if (t >= SEQ - 2) { float* d = nconv_p + (size_t)((r >> 12) * 2 + (t - (SEQ - 2))) * 512 + cc; *(f32x4*)d = u0; *(f32x4*)(d + 4) = u1; } }
                    else { const int t = r & (DSEQ - 1); if (t >= DSEQ - 2) { float* d = nconv_s + (size_t)(((r - MP) >> 4) * 2 + (t - (DSEQ - 2))) * 512 + cc; *(f32x4*)d = u0; *(f32x4*)(d + 4) = u1; } }
                }
            }
    }
};
struct EpiRes {
    static constexpr bool PERM = false, AFTER_DRAIN = false;
    const float* xs_main; const float* xs_tail; float* X; bf16_t* xb; float* ssp;
    __device__ __forceinline__ void operator()(const f32x4 (&acc)[2][2][4][2], const Unit& u, int wr, int wc, int fr, int fq) const {
        typedef unsigned u32x2v __attribute__((ext_vector_type(2)));
#pragma unroll
        for (int ai = 0; ai < 2; ++ai)
#pragma unroll
            for (int m = 0; m < 4; ++m) {
                const int r = u.pm * BM + ai * HALF + wr * 64 + m * 16 + fr;
                const float* xs = r < MP ? xs_main + (size_t)r * DM : xs_tail + (size_t)(r - MP) * DM;
                float ss = 0.f;
#pragma unroll
                for (int bj = 0; bj < 2; ++bj)
#pragma unroll
                    for (int n = 0; n < 2; ++n) {
                        const int c = u.pn * BM + bj * HALF + wc * 32 + n * 16 + 4 * fq;
                        const f32x4 v = *(const f32x4*)(xs + c) + acc[ai][bj][m][n];
                        *(f32x4*)(X + (size_t)r * DM + c) = v;
                        u32x2v w; w.x = cvt_pk_bf16(v[0], v[1]); w.y = cvt_pk_bf16(v[2], v[3]);
                        *(u32x2v*)(xb + (size_t)r * DM + c) = w;
                        ss += (v[0] * v[0] + v[1] * v[1]) + (v[2] * v[2] + v[3] * v[3]);
                    }
                ss += __shfl_xor(ss, 16); ss += __shfl_xor(ss, 32);
                if (fq == 0) ssp[(size_t)r * 16 + 4 * u.pn + wc] = ss;
            }
    }
};
struct EpiUp {
    static constexpr bool PERM = true, AFTER_DRAIN = false;
    bf16_t* H; const float* ssp;
    __device__ __forceinline__ void operator()(const f32x4 (&acc)[2][2][4][2], const Unit& u, int wr, int wc, int fr, int fq) const {
#pragma unroll
        for (int ai = 0; ai < 2; ++ai)
#pragma unroll
            for (int m = 0; m < 4; ++m) {
                const int r = u.pm * BM + ai * HALF + wr * 64 + m * 16 + fr;
                const float rs = row_rstd(ssp, r);
                bf16_t* hrow = H + (size_t)r * DFF + u.pn * BM + wc * 32 + 8 * fq;
#pragma unroll
                for (int bj = 0; bj < 2; ++bj) {
                    f32x4 v0 = acc[ai][bj][m][0] * rs, v1 = acc[ai][bj][m][1] * rs;
#pragma unroll
                    for (int e = 0; e < 4; ++e) { const float p = fmaxf(v0[e], 0.f), q = fmaxf(v1[e], 0.f); v0[e] = p * p; v1[e] = q * q; }
                    store8bf(hrow + bj * HALF, v0, v1);
                }
            }
    }
};
template <class Epi, class Sched, bool ALIGN_EPI = false, bool SP2 = false>
__device__ __forceinline__ void gemm_phase(PG8_LAS unsigned char* lds, const Gemm g, const Sched& S, const Epi& E) {
    int tid_o = threadIdx.x; asm volatile("" : "+v"(tid_o));
    const int tid = tid_o, wid = __builtin_amdgcn_readfirstlane(tid >> 6), lane = tid & 63, wr = wid >> 2, wc = wid & 3, fr = lane & 15, fq = lane >> 4;
    const int K = g.K, nt = K / BK;
    unsigned voffA[2], voffB[2];
#pragma unroll
    for (int i = 0; i < 2; ++i) { int R, C; stage_rc(tid * 16 + i * 8192, R, C); const int Rb = Epi::PERM ? ((R & ~31) + perm32(R & 31)) : R;
        voffA[i] = (unsigned)(R * K + C) * 2u; voffB[i] = (unsigned)(Rb * K + C) * 2u; }
    const size_t kstep = (size_t)(BK * 2);
    const size_t hstep = (size_t)HALF * K * 2;
    const size_t tstep = 2 * hstep;
    const unsigned ldsw = (unsigned)wid * 1024u;
    const int aoff = lds_byte(wr * 64 + fr, fq * 8), boff = lds_byte(wc * 32 + fr, fq * 8);
#define PG8_SA(b, h) (((b) * 2 + (h)) * HTB)
#define PG8_SB(b, h) ((4 + (b) * 2 + (h)) * HTB)
#define PG8_STAGE(bufoff, gbase, voff) do { _Pragma("unroll") for (int _i = 0; _i < 2; ++_i) \
        __builtin_amdgcn_global_load_lds((const unsigned*)((const char*)(gbase) + (voff)[_i]), (PG8_LAS unsigned*)(lds + (bufoff) + ldsw + _i * 8192), 16, 0, 0); } while (0)
#define PG8_LDA(dst, b, h) do { _Pragma("unroll") for (int m = 0; m < 4; ++m) _Pragma("unroll") for (int k = 0; k < 2; ++k) dst[m][k] = *(const PG8_LAS bf16x8*)(lds + PG8_SA(b, h) + aoff + m * 2048 + k * 1024); } while (0)
#define PG8_LDB(dst, b, h) do { _Pragma("unroll") for (int n = 0; n < 2; ++n) _Pragma("unroll") for (int k = 0; k < 2; ++k) dst[n][k] = *(const PG8_LAS bf16x8*)(lds + PG8_SB(b, h) + boff + n * 2048 + k * 1024); } while (0)
#define PG8_MMA(ai, bj, At, Bt) do { __builtin_amdgcn_s_setprio(1); _Pragma("unroll") for (int m = 0; m < 4; ++m) _Pragma("unroll") for (int n = 0; n < 2; ++n) _Pragma("unroll") for (int k = 0; k < 2; ++k) \
        acc[ai][bj][m][n] = __builtin_amdgcn_mfma_f32_16x16x32_bf16(Bt[n][k], At[m][k], acc[ai][bj][m][n], 0, 0, 0); __builtin_amdgcn_s_setprio(0); } while (0)
#define PG8_WAIT_V(n) asm volatile("s_waitcnt vmcnt(" #n ")" ::: "memory")
#define PG8_WAIT_L(n) asm volatile("s_waitcnt lgkmcnt(" #n ")" ::: "memory")
#define PG8_BAR __builtin_amdgcn_s_barrier()
#define PG8_SCHED __builtin_amdgcn_sched_barrier(0)
    Unit cur, nxt; int ui = 0;
    if (!S.next(0, cur)) return;
    f32x4 acc[2][2][4][2];
#pragma unroll
    for (int a = 0; a < 2; ++a)
#pragma unroll
        for (int b = 0; b < 2; ++b)
#pragma unroll
            for (int m = 0; m < 4; ++m)
#pragma unroll
                for (int n = 0; n < 2; ++n) acc[a][b][m][n] = (f32x4){0.f, 0.f, 0.f, 0.f};
    bf16x8 At[4][2], B0[2][2], B1[2][2];
    const char* cA = (const char*)g.A + (size_t)cur.pm * tstep; const char* cB = (const char*)g.Bt + (size_t)cur.pn * tstep;
    S.a_ready(cur);
    if constexpr (SP2) {
        PG8_STAGE(PG8_SB(0, 0), cB, voffB); PG8_STAGE(PG8_SB(0, 1), cB + hstep, voffB); PG8_STAGE(PG8_SA(0, 0), cA, voffA); PG8_STAGE(PG8_SA(0, 1), cA + hstep, voffA);
        if (wr == 1) PG8_BAR;
        PG8_WAIT_V(2); PG8_BAR;
        PG8_STAGE(PG8_SB(1, 0), cB + kstep, voffB); PG8_STAGE(PG8_SA(1, 0), cA + kstep, voffA); PG8_STAGE(PG8_SB(1, 1), cB + hstep + kstep, voffB);
        PG8_WAIT_V(6); PG8_BAR;
    } else {
        PG8_STAGE(PG8_SB(0, 0), cB, voffB); PG8_STAGE(PG8_SA(0, 0), cA, voffA); PG8_STAGE(PG8_SB(0, 1), cB + hstep, voffB); PG8_STAGE(PG8_SA(0, 1), cA + hstep, voffA);
        if (wr == 1) PG8_BAR;
        PG8_WAIT_V(4); PG8_BAR;
        PG8_STAGE(PG8_SB(1, 0), cB + kstep, voffB); PG8_STAGE(PG8_SA(1, 0), cA + kstep, voffA); PG8_STAGE(PG8_SB(1, 1), cB + hstep + kstep, voffB);
        PG8_WAIT_V(6); PG8_BAR;
    }
    for (;;) {
        const bool has_next = S.next(ui + 1, nxt);
        const char* nA = has_next ? (const char*)g.A + (size_t)nxt.pm * tstep : cA; const char* nB = has_next ? (const char*)g.Bt + (size_t)nxt.pn * tstep : cB;
        for (int t = 0; t < nt; t += 2) {
            const bool last = (t == nt - 2);
            const char* a1 = cA + (size_t)(t + 1) * kstep;
            const char* a2 = last ? nA : cA + (size_t)(t + 2) * kstep; const char* b2 = last ? nB : cB + (size_t)(t + 2) * kstep;
            const char* a3 = a2 + kstep; const char* b3 = b2 + kstep;
            if (last && has_next) S.a_ready(nxt);
            if constexpr (SP2) {
            PG8_LDB(B0, 0, 0); PG8_LDB(B1, 0, 1); PG8_SCHED; PG8_LDA(At, 0, 0); PG8_STAGE(PG8_SA(1, 1), a1 + hstep, voffA);
            PG8_WAIT_V(8); PG8_WAIT_L(0); PG8_BAR; PG8_MMA(0, 0, At, B0); PG8_MMA(0, 1, At, B1); PG8_BAR; PG8_SCHED;
            PG8_LDA(At, 0, 1); PG8_STAGE(PG8_SB(0, 0), b2, voffB); PG8_STAGE(PG8_SB(0, 1), b2 + hstep, voffB); PG8_STAGE(PG8_SA(0, 0), a2, voffA);
            PG8_WAIT_V(8); PG8_WAIT_L(0); PG8_BAR; PG8_MMA(1, 0, At, B0); PG8_MMA(1, 1, At, B1); PG8_BAR; PG8_SCHED;
            PG8_LDB(B0, 1, 0); PG8_LDB(B1, 1, 1); PG8_SCHED; PG8_LDA(At, 1, 0); PG8_STAGE(PG8_SA(0, 1), a2 + hstep, voffA);
            PG8_WAIT_V(8); PG8_WAIT_L(0); PG8_BAR; PG8_MMA(0, 0, At, B0); PG8_MMA(0, 1, At, B1); PG8_BAR; PG8_SCHED;
            PG8_LDA(At, 1, 1); PG8_STAGE(PG8_SB(1, 0), b3, voffB); PG8_STAGE(PG8_SB(1, 1), b3 + hstep, voffB); PG8_STAGE(PG8_SA(1, 0), a3, voffA);
            PG8_WAIT_V(8); PG8_WAIT_L(0); PG8_BAR; PG8_MMA(1, 0, At, B0); PG8_MMA(1, 1, At, B1); PG8_BAR; PG8_SCHED;
            } else {
            PG8_LDB(B0, 0, 0); PG8_SCHED; PG8_LDA(At, 0, 0); PG8_STAGE(PG8_SA(1, 1), a1 + hstep, voffA);
            PG8_WAIT_L(8); PG8_BAR; PG8_WAIT_L(0); PG8_MMA(0, 0, At, B0); PG8_BAR; PG8_SCHED;
            PG8_LDB(B1, 0, 1); PG8_STAGE(PG8_SB(0, 0), b2, voffB);
            PG8_BAR; PG8_WAIT_L(0); PG8_MMA(0, 1, At, B1); PG8_BAR;
            PG8_LDA(At, 0, 1); PG8_STAGE(PG8_SA(0, 0), a2, voffA);
            PG8_BAR; PG8_WAIT_L(0); PG8_MMA(1, 0, At, B0); PG8_BAR; PG8_SCHED;
            PG8_STAGE(PG8_SB(0, 1), b2 + hstep, voffB);
            PG8_WAIT_V(6); PG8_BAR; PG8_MMA(1, 1, At, B1); PG8_BAR;
            PG8_LDB(B0, 1, 0); PG8_SCHED; PG8_LDA(At, 1, 0); PG8_STAGE(PG8_SA(0, 1), a2 + hstep, voffA);
            PG8_WAIT_L(8); PG8_BAR; PG8_WAIT_L(0); PG8_MMA(0, 0, At, B0); PG8_BAR; PG8_SCHED;
            PG8_LDB(B1, 1, 1); PG8_STAGE(PG8_SB(1, 0), b3, voffB);
            PG8_BAR; PG8_WAIT_L(0); PG8_MMA(0, 1, At, B1); PG8_BAR;
            PG8_LDA(At, 1, 1); PG8_STAGE(PG8_SA(1, 0), a3, voffA);
            PG8_BAR; PG8_WAIT_L(0); PG8_MMA(1, 0, At, B0); PG8_BAR; PG8_SCHED;
            PG8_STAGE(PG8_SB(1, 1), b3 + hstep, voffB);
            PG8_WAIT_V(6); PG8_BAR; PG8_MMA(1, 1, At, B1); PG8_BAR;
            }
        }
        if constexpr (ALIGN_EPI) { if (wr == 0) PG8_BAR; }
        if constexpr (!Epi::AFTER_DRAIN) { E(acc, cur, wr, wc, fr, fq); S.done(cur); }
        if (!has_next) break;
#pragma unroll
        for (int a = 0; a < 2; ++a)
#pragma unroll
            for (int b = 0; b < 2; ++b)
#pragma unroll
                for (int m = 0; m < 4; ++m)
#pragma unroll
                    for (int n = 0; n < 2; ++n) acc[a][b][m][n] = (f32x4){0.f, 0.f, 0.f, 0.f};
        cur = nxt; cA = nA; cB = nB; ++ui;
        if constexpr (ALIGN_EPI) { if (wr == 1) PG8_BAR; }
    }
    PG8_WAIT_V(0);
    if constexpr (!ALIGN_EPI) { if (wr == 0) PG8_BAR; }
    PG8_BAR;
    if constexpr (Epi::AFTER_DRAIN) { E.fused(acc, cur, wr, wc, fr, fq, lds, wid, lane); S.done(cur); }
#undef PG8_SA
#undef PG8_SB
#undef PG8_STAGE
#undef PG8_LDA
#undef PG8_LDB
#undef PG8_MMA
#undef PG8_WAIT_V
#undef PG8_WAIT_L
#undef PG8_BAR
#undef PG8_SCHED
}
}
#define LAS __attribute__((address_space(3)))
#define XB_TMO      128
#define XB_XCNT(j)  (256  + 64 * (j))
#define XB_XSUB(j)  (1280 + 64 * (j))
#define XB_XGEN(j)  (2304 + 64 * (j))
#define XB_TOP      3328
#define XB_TOPGEN   3392
#define XCD_BAR_WORDS 3456
#define XB_SPIN_CAP (1u << 18)

__device__ __forceinline__ unsigned xb_ld(unsigned* p)              { return __hip_atomic_load(p, __ATOMIC_RELAXED, __HIP_MEMORY_SCOPE_AGENT); }
__device__ __forceinline__ unsigned xb_add(unsigned* p, unsigned v) { return __hip_atomic_fetch_add(p, v, __ATOMIC_RELAXED, __HIP_MEMORY_SCOPE_AGENT); }
__device__ __forceinline__ unsigned xb_xcc_id() { return (unsigned)__builtin_amdgcn_s_getreg((3 << 11) | 20) & 0xFu; }
#define XB_SPIN(cond, bar) do { unsigned _sp = 0; while (cond) { __builtin_amdgcn_s_sleep(1); \
    if ((++_sp & 255u) == 0u) { if (xb_ld(&(bar)[XB_TMO])) break; if (_sp > XB_SPIN_CAP) { atomicAdd(&(bar)[XB_TMO], 1u); break; } } } } while (0)

struct XcdBarrier {
    unsigned* bar; unsigned x;
    volatile LAS unsigned* st;
};

__device__ __forceinline__ XcdBarrier xcd_barrier_post(unsigned* bar, volatile LAS unsigned* st) {
    XcdBarrier b; b.bar = bar; b.x = xb_xcc_id(); b.st = st;
    if (threadIdx.x == 0) (void)xb_add(&bar[XB_XCNT(b.x)], 1u);
    return b;
}
__device__ __forceinline__ void xcd_barrier_complete(unsigned* bar, unsigned x, unsigned& nloc, unsigned& nx) {
    const unsigned G = gridDim.x * gridDim.y * gridDim.z;
    unsigned sum, cnt, mine, sp = 0u;
    for (;;) {
        sum = 0u; cnt = 0u; mine = 0u;
#pragma unroll
        for (unsigned j = 0; j < 16; ++j) { const unsigned c = xb_ld(&bar[XB_XCNT(j)]); sum += c; cnt += (c > 0u) ? 1u : 0u; mine = (j == x) ? c : mine; }
        if (sum == G) break;
        __builtin_amdgcn_s_sleep(1);
        if ((++sp & 255u) == 0u) { if (xb_ld(&bar[XB_TMO])) break; if (sp > XB_SPIN_CAP) { atomicAdd(&bar[XB_TMO], 1u); break; } }
    }
    nloc = mine > 0u ? mine : 1u; nx = cnt > 0u ? cnt : 1u;
}

__device__ __forceinline__ void xcd_barrier(const XcdBarrier& b) {
    asm volatile("s_waitcnt vmcnt(0)" ::: "memory");
    __syncthreads();
    if (threadIdx.x == 0) {
        unsigned* bar = b.bar;
        __builtin_amdgcn_s_waitcnt(0);
        unsigned nloc = b.st[0], nx = b.st[1];
        if (nloc == 0u) { xcd_barrier_complete(bar, b.x, nloc, nx); b.st[0] = nloc; b.st[1] = nx; }
        const unsigned old = xb_add(&bar[XB_XSUB(b.x)], 1u);
        const unsigned gen = old / nloc;
        if (old + 1u == (gen + 1u) * nloc) {
            __builtin_amdgcn_fence(__ATOMIC_RELEASE, "agent");
            asm volatile("s_waitcnt vmcnt(0)" ::: "memory");
            const unsigned og = xb_add(&bar[XB_TOP], 1u);
            const unsigned tg = og / nx;
            if (og + 1u == (tg + 1u) * nx) xb_add(&bar[XB_TOPGEN], 1u);
            else XB_SPIN(xb_ld(&bar[XB_TOPGEN]) == tg, bar);
            __builtin_amdgcn_fence(__ATOMIC_ACQUIRE, "agent");
            xb_add(&bar[XB_XGEN(b.x)], 1u);
            asm volatile("s_waitcnt vmcnt(0)" ::: "memory");
        } else {
            XB_SPIN(xb_ld(&bar[XB_XGEN(b.x)]) == gen, bar);
            __builtin_amdgcn_fence(__ATOMIC_ACQUIRE, "agent");
            asm volatile("s_waitcnt vmcnt(0)" ::: "memory");
        }
    }
    __syncthreads();
}

using pg8::bf16_t; using pg8::bf16x8; using pg8::f32x4; using pg8::u32x4;
using pg8::DM; using pg8::MP; using pg8::MS; using pg8::MT; using pg8::NIN; using pg8::DFF; using pg8::LDP; using pg8::SEQ; using pg8::DSEQ;
using pg8::NBATCH; using pg8::DBATCH; using pg8::DEPTH;
#define LAS __attribute__((address_space(3)))
typedef unsigned u32x2 __attribute__((ext_vector_type(2)));
typedef float f32x2 __attribute__((ext_vector_type(2)));

constexpr int NTHR = 512;
constexpr int LDS_BYTES = 147456;
constexpr size_t O_YP = 0, O_YS = (size_t)MP * DM, O_RETP = O_YS + (size_t)MS * DM, O_CONVP = O_RETP + (size_t)DEPTH * NBATCH * 4 * 16384,
                 O_RETS = O_CONVP + (size_t)DEPTH * NBATCH * 2 * 512, O_CONVS = O_RETS + (size_t)DEPTH * DBATCH * 4 * 16384;
constexpr size_t MiB = 1u << 20;
constexpr size_t WS_WIN = 0, WS_WOUT = 14 * MiB, WS_WUP = 18 * MiB, WS_WDN = 34 * MiB;
constexpr size_t WS_COS = 50 * MiB, WS_SIN = 51 * MiB, WS_SSP = 52 * MiB, WS_SSEG = 55 * MiB;
constexpr size_t WS_CTL = 54 * MiB + 512 * 1024;
constexpr int CTL_WORDS = 8192, CW_CNT = 4096;
constexpr size_t WS_XB = 71 * MiB;
constexpr size_t WS_PROJ = 136 * MiB;
constexpr size_t WS_MIX = WS_PROJ + (size_t)MT * LDP * 2;
constexpr size_t WS_H = WS_PROJ;
constexpr size_t WS_END = WS_MIX + (size_t)MT * DM * 2;
static_assert(WS_XB + (size_t)MT * DM * 2 <= WS_PROJ && WS_END <= 512 * MiB && WS_H + (size_t)MT * DFF * 2 <= WS_END, "ws map");

__device__ __forceinline__ float bf2f(unsigned b) { return __uint_as_float(b << 16); }
__device__ __forceinline__ unsigned pk2(float lo, float hi) { return pg8::cvt_pk_bf16(lo, hi); }
__device__ __forceinline__ float ex2(float x) { return __builtin_amdgcn_exp2f(x); }
__device__ __forceinline__ f32x4 mma(const bf16x8 x, const bf16x8 y, const f32x4 c) { return __builtin_amdgcn_mfma_f32_16x16x32_bf16(x, y, c, 0, 0, 0); }
__device__ __forceinline__ bf16x8 frag(LAS unsigned char* base, int row, int stride, int kg, int kb) { return *(const LAS bf16x8*)(base + row * stride + 16 * kg + 64 * kb); }

constexpr int R_Q = 0, R_K = 17408, R_KT = 34816, R_VT = 53248, R_SP = 71680, R_RT = 80896, R_ST = 115712;
constexpr int SQ = 272, ST = 144;
__device__ __forceinline__ void ret_item(LAS unsigned char* lds, const bf16_t* proj, bf16_t* mix, int row0, int nchunks, int CL, int h, float lg2, bool full,
                                         int rinit, const float* rsrc, int nprefix, float* rdst, const float* gnw) {
    int tid_o = threadIdx.x; asm volatile("" : "+v"(tid_o));
    const int tid = tid_o, w = __builtin_amdgcn_readfirstlane(tid >> 6), lane = tid & 63, j = lane & 15, ig = lane >> 4;
    f32x4 R[8];
#pragma unroll
    for (int dt = 0; dt < 8; ++dt) {
#pragma unroll
        for (int t = 0; t < 4; ++t) {
            const int idx = (16 * dt + 4 * ig + t) * 128 + 16 * w + j;
            float v = 0.f;
            if (rinit == 2) v = rsrc[idx];
            else if (rinit == 1) { for (int s = 0; s < nprefix; ++s) v += rsrc[(size_t)s * 16384 + idx] * ex2(lg2 * 512.f * (float)(nprefix - 1 - s)); }
            R[dt][t] = v;
        }
    }
    if (full) {
#pragma unroll
        for (int dt = 0; dt < 8; ++dt) { u32x2 p; p.x = pk2(R[dt][0], R[dt][1]); p.y = pk2(R[dt][2], R[dt][3]); *(LAS u32x2*)(lds + R_RT + (16 * w + j) * SQ + (16 * dt + 4 * ig) * 2) = p; }
    }
    const float cdec = ex2(lg2 * (float)CL);
    const float kdec = ex2(lg2 * (float)(CL - 1 - lane));
    u32x4 qreg[2], kreg[2], vreg[2];
    const u32x4 zero4 = (u32x4){0u, 0u, 0u, 0u};
#define RET_LOAD(c) do { _Pragma("unroll") for (int it = 0; it < 2; ++it) { \
        const int qm = (tid + NTHR * it) >> 4, qd = (tid + NTHR * it) & 15, kd = w + 8 * it; \
        const bf16_t* rb = proj + (size_t)(row0 + (c) * 64) * LDP + h * 128; \
        qreg[it] = (full && qm < CL) ? *(const u32x4*)(rb + (size_t)qm * LDP + 8 * qd) : zero4; \
        kreg[it] = (lane < CL) ? *(const u32x4*)(rb + (size_t)lane * LDP + 512 + 8 * kd) : zero4; \
        vreg[it] = (lane < CL) ? *(const u32x4*)(rb + (size_t)lane * LDP + 1024 + 8 * kd) : zero4; } } while (0)
    RET_LOAD(0);
    for (int c = 0; c < nchunks; ++c) {
#pragma unroll
        for (int it = 0; it < 2; ++it) {
            const int qm = (tid + NTHR * it) >> 4, qd = (tid + NTHR * it) & 15, kd = w + 8 * it;
            if (full) { *(LAS u32x4*)(lds + R_Q + qm * SQ + 16 * qd) = qreg[it]; *(LAS u32x4*)(lds + R_K + lane * SQ + 16 * kd) = kreg[it]; }
#pragma unroll
            for (int e = 0; e < 4; ++e) {
                const unsigned kw = kreg[it][e], vw = vreg[it][e];
                const unsigned kp = pk2(bf2f(kw & 0xffffu) * kdec, bf2f(kw >> 16) * kdec);
                *(LAS unsigned short*)(lds + R_KT + (8 * kd + 2 * e) * ST + 2 * lane) = (unsigned short)(kp & 0xffffu);
                *(LAS unsigned short*)(lds + R_KT + (8 * kd + 2 * e + 1) * ST + 2 * lane) = (unsigned short)(kp >> 16);
                *(LAS unsigned short*)(lds + R_VT + (8 * kd + 2 * e) * ST + 2 * lane) = (unsigned short)(vw & 0xffffu);
                *(LAS unsigned short*)(lds + R_VT + (8 * kd + 2 * e + 1) * ST + 2 * lane) = (unsigned short)(vw >> 16);
            }
        }
        if (c + 1 < nchunks) RET_LOAD(c + 1);
        __syncthreads();
        f32x4 o[4];
        if (full) {
            const int mt = w & 3;
#pragma unroll
            for (int q2 = 0; q2 < 2; ++q2) {
                const int nt = 2 * (w >> 2) + q2;
                f32x4 s = (f32x4){0.f, 0.f, 0.f, 0.f};
#pragma unroll
                for (int kb = 0; kb < 4; ++kb) s = mma(frag(lds + R_K, 16 * mt + j, SQ, ig, kb), frag(lds + R_Q, 16 * nt + j, SQ, ig, kb), s);
                const int n = 16 * nt + j, m0 = 16 * mt + 4 * ig;
#pragma unroll
                for (int t = 0; t < 4; ++t) { const int df = n - (m0 + t); s[t] = df >= 0 ? s[t] * ex2(lg2 * (float)df) : 0.f; }
                u32x2 p; p.x = pk2(s[0], s[1]); p.y = pk2(s[2], s[3]);
                *(LAS u32x2*)(lds + R_SP + n * ST + m0 * 2) = p;
            }
            __syncthreads();
            bf16x8 rt[4], vt[2];
#pragma unroll
            for (int kb = 0; kb < 4; ++kb) rt[kb] = frag(lds + R_RT, 16 * w + j, SQ, ig, kb);
#pragma unroll
            for (int kb = 0; kb < 2; ++kb) vt[kb] = frag(lds + R_VT, 16 * w + j, ST, ig, kb);
#pragma unroll
            for (int nt = 0; nt < 4; ++nt) {
                f32x4 a = (f32x4){0.f, 0.f, 0.f, 0.f}, b = (f32x4){0.f, 0.f, 0.f, 0.f};
#pragma unroll
                for (int kb = 0; kb < 4; ++kb) a = mma(rt[kb], frag(lds + R_Q, 16 * nt + j, SQ, ig, kb), a);
#pragma unroll
                for (int kb = 0; kb < 2; ++kb) b = mma(vt[kb], frag(lds + R_SP, 16 * nt + j, ST, ig, kb), b);
                const float qd = ex2(lg2 * (float)(16 * nt + j + 1));
                o[nt] = b + a * qd;
                float s1 = (o[nt][0] + o[nt][1]) + (o[nt][2] + o[nt][3]);
                float s2 = (o[nt][0] * o[nt][0] + o[nt][1] * o[nt][1]) + (o[nt][2] * o[nt][2] + o[nt][3] * o[nt][3]);
                s1 += __shfl_xor(s1, 16); s1 += __shfl_xor(s1, 32); s2 += __shfl_xor(s2, 16); s2 += __shfl_xor(s2, 32);
                if (ig == 0) *(LAS f32x2*)(lds + R_ST + ((16 * nt + j) * 8 + w) * 8) = (f32x2){s1, s2};
            }
        }
        {
            bf16x8 vt[2];
#pragma unroll
            for (int kb = 0; kb < 2; ++kb) vt[kb] = frag(lds + R_VT, 16 * w + j, ST, ig, kb);
#pragma unroll
            for (int dt = 0; dt < 8; ++dt) {
                R[dt] = R[dt] * cdec;
#pragma unroll
                for (int kb = 0; kb < 2; ++kb) R[dt] = mma(frag(lds + R_KT, 16 * dt + j, ST, ig, kb), vt[kb], R[dt]);
            }
        }
        if (full && c + 1 < nchunks) {
#pragma unroll
            for (int dt = 0; dt < 8; ++dt) { u32x2 p; p.x = pk2(R[dt][0], R[dt][1]); p.y = pk2(R[dt][2], R[dt][3]); *(LAS u32x2*)(lds + R_RT + (16 * w + j) * SQ + (16 * dt + 4 * ig) * 2) = p; }
        }
        __syncthreads();
        if (full) {
            const f32x4 gw = *(const f32x4*)(gnw + h * 128 + 16 * w + 4 * ig);
#pragma unroll
            for (int nt = 0; nt < 4; ++nt) {
                const int n = 16 * nt + j;
                if (n < CL) {
                    const LAS f32x4* sp = (const LAS f32x4*)(lds + R_ST + n * 64);
                    const f32x4 p0 = sp[0], p1 = sp[1], p2 = sp[2], p3 = sp[3];
                    const float s1 = (p0[0] + p0[2]) + (p1[0] + p1[2]) + (p2[0] + p2[2]) + (p3[0] + p3[2]);
                    const float s2 = (p0[1] + p0[3]) + (p1[1] + p1[3]) + (p2[1] + p2[3]) + (p3[1] + p3[3]);
                    const float mean = s1 * (1.0f / 128.0f);
                    const float var = fmaxf(s2 * (1.0f / 128.0f) - mean * mean, 0.f);
                    const float rstd = __builtin_amdgcn_rsqf(var + pg8::GN_EPS);
                    const size_t row = (size_t)(row0 + c * 64 + n);
                    const u32x2 sg = *(const u32x2*)(proj + row * LDP + 1536 + h * 128 + 16 * w + 4 * ig);
                    const float g0 = bf2f(sg.x & 0xffffu), g1 = bf2f(sg.x >> 16), g2 = bf2f(sg.y & 0xffffu), g3 = bf2f(sg.y >> 16);
                    u32x2 p;
                    p.x = pk2((o[nt][0] - mean) * rstd * gw[0] * g0, (o[nt][1] - mean) * rstd * gw[1] * g1);
                    p.y = pk2((o[nt][2] - mean) * rstd * gw[2] * g2, (o[nt][3] - mean) * rstd * gw[3] * g3);
                    *(u32x2*)(mix + row * DM + h * 128 + 16 * w + 4 * ig) = p;
                }
            }
        }
    }
#undef RET_LOAD
    if (rdst) {
#pragma unroll
        for (int dt = 0; dt < 8; ++dt)
#pragma unroll
            for (int t = 0; t < 4; ++t) rdst[(16 * dt + 4 * ig + t) * 128 + 16 * w + j] = R[dt][t];
    }
    __syncthreads();
}
__device__ __forceinline__ float head_lg2(int h) { return h == 0 ? -0.04580368961312479f : h == 1 ? -0.02272007650008353f : h == 2 ? -0.011315313227834146f : -0.005646563141142063f; }

__device__ __forceinline__ void conv_phase(const bf16_t* proj, bf16_t* mix, const float* conv_w  , const float* sconv  , int gtid, int nthr) {
    const int nitems = (MT / 16) * 64;
    for (int it = gtid; it < nitems; it += nthr) {
        const int co = it & 63, rb = it >> 6, r0 = rb * 16, c0 = co * 8;
        float w0[8], w1[8], w2[8], um2[8], um1[8];
#pragma unroll
        for (int e = 0; e < 8; ++e) { w0[e] = conv_w[(c0 + e) * 3 + 0]; w1[e] = conv_w[(c0 + e) * 3 + 1]; w2[e] = conv_w[(c0 + e) * 3 + 2]; }
        const bool seq_start = r0 < MP ? ((r0 & (SEQ - 1)) == 0) : true;
        if (seq_start) {
            if (r0 < MP) {
#pragma unroll
                for (int e = 0; e < 8; ++e) { um2[e] = 0.f; um1[e] = 0.f; }
            } else {
                const float* sb = sconv + (size_t)((r0 - MP) >> 4) * 1024 + c0;
#pragma unroll
                for (int e = 0; e < 8; ++e) { um2[e] = sb[e]; um1[e] = sb[512 + e]; }
            }
        } else {
            const u32x4 a = *(const u32x4*)(proj + (size_t)(r0 - 2) * LDP + 2560 + c0), b = *(const u32x4*)(proj + (size_t)(r0 - 1) * LDP + 2560 + c0);
#pragma unroll
            for (int e = 0; e < 4; ++e) { um2[2 * e] = bf2f(a[e] & 0xffffu); um2[2 * e + 1] = bf2f(a[e] >> 16); um1[2 * e] = bf2f(b[e] & 0xffffu); um1[2 * e + 1] = bf2f(b[e] >> 16); }
        }
#pragma unroll 4
        for (int i = 0; i < 16; ++i) {
            const size_t row = (size_t)(r0 + i);
            const u32x4 uu = *(const u32x4*)(proj + row * LDP + 2560 + c0), bb = *(const u32x4*)(proj + row * LDP + 2048 + c0);
            float res[8];
#pragma unroll
            for (int e = 0; e < 4; ++e) {
                const float u0 = bf2f(uu[e] & 0xffffu), u1 = bf2f(uu[e] >> 16), b0 = bf2f(bb[e] & 0xffffu), b1 = bf2f(bb[e] >> 16);
                res[2 * e] = b0 * (w0[2 * e] * um2[2 * e] + w1[2 * e] * um1[2 * e] + w2[2 * e] * u0);
                res[2 * e + 1] = b1 * (w0[2 * e + 1] * um2[2 * e + 1] + w1[2 * e + 1] * um1[2 * e + 1] + w2[2 * e + 1] * u1);
                um2[2 * e] = um1[2 * e]; um1[2 * e] = u0; um2[2 * e + 1] = um1[2 * e + 1]; um1[2 * e + 1] = u1;
            }
            u32x4 o; o.x = pk2(res[0], res[1]); o.y = pk2(res[2], res[3]); o.z = pk2(res[4], res[5]); o.w = pk2(res[6], res[7]);
            *(u32x4*)(mix + row * DM + 512 + c0) = o;
        }
    }
}

__device__ __forceinline__ void conv_weight(const float* W, int K, int N, bf16_t* Wt, const float* ksc, int mode, int gtid, int nthr) {
    const int nitems = (K / 8) * N;
    for (int it = gtid; it < nitems; it += nthr) {
        const int ko = it / N, np = it - ko * N, k0 = ko * 8;
        int col = np; float cs = 1.f;
        if (mode == 1) {
            const int pn = np >> 8, bj = (np >> 7) & 1, t = np & 127;
            if (pn < 4) { col = (pn < 2 ? 0 : 512) + 128 * (2 * (pn & 1) + (t >> 6)) + 64 * bj + (t & 63); if (pn >= 2) cs = 0.08838834764831845f; }
            else if (pn >= 10) col = (bj ? 3072 : 2560) + 128 * (pn - 10) + t;
        }
        float v[8];
#pragma unroll
        for (int e = 0; e < 8; ++e) v[e] = W[(size_t)(k0 + e) * N + col] * (ksc ? ksc[k0 + e] : 1.f) * cs;
        u32x4 o; o.x = pk2(v[0], v[1]); o.y = pk2(v[2], v[3]); o.z = pk2(v[4], v[5]); o.w = pk2(v[6], v[7]);
        *(u32x4*)(Wt + (size_t)np * K + k0) = o;
    }
}
__device__ __forceinline__ float wave_sum(float v) {
#pragma unroll
    for (int o = 1; o < 64; o <<= 1) v += __shfl_xor(v, o);
    return v;
}

struct Args { const float* in[13]; float* out; unsigned char* ws; };

__global__ void __launch_bounds__(NTHR, 2) hymba_fwd(Args args) {
    extern __shared__ __attribute__((aligned(16))) unsigned char lds_raw[];
    LAS unsigned char* lds = (LAS unsigned char*)lds_raw;
    cg::grid_group grid = cg::this_grid();
    const int tid = threadIdx.x, lane = tid & 63, wave = __builtin_amdgcn_readfirstlane(tid >> 6);
    const int G = gridDim.x, bx = blockIdx.x;
    const int gtid = bx * NTHR + tid, nthr = G * NTHR, gw = bx * 8 + wave, ngw = G * 8;
    unsigned char* ws = args.ws;
    const float* x_prompt = args.in[0]; const float* x_sample = args.in[1]; const float* state_ret = args.in[2]; const float* state_conv = args.in[3];
    const float* ln1_w = args.in[4]; const float* w_in = args.in[5]; const float* conv_w = args.in[6]; const float* ret_norm_w = args.in[7];
    const float* w_out = args.in[8]; const float* ln2_w = args.in[9]; const float* w_up = args.in[10]; const float* w_dn = args.in[11]; const float* ln_f_w = args.in[12];
    float* out = args.out;
    bf16_t* WtIn = (bf16_t*)(ws + WS_WIN); bf16_t* WtOut = (bf16_t*)(ws + WS_WOUT); bf16_t* WtUp = (bf16_t*)(ws + WS_WUP); bf16_t* WtDn = (bf16_t*)(ws + WS_WDN);
    float* rcos = (float*)(ws + WS_COS); float* rsin = (float*)(ws + WS_SIN); float* ssp = (float*)(ws + WS_SSP); float* sseg = (float*)(ws + WS_SSEG);
    bf16_t* xb = (bf16_t*)(ws + WS_XB); bf16_t* proj = (bf16_t*)(ws + WS_PROJ); bf16_t* mix = (bf16_t*)(ws + WS_MIX); bf16_t* Hb = (bf16_t*)(ws + WS_H);
    unsigned* ctl = (unsigned*)(ws + WS_CTL);
    volatile LAS unsigned* MISC = (volatile LAS unsigned*)(lds + 131072 + 512);
    if (tid < 64) MISC[tid] = 0u;
    if (bx == 0) { for (int i = tid; i < CTL_WORDS; i += NTHR) ctl[i] = 0u; }
    __syncthreads();
    float* X = out;

#pragma unroll 1
    for (int l = 0; l < DEPTH; ++l) {
        conv_weight(w_in + (size_t)l * DM * NIN, DM, NIN, WtIn + (size_t)l * NIN * DM, ln1_w + l * DM, 1, gtid, nthr);
        conv_weight(w_out + (size_t)l * DM * DM, DM, DM, WtOut + (size_t)l * DM * DM, nullptr, 0, gtid, nthr);
        conv_weight(w_up + (size_t)l * DM * DFF, DM, DFF, WtUp + (size_t)l * DFF * DM, ln2_w + l * DM, 0, gtid, nthr);
        conv_weight(w_dn + (size_t)l * DFF * DM, DFF, DM, WtDn + (size_t)l * DM * DFF, nullptr, 0, gtid, nthr);
    }
    for (int it = gtid; it < SEQ * 64; it += nthr) {
        const int pos = it >> 6, i = it & 63;
        const float inv = ex2(-(float)i * (13.287712379549449f / 64.0f));
        const float ang = (float)pos * inv;
        const double rev = (double)ang * 0.15915494309189535;
        const float fr = (float)(rev - __builtin_floor(rev));
        rcos[it] = __builtin_amdgcn_cosf(fr); rsin[it] = __builtin_amdgcn_sinf(fr);
    }
    for (int r = gw; r < MT; r += ngw) {
        const float* xr = r < MP ? x_prompt + (size_t)r * DM : x_sample + (size_t)(r - MP) * DM;
        float s = 0.f;
#pragma unroll
        for (int q = 0; q < 4; ++q) {
            const f32x4 v = *(const f32x4*)(xr + 256 * q + 4 * lane);
            u32x2 p; p.x = pk2(v[0], v[1]); p.y = pk2(v[2], v[3]);
            *(u32x2*)(xb + (size_t)r * DM + 256 * q + 4 * lane) = p;
            s += (v[0] * v[0] + v[1] * v[1]) + (v[2] * v[2] + v[3] * v[3]);
        }
        s = wave_sum(s);
        if (lane < 16) ssp[(size_t)r * 16 + lane] = lane == 0 ? s : 0.f;
    }
    grid.sync();
    XcdBarrier bar = xcd_barrier_post(ctl, MISC + 8);

#pragma unroll 1
    for (int l = 0; l < DEPTH; ++l) {
        {
            pg8::Gemm g{xb, WtIn + (size_t)l * NIN * DM, MT, NIN, DM}; pg8::StaticOrder S; S.init(MT, NIN, G, bx);
            pg8::EpiIn E{proj, ssp, rcos, rsin, out + O_CONVP + (size_t)l * NBATCH * 1024, out + O_CONVS + (size_t)l * DBATCH * 1024};
            pg8::gemm_phase<pg8::EpiIn, pg8::StaticOrder, true, true>(lds, g, S, E);
        }
        xcd_barrier(bar);
        for (int it = bx; it < 288; it += G) {
            if (it < 224) {
                const int b = it / 28, rem = it - b * 28, h = rem / 7, sg = rem - h * 7;
                ret_item(lds, proj, mix, b * SEQ + sg * 512, 8, 64, h, head_lg2(h), false, 0, nullptr, 0, sseg + (size_t)((b * 4 + h) * 8 + sg) * 16384, nullptr);
            } else {
                const int si = it - 224, b = si >> 2, h = si & 3;
                ret_item(lds, proj, mix, MP + b * DSEQ, 1, DSEQ, h, head_lg2(h), true, 2, state_ret + (size_t)((l * DBATCH + b) * 4 + h) * 16384, 0,
                         out + O_RETS + (size_t)((l * DBATCH + b) * 4 + h) * 16384, ret_norm_w + l * 512);
            }
        }
        conv_phase(proj, mix, conv_w + (size_t)l * 512 * 3, state_conv + (size_t)l * DBATCH * 1024, gtid, nthr);
        xcd_barrier(bar);
        for (int it = bx; it < 256; it += G) {
            const int b = it >> 5, h = (it >> 3) & 3, sg = it & 7;
            ret_item(lds, proj, mix, b * SEQ + sg * 512, 8, 64, h, head_lg2(h), true, sg > 0 ? 1 : 0, sseg + (size_t)((b * 4 + h) * 8) * 16384, sg,
                     sg == 7 ? out + O_RETP + (size_t)((l * NBATCH + b) * 4 + h) * 16384 : nullptr, ret_norm_w + l * 512);
        }
        xcd_barrier(bar);
        {
            pg8::Gemm g{mix, WtOut + (size_t)l * DM * DM, MT, DM, DM}; pg8::StaticOrder S; S.init(MT, DM, G, bx);
            pg8::EpiRes E{l == 0 ? x_prompt : X, l == 0 ? x_sample : X + (size_t)MP * DM, X, xb, ssp};
            pg8::gemm_phase<pg8::EpiRes, pg8::StaticOrder, true, true>(lds, g, S, E);
        }
        xcd_barrier(bar);
        {
            pg8::Gemm g{xb, WtUp + (size_t)l * DFF * DM, MT, DFF, DM}; pg8::StaticOrder S; S.init(MT, DFF, G, bx);
            pg8::EpiUp E{Hb, ssp};
            pg8::gemm_phase<pg8::EpiUp, pg8::StaticOrder, true, true>(lds, g, S, E);
        }
        xcd_barrier(bar);
        {
            pg8::Gemm g{Hb, WtDn + (size_t)l * DM * DFF, MT, DM, DFF}; pg8::StaticOrder S; S.init(MT, DM, G, bx);
            pg8::EpiRes E{X, X + (size_t)MP * DM, X, xb, ssp};
            pg8::gemm_phase<pg8::EpiRes, pg8::StaticOrder, true, true>(lds, g, S, E);
        }
        xcd_barrier(bar);
    }
    for (int r = gw; r < MT; r += ngw) {
        const float rs = pg8::row_rstd(ssp, r);
        float* xr = X + (size_t)r * DM;
#pragma unroll
        for (int q = 0; q < 4; ++q) {
            const f32x4 v = *(const f32x4*)(xr + 256 * q + 4 * lane), wv = *(const f32x4*)(ln_f_w + 256 * q + 4 * lane);
            *(f32x4*)(xr + 256 * q + 4 * lane) = v * rs * wv;
        }
    }
}

extern "C" void kernel_launch(void* const* d_in, const int* in_sizes, int n_in, void* d_out, int out_size, void* d_ws, size_t ws_size, hipStream_t stream) {
    static int grid = 0;
    if (grid == 0) {
        int dev = 0, cus = 0, per_cu = 0;
        if (n_in != 13 || ws_size < WS_END) { fprintf(stderr, "kernel_launch: unexpected n_in %d / ws_size %zu (need %zu)\n", n_in, ws_size, (size_t)WS_END); grid = -1; return; }
        hipGetDevice(&dev);
        hipDeviceGetAttribute(&cus, hipDeviceAttributeMultiprocessorCount, dev);
        hipFuncSetAttribute((const void*)hymba_fwd, hipFuncAttributeMaxDynamicSharedMemorySize, LDS_BYTES);
        hipOccupancyMaxActiveBlocksPerMultiprocessor(&per_cu, (const void*)hymba_fwd, NTHR, LDS_BYTES);
        if (per_cu < 1) { fprintf(stderr, "kernel_launch: occupancy query says %d blocks/CU\n", per_cu); per_cu = 1; }
        (void)hipGetLastError();
        grid = cus;
    }
    if (grid < 0) return;
    Args a{};
    for (int i = 0; i < 13; ++i) a.in[i] = (const float*)d_in[i];
    a.out = (float*)d_out; a.ws = (unsigned char*)d_ws;
    void* kargs[] = {&a};
    hipError_t e = hipLaunchCooperativeKernel((const void*)hymba_fwd, dim3(grid), dim3(NTHR), kargs, LDS_BYTES, stream);
    if (e != hipSuccess) fprintf(stderr, "cooperative launch failed: %s (grid %d)\n", hipGetErrorString(e), grid);
}
```

```cpp
#include <hip/hip_runtime.h>
#include <hip/hip_cooperative_groups.h>
#include <cstdio>
#include <cstdint>
namespace cg = cooperative_groups;
namespace pg8 {
#define PG8_LAS __attribute__((address_space(3)))
typedef unsigned short bf16_t;
typedef short bf16x8 __attribute__((ext_vector_type(8)));
typedef float f32x4 __attribute__((ext_vector_type(4)));
typedef unsigned u32x4 __attribute__((ext_vector_type(4)));
constexpr int BM = 256, BK = 64, HALF = 128, HTB = HALF * BK * 2  , STAGE_BYTES = 8 * HTB, NXCD = 8, WGM = 8;

__host__ __device__ __forceinline__ int lds_byte(int r, int c) { const int st = (r >> 4) * 2 + (c >> 5), rr = r & 15, cc = c & 31, ob = rr * 64 + cc * 2; return st * 1024 + (ob ^ (((ob >> 9) & 1) << 5)); }
__host__ __device__ __forceinline__ void stage_rc(int b, int& R, int& C) { const int st = b / 1024, sb = b % 1024, swz = sb ^ (((sb >> 9) & 1) << 5); R = (st >> 1) * 16 + swz / 64; C = (st & 1) * 32 + (swz % 64) / 2; }
__host__ __device__ __forceinline__ int perm32(int rho) { const int n = rho >> 4, i = rho & 15; return 8 * (i >> 2) + 4 * n + (i & 3); }

struct Unit { int pm, pn; };
struct Gemm { const bf16_t* A; const bf16_t* Bt; int M, N, K, Kloop; };

struct StaticOrder {
    int nM, nN, nwg, G, c;
    __host__ __device__ __forceinline__ void init(int M, int N, int G_, int c_) { nM = M / BM; nN = N / BM; nwg = nM * nN; G = G_; c = c_; }
    __host__ __device__ __forceinline__ void map(int L, int& pm, int& pn) const {
        int wgid = L; { const int q = nwg / NXCD, r = nwg % NXCD, xcd = wgid % NXCD, off = wgid / NXCD; wgid = (xcd < r ? xcd * (q + 1) : r * (q + 1) + (xcd - r) * q) + off; }
        const int nig = WGM * nN, gid = wgid / nig, fm = gid * WGM, gsz = (nM - fm) < WGM ? (nM - fm) : WGM;
        pm = fm + ((wgid % nig) % gsz); pn = (wgid % nig) / gsz;
    }
    __host__ __device__ __forceinline__ bool next(int i, Unit& u) const {
        const long L = (long)i * G + c; if (L >= nwg) return false;
        int wgid = (int)L; { const int q = nwg / NXCD, r = nwg % NXCD, xcd = wgid % NXCD, off = wgid / NXCD; wgid = (xcd < r ? xcd * (q + 1) : r * (q + 1) + (xcd - r) * q) + off; }
        const int nig = WGM * nN, gid = wgid / nig, fm = gid * WGM, gsz = (nM - fm) < WGM ? (nM - fm) : WGM;
        u.pm = fm + ((wgid % nig) % gsz); u.pn = (wgid % nig) / gsz; return true;
    }
    __device__ __forceinline__ void a_ready(const Unit&) const {}
    __device__ __forceinline__ void done(const Unit&) const {}
};

__device__ __forceinline__ unsigned cvt_pk_bf16(float lo, float hi) { unsigned r; asm volatile("v_cvt_pk_bf16_f32 %0, %1, %2" : "=v"(r) : "v"(lo), "v"(hi)); return r; }
typedef float f32x2 __attribute__((ext_vector_type(2)));

constexpr int DM = 1024, NBATCH = 8, SEQ = 4096, DEPTH = 2, DBATCH = 16, DSEQ = 16, PAST = 2048;
constexpr int MP = NBATCH * SEQ, MS = DBATCH * DSEQ, MT = MP + MS;
constexpr int NIN = 3584, DFF = 4096, LDP = 3072;
constexpr float RMS_EPS = 1e-6f, GN_EPS = 1e-5f;

__device__ __forceinline__ void store8bf(bf16_t* p, const f32x4 a, const f32x4 b) {
    u32x4 w; w.x = cvt_pk_bf16(a[0], a[1]); w.y = cvt_pk_bf16(a[2], a[3]); w.z = cvt_pk_bf16(b[0], b[1]); w.w = cvt_pk_bf16(b[2], b[3]);
    *(u32x4*)p = w;
}
__device__ __forceinline__ float row_rstd(const float* ssp, int r) {
    const f32x4* sp = (const f32x4*)(ssp + (size_t)r * 16);
    const f32x4 s0 = sp[0], s1 = sp[1], s2 = sp[2], s3 = sp[3];
    const f32x4 s = (s0 + s1) + (s2 + s3);
    const float tot = (s[0] + s[1]) + (s[2] + s[3]);
    return __builtin_amdgcn_rsqf(tot * (1.0f / DM) + RMS_EPS);
}
__device__ __forceinline__ float silu_f(float x) { return x * __builtin_amdgcn_rcpf(1.0f + __builtin_amdgcn_exp2f(-1.4426950408889634f * x)); }

struct EpiIn {
    static constexpr bool PERM = true, AFTER_DRAIN = false;
    bf16_t* proj; const float* ssp; const float* rcos; const float* rsin; float* nconv_p; float* nconv_s;
    __device__ __forceinline__ void operator()(f32x4 (&acc)[2][2][4][2], const Unit& u, int wr, int wc, int fr, int fq) const {
        const int pn = u.pn, tcol = wc * 32 + 8 * fq;
#pragma unroll
        for (int ai = 0; ai < 2; ++ai)
#pragma unroll
            for (int m = 0; m < 4; ++m) {
                const int r = u.pm * BM + ai * HALF + wr * 64 + m * 16 + fr;
                const float rs = row_rstd(ssp, r);
                const f32x4 a0 = acc[ai][0][m][0] * rs, a1 = acc[ai][0][m][1] * rs, b0 = acc[ai][1][m][0] * rs, b1 = acc[ai][1][m][1] * rs;
                bf16_t* prow = proj + (size_t)r * LDP;
                if (pn < 4) {
                    const int pos = r < MP ? (r & (SEQ - 1)) : PAST + (r & (DSEQ - 1));
                    const int i0 = 32 * (wc & 1) + 8 * fq;
                    const f32x4 c0 = *(const f32x4*)(rcos + pos * 64 + i0), c1 = *(const f32x4*)(rcos + pos * 64 + i0 + 4);
                    const f32x4 s0 = *(const f32x4*)(rsin + pos * 64 + i0), s1 = *(const f32x4*)(rsin + pos * 64 + i0 + 4);
                    const f32x4 o10 = a0 * c0 - b0 * s0, o11 = a1 * c1 - b1 * s1, o20 = a0 * s0 + b0 * c0, o21 = a1 * s1 + b1 * c1;
                    const int dcol = (pn < 2 ? 0 : 512) + 128 * (2 * (pn & 1) + (wc >> 1)) + i0;
                    store8bf(prow + dcol, o10, o11); store8bf(prow + dcol + 64, o20, o21);
                } else if (pn < 10) {
                    f32x4 x0 = a0, x1 = a1, y0 = b0, y1 = b1;
                    if (pn == 6 || pn == 7) {
#pragma unroll
                        for (int e = 0; e < 4; ++e) { x0[e] = silu_f(x0[e]); x1[e] = silu_f(x1[e]); y0[e] = silu_f(y0[e]); y1[e] = silu_f(y1[e]); }
                    }
                    const int dcol = 256 * pn + tcol;
                    store8bf(prow + dcol, x0, x1); store8bf(prow + dcol + 128, y0, y1);
                } else {
                    const f32x4 u0 = a0 * b0, u1 = a1 * b1;
                    const int cc = 128 * (pn - 10) + tcol;
                    store8bf(prow + 2560 + cc, u0, u1);
                    if (r < MP) { const int t = r & (SEQ - 1); if (t >= SEQ - 2) { float* d = nconv_p + (size_t)((r >> 12) * 2 + (t - (SEQ - 2))) * 512 + cc; *(f32x4*)d = u0; *(f32x4*)(d + 4) = u1; } }
                    else { const int t = r & (DSEQ - 1); if (t >= DSEQ - 2) { float* d = nconv_s + (size_t)(((r - MP) >> 4) * 2 + (t - (DSEQ - 2))) * 512 + cc; *(f32x4*)d = u0; *(f32x4*)(d + 4) = u1; } }
                }
            }
    }
};
struct EpiRes {
    static constexpr bool PERM = false, AFTER_DRAIN = false;
    const float* xs_main; const float* xs_tail; float* X; bf16_t* xb; float* ssp;
    __device__ __forceinline__ void operator()(f32x4 (&acc)[2][2][4][2], const Unit& u, int wr, int wc, int fr, int fq) const {
        typedef unsigned u32x2v __attribute__((ext_vector_type(2)));
#pragma unroll
        for (int ai = 0; ai < 2; ++ai)
#pragma unroll
            for (int m = 0; m < 4; ++m) {
                const int r = u.pm * BM + ai * HALF + wr * 64 + m * 16 + fr;
                const float* xs = r < MP ? xs_main + (size_t)r * DM : xs_tail + (size_t)(r - MP) * DM;
                float ss = 0.f;
#pragma unroll
                for (int bj = 0; bj < 2; ++bj)
#pragma unroll
                    for (int n = 0; n < 2; ++n) {
                        const int c = u.pn * BM + bj * HALF + wc * 32 + n * 16 + 4 * fq;
                        const f32x4 v = *(const f32x4*)(xs + c) + acc[ai][bj][m][n];
                        *(f32x4*)(X + (size_t)r * DM + c) = v;
                        u32x2v w; w.x = cvt_pk_bf16(v[0], v[1]); w.y = cvt_pk_bf16(v[2], v[3]);
                        *(u32x2v*)(xb + (size_t)r * DM + c) = w;
                        ss += (v[0] * v[0] + v[1] * v[1]) + (v[2] * v[2] + v[3] * v[3]);
                    }
                ss += __shfl_xor(ss, 16); ss += __shfl_xor(ss, 32);
                if (fq == 0) ssp[(size_t)r * 16 + 4 * u.pn + wc] = ss;
            }
    }
};
struct EpiUp {
    static constexpr bool PERM = true, AFTER_DRAIN = false;
    bf16_t* H; const float* ssp;
    __device__ __forceinline__ void operator()(f32x4 (&acc)[2][2][4][2], const Unit& u, int wr, int wc, int fr, int fq) const {
#pragma unroll
        for (int ai = 0; ai < 2; ++ai)
#pragma unroll
            for (int m = 0; m < 4; ++m) {
                const int r = u.pm * BM + ai * HALF + wr * 64 + m * 16 + fr;
                const float rs = row_rstd(ssp, r);
                bf16_t* hrow = H + (size_t)r * DFF + u.pn * BM + wc * 32 + 8 * fq;
#pragma unroll
                for (int bj = 0; bj < 2; ++bj) {
                    f32x4 v0 = acc[ai][bj][m][0] * rs, v1 = acc[ai][bj][m][1] * rs;
#pragma unroll
                    for (int e = 0; e < 4; ++e) { const float p = fmaxf(v0[e], 0.f), q = fmaxf(v1[e], 0.f); v0[e] = p * p; v1[e] = q * q; }
                    store8bf(hrow + bj * HALF, v0, v1);
                }
            }
    }
};

struct SliceOrder {
    int first, nN, c;
    __device__ __forceinline__ bool next(int i, Unit& u) const { const int idx = c - first; u.pm = MP / BM; u.pn = idx; return i == 0 && idx >= 0 && idx < nN; }
    __device__ __forceinline__ void a_ready(const Unit&) const {}
    __device__ __forceinline__ void done(const Unit&) const {}
};
__device__ __forceinline__ void ld16_coh(const f32x4* p, f32x4 (&t)[16]) {
    const f32x4 *p0 = p, *p1 = p + 256, *p2 = p + 512, *p3 = p + 768;
    asm volatile(
        "global_load_dwordx4 %0, %16, off sc1\n\tglobal_load_dwordx4 %1, %16, off offset:1024 sc1\n\tglobal_load_dwordx4 %2, %16, off offset:2048 sc1\n\tglobal_load_dwordx4 %3, %16, off offset:3072 sc1\n\t"
        "global_load_dwordx4 %4, %17, off sc1\n\tglobal_load_dwordx4 %5, %17, off offset:1024 sc1\n\tglobal_load_dwordx4 %6, %17, off offset:2048 sc1\n\tglobal_load_dwordx4 %7, %17, off offset:3072 sc1\n\t"
        "global_load_dwordx4 %8, %18, off sc1\n\tglobal_load_dwordx4 %9, %18, off offset:1024 sc1\n\tglobal_load_dwordx4 %10, %18, off offset:2048 sc1\n\tglobal_load_dwordx4 %11, %18, off offset:3072 sc1\n\t"
        "global_load_dwordx4 %12, %19, off sc1\n\tglobal_load_dwordx4 %13, %19, off offset:1024 sc1\n\tglobal_load_dwordx4 %14, %19, off offset:2048 sc1\n\tglobal_load_dwordx4 %15, %19, off offset:3072 sc1\n\t"
        "s_waitcnt vmcnt(0)"
        : "=&v"(t[0]), "=&v"(t[1]), "=&v"(t[2]), "=&v"(t[3]), "=&v"(t[4]), "=&v"(t[5]), "=&v"(t[6]), "=&v"(t[7]),
          "=&v"(t[8]), "=&v"(t[9]), "=&v"(t[10]), "=&v"(t[11]), "=&v"(t[12]), "=&v"(t[13]), "=&v"(t[14]), "=&v"(t[15])
        : "v"(p0), "v"(p1), "v"(p2), "v"(p3) : "memory");
}
template <class E> struct SplitEpi {
    static constexpr bool PERM = E::PERM, AFTER_DRAIN = false;
    E e; float* part; unsigned* cnt; int slice, nsl;
    __device__ __forceinline__ void operator()(f32x4 (&acc)[2][2][4][2], const Unit& u, int wr, int wc, int fr, int fq) const {
        const int wid = wr * 4 + wc, lane = fq * 16 + fr;
        f32x4* base = (f32x4*)part + (size_t)(u.pn * 8 + wid) * 32 * 64 + lane;
        const size_t sstride = (size_t)16 * 8 * 32 * 64;
        f32x4* dst = base + (size_t)slice * sstride;
#pragma unroll
        for (int q = 0; q < 32; ++q) asm volatile("global_store_dwordx4 %0, %1, off sc1\n\ts_nop 2" :: "v"(dst + q * 64), "v"(acc[q >> 4][(q >> 3) & 1][(q >> 1) & 3][q & 1]) : "memory");
        asm volatile("s_waitcnt vmcnt(0)" ::: "memory");
        unsigned old = 0u;
        if (lane == 0) old = __hip_atomic_fetch_add(cnt + u.pn * 8 + wid, 1u, __ATOMIC_RELAXED, __HIP_MEMORY_SCOPE_AGENT);
        old = (unsigned)__builtin_amdgcn_readfirstlane((int)old);
        if (old + 1u == (unsigned)nsl) {
            __builtin_amdgcn_fence(__ATOMIC_ACQUIRE, "agent");
#pragma unroll
            for (int q = 0; q < 32; ++q) acc[q >> 4][(q >> 3) & 1][(q >> 1) & 3][q & 1] = (f32x4){0.f, 0.f, 0.f, 0.f};
#pragma unroll 1
            for (int sl = 0; sl < nsl; ++sl) {
                const f32x4* src = base + (size_t)sl * sstride;
#pragma unroll
                for (int hb = 0; hb < 2; ++hb) {
                    f32x4 t[16]; ld16_coh(src + hb * 16 * 64, t);
#pragma unroll
                    for (int i = 0; i < 16; ++i) { const int q = hb * 16 + i; acc[q >> 4][(q >> 3) & 1][(q >> 1) & 3][q & 1] += t[i]; }
                }
            }
            e(acc, u, wr, wc, fr, fq);
        }
    }
};
template <class Epi, class Sched, bool ALIGN_EPI = false, bool SP2 = false>
__device__ __forceinline__ void gemm_phase(PG8_LAS unsigned char* lds, const Gemm g, const Sched& S, const Epi& E) {
    int tid_o = threadIdx.x; asm volatile("" : "+v"(tid_o));
    const int tid = tid_o, wid = __builtin_amdgcn_readfirstlane(tid >> 6), lane = tid & 63, wr = wid >> 2, wc = wid & 3, fr = lane & 15, fq = lane >> 4;
    const int K = g.K, nt = g.Kloop / BK;
    unsigned voffA[2], voffB[2];
#pragma unroll
    for (int i = 0; i < 2; ++i) { int R, C; stage_rc(tid * 16 + i * 8192, R, C); const int Rb = Epi::PERM ? ((R & ~31) + perm32(R & 31)) : R;
        voffA[i] = (unsigned)(R * K + C) * 2u; voffB[i] = (unsigned)(Rb * K + C) * 2u; }
    const size_t kstep = (size_t)(BK * 2);
    const size_t hstep = (size_t)HALF * K * 2;
    const size_t tstep = 2 * hstep;
    const unsigned ldsw = (unsigned)wid * 1024u;
    const int aoff = lds_byte(wr * 64 + fr, fq * 8), boff = lds_byte(wc * 32 + fr, fq * 8);
#define PG8_SA(b, h) (((b) * 2 + (h)) * HTB)
#define PG8_SB(b, h) ((4 + (b) * 2 + (h)) * HTB)
#define PG8_STAGE(bufoff, gbase, voff) do { _Pragma("unroll") for (int _i = 0; _i < 2; ++_i) \
        __builtin_amdgcn_global_load_lds((const unsigned*)((const char*)(gbase) + (voff)[_i]), (PG8_LAS unsigned*)(lds + (bufoff) + ldsw + _i * 8192), 16, 0, 0); } while (0)
#define PG8_LDA(dst, b, h) do { _Pragma("unroll") for (int m = 0; m < 4; ++m) _Pragma("unroll") for (int k = 0; k < 2; ++k) dst[m][k] = *(const PG8_LAS bf16x8*)(lds + PG8_SA(b, h) + aoff + m * 2048 + k * 1024); } while (0)
#define PG8_LDB(dst, b, h) do { _Pragma("unroll") for (int n = 0; n < 2; ++n) _Pragma("unroll") for (int k = 0; k < 2; ++k) dst[n][k] = *(const PG8_LAS bf16x8*)(lds + PG8_SB(b, h) + boff + n * 2048 + k * 1024); } while (0)
#define PG8_MMA(ai, bj, At, Bt) do { __builtin_amdgcn_s_setprio(1); _Pragma("unroll") for (int m = 0; m < 4; ++m) _Pragma("unroll") for (int n = 0; n < 2; ++n) _Pragma("unroll") for (int k = 0; k < 2; ++k) \
        acc[ai][bj][m][n] = __builtin_amdgcn_mfma_f32_16x16x32_bf16(Bt[n][k], At[m][k], acc[ai][bj][m][n], 0, 0, 0); __builtin_amdgcn_s_setprio(0); } while (0)
#define PG8_WAIT_V(n) asm volatile("s_waitcnt vmcnt(" #n ")" ::: "memory")
#define PG8_WAIT_L(n) asm volatile("s_waitcnt lgkmcnt(" #n ")" ::: "memory")
#define PG8_BAR __builtin_amdgcn_s_barrier()
#define PG8_SCHED __builtin_amdgcn_sched_barrier(0)
    Unit cur, nxt; int ui = 0;
    if (!S.next(0, cur)) return;
    f32x4 acc[2][2][4][2];
#pragma unroll
    for (int a = 0; a < 2; ++a)
#pragma unroll
        for (int b = 0; b < 2; ++b)
#pragma unroll
            for (int m = 0; m < 4; ++m)
#pragma unroll
                for (int n = 0; n < 2; ++n) acc[a][b][m][n] = (f32x4){0.f, 0.f, 0.f, 0.f};
    bf16x8 At[4][2], B0[2][2], B1[2][2];
    const char* cA = (const char*)g.A + (size_t)cur.pm * tstep; const char* cB = (const char*)g.Bt + (size_t)cur.pn * tstep;
    S.a_ready(cur);
    if constexpr (SP2) {
        PG8_STAGE(PG8_SB(0, 0), cB, voffB); PG8_STAGE(PG8_SB(0, 1), cB + hstep, voffB); PG8_STAGE(PG8_SA(0, 0), cA, voffA); PG8_STAGE(PG8_SA(0, 1), cA + hstep, voffA);
        if (wr == 1) PG8_BAR;
        PG8_WAIT_V(2); PG8_BAR;
        PG8_STAGE(PG8_SB(1, 0), cB + kstep, voffB); PG8_STAGE(PG8_SA(1, 0), cA + kstep, voffA); PG8_STAGE(PG8_SB(1, 1), cB + hstep + kstep, voffB);
        PG8_WAIT_V(6); PG8_BAR;
    } else {
        PG8_STAGE(PG8_SB(0, 0), cB, voffB); PG8_STAGE(PG8_SA(0, 0), cA, voffA); PG8_STAGE(PG8_SB(0, 1), cB + hstep, voffB); PG8_STAGE(PG8_SA(0, 1), cA + hstep, voffA);
        if (wr == 1) PG8_BAR;
        PG8_WAIT_V(4); PG8_BAR;
        PG8_STAGE(PG8_SB(1, 0), cB + kstep, voffB); PG8_STAGE(PG8_SA(1, 0), cA + kstep, voffA); PG8_STAGE(PG8_SB(1, 1), cB + hstep + kstep, voffB);
        PG8_WAIT_V(6); PG8_BAR;
    }
    for (;;) {
        const bool has_next = S.next(ui + 1, nxt);
        const char* nA = has_next ? (const char*)g.A + (size_t)nxt.pm * tstep : cA; const char* nB = has_next ? (const char*)g.Bt + (size_t)nxt.pn * tstep : cB;
        for (int t = 0; t < nt; t += 2) {
            const bool last = (t == nt - 2);
            const char* a1 = cA + (size_t)(t + 1) * kstep;
            const char* a2 = last ? nA : cA + (size_t)(t + 2) * kstep; const char* b2 = last ? nB : cB + (size_t)(t + 2) * kstep;
            const char* a3 = a2 + kstep; const char* b3 = b2 + kstep;
            if (last && has_next) S.a_ready(nxt);
            if constexpr (SP2) {
            PG8_LDB(B0, 0, 0); PG8_LDB(B1, 0, 1); PG8_SCHED; PG8_LDA(At, 0, 0); PG8_STAGE(PG8_SA(1, 1), a1 + hstep, voffA);
            PG8_WAIT_V(8); PG8_WAIT_L(0); PG8_BAR; PG8_MMA(0, 0, At, B0); PG8_MMA(0, 1, At, B1); PG8_BAR; PG8_SCHED;
            PG8_LDA(At, 0, 1); PG8_STAGE(PG8_SB(0, 0), b2, voffB); PG8_STAGE(PG8_SB(0, 1), b2 + hstep, voffB); PG8_STAGE(PG8_SA(0, 0), a2, voffA);
            PG8_WAIT_V(8); PG8_WAIT_L(0); PG8_BAR; PG8_MMA(1, 0, At, B0); PG8_MMA(1, 1, At, B1); PG8_BAR; PG8_SCHED;
            PG8_LDB(B0, 1, 0); PG8_LDB(B1, 1, 1); PG8_SCHED; PG8_LDA(At, 1, 0); PG8_STAGE(PG8_SA(0, 1), a2 + hstep, voffA);
            PG8_WAIT_V(8); PG8_WAIT_L(0); PG8_BAR; PG8_MMA(0, 0, At, B0); PG8_MMA(0, 1, At, B1); PG8_BAR; PG8_SCHED;
            PG8_LDA(At, 1, 1); PG8_STAGE(PG8_SB(1, 0), b3, voffB); PG8_STAGE(PG8_SB(1, 1), b3 + hstep, voffB); PG8_STAGE(PG8_SA(1, 0), a3, voffA);
            PG8_WAIT_V(8); PG8_WAIT_L(0); PG8_BAR; PG8_MMA(1, 0, At, B0); PG8_MMA(1, 1, At, B1); PG8_BAR; PG8_SCHED;
            } else {
            PG8_LDB(B0, 0, 0); PG8_SCHED; PG8_LDA(At, 0, 0); PG8_STAGE(PG8_SA(1, 1), a1 + hstep, voffA);
            PG8_WAIT_L(8); PG8_BAR; PG8_WAIT_L(0); PG8_MMA(0, 0, At, B0); PG8_BAR; PG8_SCHED;
            PG8_LDB(B1, 0, 1); PG8_STAGE(PG8_SB(0, 0), b2, voffB);
            PG8_BAR; PG8_WAIT_L(0); PG8_MMA(0, 1, At, B1); PG8_BAR;
            PG8_LDA(At, 0, 1); PG8_STAGE(PG8_SA(0, 0), a2, voffA);
            PG8_BAR; PG8_WAIT_L(0); PG8_MMA(1, 0, At, B0); PG8_BAR; PG8_SCHED;
            PG8_STAGE(PG8_SB(0, 1), b2 + hstep, voffB);
            PG8_WAIT_V(6); PG8_BAR; PG8_MMA(1, 1, At, B1); PG8_BAR;
            PG8_LDB(B0, 1, 0); PG8_SCHED; PG8_LDA(At, 1, 0); PG8_STAGE(PG8_SA(0, 1), a2 + hstep, voffA);
            PG8_WAIT_L(8); PG8_BAR; PG8_WAIT_L(0); PG8_MMA(0, 0, At, B0); PG8_BAR; PG8_SCHED;
            PG8_LDB(B1, 1, 1); PG8_STAGE(PG8_SB(1, 0), b3, voffB);
            PG8_BAR; PG8_WAIT_L(0); PG8_MMA(0, 1, At, B1); PG8_BAR;
            PG8_LDA(At, 1, 1); PG8_STAGE(PG8_SA(1, 0), a3, voffA);
            PG8_BAR; PG8_WAIT_L(0); PG8_MMA(1, 0, At, B0); PG8_BAR; PG8_SCHED;
            PG8_STAGE(PG8_SB(1, 1), b3 + hstep, voffB);
            PG8_WAIT_V(6); PG8_BAR; PG8_MMA(1, 1, At, B1); PG8_BAR;
            }
        }
        if constexpr (ALIGN_EPI) { if (wr == 0) PG8_BAR; }
        if constexpr (!Epi::AFTER_DRAIN) { E(acc, cur, wr, wc, fr, fq); S.done(cur); }
        if (!has_next) break;
#pragma unroll
        for (int a = 0; a < 2; ++a)
#pragma unroll
            for (int b = 0; b < 2; ++b)
#pragma unroll
                for (int m = 0; m < 4; ++m)
#pragma unroll
                    for (int n = 0; n < 2; ++n) acc[a][b][m][n] = (f32x4){0.f, 0.f, 0.f, 0.f};
        cur = nxt; cA = nA; cB = nB; ++ui;
        if constexpr (ALIGN_EPI) { if (wr == 1) PG8_BAR; }
    }
    PG8_WAIT_V(0);
    if constexpr (!ALIGN_EPI) { if (wr == 0) PG8_BAR; }
    PG8_BAR;
    if constexpr (Epi::AFTER_DRAIN) { E.fused(acc, cur, wr, wc, fr, fq, lds, wid, lane); S.done(cur); }
#undef PG8_SA
#undef PG8_SB
#undef PG8_STAGE
#undef PG8_LDA
#undef PG8_LDB
#undef PG8_MMA
#undef PG8_WAIT_V
#undef PG8_WAIT_L
#undef PG8_BAR
#undef PG8_SCHED
}
}
#define LAS __attribute__((address_space(3)))
#define XB_TMO      128
#define XB_XCNT(j)  (256  + 64 * (j))
#define XB_XSUB(j)  (1280 + 64 * (j))
#define XB_XGEN(j)  (2304 + 64 * (j))
#define XB_TOP      3328
#define XB_TOPGEN   3392
#define XCD_BAR_WORDS 3456
#define XB_SPIN_CAP (1u << 18)

__device__ __forceinline__ unsigned xb_ld(unsigned* p)              { return __hip_atomic_load(p, __ATOMIC_RELAXED, __HIP_MEMORY_SCOPE_AGENT); }
__device__ __forceinline__ unsigned xb_add(unsigned* p, unsigned v) { return __hip_atomic_fetch_add(p, v, __ATOMIC_RELAXED, __HIP_MEMORY_SCOPE_AGENT); }
__device__ __forceinline__ unsigned xb_xcc_id() { return (unsigned)__builtin_amdgcn_s_getreg((3 << 11) | 20) & 0xFu; }
#define XB_SPIN(cond, bar) do { unsigned _sp = 0; while (cond) { __builtin_amdgcn_s_sleep(1); \
    if ((++_sp & 255u) == 0u) { if (xb_ld(&(bar)[XB_TMO])) break; if (_sp > XB_SPIN_CAP) { atomicAdd(&(bar)[XB_TMO], 1u); break; } } } } while (0)

struct XcdBarrier {
    unsigned* bar; unsigned x;
    volatile LAS unsigned* st;
};

__device__ __forceinline__ XcdBarrier xcd_barrier_post(unsigned* bar, volatile LAS unsigned* st) {
    XcdBarrier b; b.bar = bar; b.x = xb_xcc_id(); b.st = st;
    if (threadIdx.x == 0) (void)xb_add(&bar[XB_XCNT(b.x)], 1u);
    return b;
}
__device__ __forceinline__ void xcd_barrier_complete(unsigned* bar, unsigned x, unsigned& nloc, unsigned& nx) {
    const unsigned G = gridDim.x * gridDim.y * gridDim.z;
    unsigned sum, cnt, mine, sp = 0u;
    for (;;) {
        sum = 0u; cnt = 0u; mine = 0u;
#pragma unroll
        for (unsigned j = 0; j < 16; ++j) { const unsigned c = xb_ld(&bar[XB_XCNT(j)]); sum += c; cnt += (c > 0u) ? 1u : 0u; mine = (j == x) ? c : mine; }
        if (sum == G) break;
        __builtin_amdgcn_s_sleep(1);
        if ((++sp & 255u) == 0u) { if (xb_ld(&bar[XB_TMO])) break; if (sp > XB_SPIN_CAP) { atomicAdd(&bar[XB_TMO], 1u); break; } }
    }
    nloc = mine > 0u ? mine : 1u; nx = cnt > 0u ? cnt : 1u;
}

__device__ __forceinline__ void xcd_barrier(const XcdBarrier& b) {
    asm volatile("s_waitcnt vmcnt(0)" ::: "memory");
    __syncthreads();
    if (threadIdx.x == 0) {
        unsigned* bar = b.bar;
        __builtin_amdgcn_s_waitcnt(0);
        unsigned nloc = b.st[0], nx = b.st[1];
        if (nloc == 0u) { xcd_barrier_complete(bar, b.x, nloc, nx); b.st[0] = nloc; b.st[1] = nx; }
        const unsigned old = xb_add(&bar[XB_XSUB(b.x)], 1u);
        const unsigned gen = old / nloc;
        if (old + 1u == (gen + 1u) * nloc) {
            __builtin_amdgcn_fence(__ATOMIC_RELEASE, "agent");
            asm volatile("s_waitcnt vmcnt(0)" ::: "memory");
            const unsigned og = xb_add(&bar[XB_TOP], 1u);
            const unsigned tg = og / nx;
            if (og + 1u == (tg + 1u) * nx) xb_add(&bar[XB_TOPGEN], 1u);
            else XB_SPIN(xb_ld(&bar[XB_TOPGEN]) == tg, bar);
            __builtin_amdgcn_fence(__ATOMIC_ACQUIRE, "agent");
            xb_add(&bar[XB_XGEN(b.x)], 1u);
            asm volatile("s_waitcnt vmcnt(0)" ::: "memory");
        } else {
            XB_SPIN(xb_ld(&bar[XB_XGEN(b.x)]) == gen, bar);
            __builtin_amdgcn_fence(__ATOMIC_ACQUIRE, "agent");
            asm volatile("s_waitcnt vmcnt(0)" ::: "memory");
        }
    }
    __syncthreads();
}

using pg8::bf16_t; using pg8::bf16x8; using pg8::f32x4; using pg8::u32x4;
using pg8::DM; using pg8::MP; using pg8::MS; using pg8::MT; using pg8::NIN; using pg8::DFF; using pg8::LDP; using pg8::SEQ; using pg8::DSEQ;
using pg8::NBATCH; using pg8::DBATCH; using pg8::DEPTH;
#define LAS __attribute__((address_space(3)))
typedef unsigned u32x2 __attribute__((ext_vector_type(2)));
typedef float f32x2 __attribute__((ext_vector_type(2)));

constexpr int NTHR = 512;
constexpr int LDS_BYTES = 147456;
constexpr size_t O_YP = 0, O_YS = (size_t)MP * DM, O_RETP = O_YS + (size_t)MS * DM, O_CONVP = O_RETP + (size_t)DEPTH * NBATCH * 4 * 16384,
                 O_RETS = O_CONVP + (size_t)DEPTH * NBATCH * 2 * 512, O_CONVS = O_RETS + (size_t)DEPTH * DBATCH * 4 * 16384;
constexpr size_t MiB = 1u << 20;
constexpr size_t WS_WIN = 0, WS_WOUT = 14 * MiB, WS_WUP = 18 * MiB, WS_WDN = 34 * MiB;
constexpr size_t WS_COS = 50 * MiB, WS_SIN = 51 * MiB, WS_SSP = 52 * MiB, WS_SSEG = 55 * MiB;
constexpr size_t WS_CTL = 54 * MiB + 512 * 1024;
constexpr int CTL_WORDS = 8192, CW_CNT = 4096;
constexpr size_t WS_PART = 400 * MiB;
constexpr size_t WS_XB = 71 * MiB;
constexpr size_t WS_PROJ = 136 * MiB;
constexpr size_t WS_MIX = WS_PROJ + (size_t)MT * LDP * 2;
constexpr size_t WS_H = WS_PROJ;
constexpr size_t WS_END = WS_MIX + (size_t)MT * DM * 2;
static_assert(WS_END <= WS_PART && WS_PART + 64 * MiB <= 512 * MiB && WS_XB + (size_t)MT * DM * 2 <= WS_PROJ && WS_END <= 512 * MiB && WS_H + (size_t)MT * DFF * 2 <= WS_END, "ws map");

__device__ __forceinline__ float bf2f(unsigned b) { return __uint_as_float(b << 16); }
__device__ __forceinline__ unsigned pk2(float lo, float hi) { return pg8::cvt_pk_bf16(lo, hi); }
__device__ __forceinline__ float ex2(float x) { return __builtin_amdgcn_exp2f(x); }
__device__ __forceinline__ f32x4 mma(const bf16x8 x, const bf16x8 y, const f32x4 c) { return __builtin_amdgcn_mfma_f32_16x16x32_bf16(x, y, c, 0, 0, 0); }
__device__ __forceinline__ bf16x8 frag(LAS unsigned char* base, int row, int stride, int kg, int kb) { return *(const LAS bf16x8*)(base + row * stride + 16 * kg + 64 * kb); }

constexpr int R_Q = 0, R_K = 17408, R_KT = 34816, R_VT = 53248, R_SP = 71680, R_RT = 80896, R_ST = 115712;
constexpr int SQ = 272, ST = 144;
__device__ __forceinline__ void ret_item(LAS unsigned char* lds, const bf16_t* proj, bf16_t* mix, int row0, int nchunks, int CL, int h, float lg2, bool full,
                                         int rinit, const float* rsrc, int nprefix, float* rdst, const float* gnw) {
    int tid_o = threadIdx.x; asm volatile("" : "+v"(tid_o));
    const int tid = tid_o, w = __builtin_amdgcn_readfirstlane(tid >> 6), lane = tid & 63, j = lane & 15, ig = lane >> 4;
    f32x4 R[8];
#pragma unroll
    for (int dt = 0; dt < 8; ++dt) {
#pragma unroll
        for (int t = 0; t < 4; ++t) {
            const int idx = (16 * dt + 4 * ig + t) * 128 + 16 * w + j;
            float v = 0.f;
            if (rinit == 2) v = rsrc[idx];
            else if (rinit == 1) { for (int s = 0; s < nprefix; ++s) v += rsrc[(size_t)s * 16384 + idx] * ex2(lg2 * 512.f * (float)(nprefix - 1 - s)); }
            R[dt][t] = v;
        }
    }
    if (full) {
#pragma unroll
        for (int dt = 0; dt < 8; ++dt) { u32x2 p; p.x = pk2(R[dt][0], R[dt][1]); p.y = pk2(R[dt][2], R[dt][3]); *(LAS u32x2*)(lds + R_RT + (16 * w + j) * SQ + (16 * dt + 4 * ig) * 2) = p; }
    }
    const float cdec = ex2(lg2 * (float)CL);
    const float kdec = ex2(lg2 * (float)(CL - 1 - lane));
    u32x4 qreg[2], kreg[2], vreg[2];
    const u32x4 zero4 = (u32x4){0u, 0u, 0u, 0u};
#define RET_LOAD(c) do { _Pragma("unroll") for (int it = 0; it < 2; ++it) { \
        const int qm = (tid + NTHR * it) >> 4, qd = (tid + NTHR * it) & 15, kd = w + 8 * it; \
        const bf16_t* rb = proj + (size_t)(row0 + (c) * 64) * LDP + h * 128; \
        qreg[it] = (full && qm < CL) ? *(const u32x4*)(rb + (size_t)qm * LDP + 8 * qd) : zero4; \
        kreg[it] = (lane < CL) ? *(const u32x4*)(rb + (size_t)lane * LDP + 512 + 8 * kd) : zero4; \
        vreg[it] = (lane < CL) ? *(const u32x4*)(rb + (size_t)lane * LDP + 1024 + 8 * kd) : zero4; } } while (0)
    RET_LOAD(0);
    for (int c = 0; c < nchunks; ++c) {
#pragma unroll
        for (int it = 0; it < 2; ++it) {
            const int qm = (tid + NTHR * it) >> 4, qd = (tid + NTHR * it) & 15, kd = w + 8 * it;
            if (full) { *(LAS u32x4*)(lds + R_Q + qm * SQ + 16 * qd) = qreg[it]; *(LAS u32x4*)(lds + R_K + lane * SQ + 16 * kd) = kreg[it]; }
#pragma unroll
            for (int e = 0; e < 4; ++e) {
                const unsigned kw = kreg[it][e], vw = vreg[it][e];
                const unsigned kp = pk2(bf2f(kw & 0xffffu) * kdec, bf2f(kw >> 16) * kdec);
                *(LAS unsigned short*)(lds + R_KT + (8 * kd + 2 * e) * ST + 2 * lane) = (unsigned short)(kp & 0xffffu);
                *(LAS unsigned short*)(lds + R_KT + (8 * kd + 2 * e + 1) * ST + 2 * lane) = (unsigned short)(kp >> 16);
                *(LAS unsigned short*)(lds + R_VT + (8 * kd + 2 * e) * ST + 2 * lane) = (unsigned short)(vw & 0xffffu);
                *(LAS unsigned short*)(lds + R_VT + (8 * kd + 2 * e + 1) * ST + 2 * lane) = (unsigned short)(vw >> 16);
            }
        }
        if (c + 1 < nchunks) RET_LOAD(c + 1);
        __syncthreads();
        f32x4 o[4];
        if (full) {
            const int mt = w & 3;
#pragma unroll
            for (int q2 = 0; q2 < 2; ++q2) {
                const int nt = 2 * (w >> 2) + q2;
                f32x4 s = (f32x4){0.f, 0.f, 0.f, 0.f};
#pragma unroll
                for (int kb = 0; kb < 4; ++kb) s = mma(frag(lds + R_K, 16 * mt + j, SQ, ig, kb), frag(lds + R_Q, 16 * nt + j, SQ, ig, kb), s);
                const int n = 16 * nt + j, m0 = 16 * mt + 4 * ig;
#pragma unroll
                for (int t = 0; t < 4; ++t) { const int df = n - (m0 + t); s[t] = df >= 0 ? s[t] * ex2(lg2 * (float)df) : 0.f; }
                u32x2 p; p.x = pk2(s[0], s[1]); p.y = pk2(s[2], s[3]);
                *(LAS u32x2*)(lds + R_SP + n * ST + m0 * 2) = p;
            }
            __syncthreads();
            bf16x8 rt[4], vt[2];
#pragma unroll
            for (int kb = 0; kb < 4; ++kb) rt[kb] = frag(lds + R_RT, 16 * w + j, SQ, ig, kb);
#pragma unroll
            for (int kb = 0; kb < 2; ++kb) vt[kb] = frag(lds + R_VT, 16 * w + j, ST, ig, kb);
#pragma unroll
            for (int nt = 0; nt < 4; ++nt) {
                f32x4 a = (f32x4){0.f, 0.f, 0.f, 0.f}, b = (f32x4){0.f, 0.f, 0.f, 0.f};
#pragma unroll
                for (int kb = 0; kb < 4; ++kb) a = mma(rt[kb], frag(lds + R_Q, 16 * nt + j, SQ, ig, kb), a);
#pragma unroll
                for (int kb = 0; kb < 2; ++kb) b = mma(vt[kb], frag(lds + R_SP, 16 * nt + j, ST, ig, kb), b);
                const float qd = ex2(lg2 * (float)(16 * nt + j + 1));
                o[nt] = b + a * qd;
                float s1 = (o[nt][0] + o[nt][1]) + (o[nt][2] + o[nt][3]);
                float s2 = (o[nt][0] * o[nt][0] + o[nt][1] * o[nt][1]) + (o[nt][2] * o[nt][2] + o[nt][3] * o[nt][3]);
                s1 += __shfl_xor(s1, 16); s1 += __shfl_xor(s1, 32); s2 += __shfl_xor(s2, 16); s2 += __shfl_xor(s2, 32);
                if (ig == 0) *(LAS f32x2*)(lds + R_ST + ((16 * nt + j) * 8 + w) * 8) = (f32x2){s1, s2};
            }
        }
        {
            bf16x8 vt[2];
#pragma unroll
            for (int kb = 0; kb < 2; ++kb) vt[kb] = frag(lds + R_VT, 16 * w + j, ST, ig, kb);
#pragma unroll
            for (int dt = 0; dt < 8; ++dt) {
                R[dt] = R[dt] * cdec;
#pragma unroll
                for (int kb = 0; kb < 2; ++kb) R[dt] = mma(frag(lds + R_KT, 16 * dt + j, ST, ig, kb), vt[kb], R[dt]);
            }
        }
        if (full && c + 1 < nchunks) {
#pragma unroll
            for (int dt = 0; dt < 8; ++dt) { u32x2 p; p.x = pk2(R[dt][0], R[dt][1]); p.y = pk2(R[dt][2], R[dt][3]); *(LAS u32x2*)(lds + R_RT + (16 * w + j) * SQ + (16 * dt + 4 * ig) * 2) = p; }
        }
        __syncthreads();
        if (full) {
            const f32x4 gw = *(const f32x4*)(gnw + h * 128 + 16 * w + 4 * ig);
#pragma unroll
            for (int nt = 0; nt < 4; ++nt) {
                const int n = 16 * nt + j;
                if (n < CL) {
                    const LAS f32x4* sp = (const LAS f32x4*)(lds + R_ST + n * 64);
                    const f32x4 p0 = sp[0], p1 = sp[1], p2 = sp[2], p3 = sp[3];
                    const float s1 = (p0[0] + p0[2]) + (p1[0] + p1[2]) + (p2[0] + p2[2]) + (p3[0] + p3[2]);
                    const float s2 = (p0[1] + p0[3]) + (p1[1] + p1[3]) + (p2[1] + p2[3]) + (p3[1] + p3[3]);
                    const float mean = s1 * (1.0f / 128.0f);
                    const float var = fmaxf(s2 * (1.0f / 128.0f) - mean * mean, 0.f);
                    const float rstd = __builtin_amdgcn_rsqf(var + pg8::GN_EPS);
                    const size_t row = (size_t)(row0 + c * 64 + n);
                    const u32x2 sg = *(const u32x2*)(proj + row * LDP + 1536 + h * 128 + 16 * w + 4 * ig);
                    const float g0 = bf2f(sg.x & 0xffffu), g1 = bf2f(sg.x >> 16), g2 = bf2f(sg.y & 0xffffu), g3 = bf2f(sg.y >> 16);
                    u32x2 p;
                    p.x = pk2((o[nt][0] - mean) * rstd * gw[0] * g0, (o[nt][1] - mean) * rstd * gw[1] * g1);
                    p.y = pk2((o[nt][2] - mean) * rstd * gw[2] * g2, (o[nt][3] - mean) * rstd * gw[3] * g3);
                    *(u32x2*)(mix + row * DM + h * 128 + 16 * w + 4 * ig) = p;
                }
            }
        }
    }
#undef RET_LOAD
    if (rdst) {
#pragma unroll
        for (int dt = 0; dt < 8; ++dt)
#pragma unroll
            for (int t = 0; t < 4; ++t) rdst[(16 * dt + 4 * ig + t) * 128 + 16 * w + j] = R[dt][t];
    }
    __syncthreads();
}
__device__ __forceinline__ float head_lg2(int h) { return h == 0 ? -0.04580368961312479f : h == 1 ? -0.02272007650008353f : h == 2 ? -0.011315313227834146f : -0.005646563141142063f; }

__device__ __forceinline__ void conv_phase(const bf16_t* proj, bf16_t* mix, const float* conv_w  , const float* sconv  , int gtid, int nthr) {
    const int nitems = (MT / 16) * 64;
    for (int it = gtid; it < nitems; it += nthr) {
        const int co = it & 63, rb = it >> 6, r0 = rb * 16, c0 = co * 8;
        float w0[8], w1[8], w2[8], um2[8], um1[8];
#pragma unroll
        for (int e = 0; e < 8; ++e) { w0[e] = conv_w[(c0 + e) * 3 + 0]; w1[e] = conv_w[(c0 + e) * 3 + 1]; w2[e] = conv_w[(c0 + e) * 3 + 2]; }
        const bool seq_start = r0 < MP ? ((r0 & (SEQ - 1)) == 0) : true;
        if (seq_start) {
            if (r0 < MP) {
#pragma unroll
                for (int e = 0; e < 8; ++e) { um2[e] = 0.f; um1[e] = 0.f; }
            } else {
                const float* sb = sconv + (size_t)((r0 - MP) >> 4) * 1024 + c0;
#pragma unroll
                for (int e = 0; e < 8; ++e) { um2[e] = sb[e]; um1[e] = sb[512 + e]; }
            }
        } else {
            const u32x4 a = *(const u32x4*)(proj + (size_t)(r0 - 2) * LDP + 2560 + c0), b = *(const u32x4*)(proj + (size_t)(r0 - 1) * LDP + 2560 + c0);
#pragma unroll
            for (int e = 0; e < 4; ++e) { um2[2 * e] = bf2f(a[e] & 0xffffu); um2[2 * e + 1] = bf2f(a[e] >> 16); um1[2 * e] = bf2f(b[e] & 0xffffu); um1[2 * e + 1] = bf2f(b[e] >> 16); }
        }
#pragma unroll 4
        for (int i = 0; i < 16; ++i) {
            const size_t row = (size_t)(r0 + i);
            const u32x4 uu = *(const u32x4*)(proj + row * LDP + 2560 + c0), bb = *(const u32x4*)(proj + row * LDP + 2048 + c0);
            float res[8];
#pragma unroll
            for (int e = 0; e < 4; ++e) {
                const float u0 = bf2f(uu[e] & 0xffffu), u1 = bf2f(uu[e] >> 16), b0 = bf2f(bb[e] & 0xffffu), b1 = bf2f(bb[e] >> 16);
                res[2 * e] = b0 * (w0[2 * e] * um2[2 * e] + w1[2 * e] * um1[2 * e] + w2[2 * e] * u0);
                res[2 * e + 1] = b1 * (w0[2 * e + 1] * um2[2 * e + 1] + w1[2 * e + 1] * um1[2 * e + 1] + w2[2 * e + 1] * u1);
                um2[2 * e] = um1[2 * e]; um1[2 * e] = u0; um2[2 * e + 1] = um1[2 * e + 1]; um1[2 * e + 1] = u1;
            }
            u32x4 o; o.x = pk2(res[0], res[1]); o.y = pk2(res[2], res[3]); o.z = pk2(res[4], res[5]); o.w = pk2(res[6], res[7]);
            *(u32x4*)(mix + row * DM + 512 + c0) = o;
        }
    }
}

__device__ __forceinline__ void conv_weight(const float* W, int K, int N, bf16_t* Wt, const float* ksc, int mode, int gtid, int nthr) {
    const int nitems = (K / 8) * N;
    for (int it = gtid; it < nitems; it += nthr) {
        const int ko = it / N, np = it - ko * N, k0 = ko * 8;
        int col = np; float cs = 1.f;
        if (mode == 1) {
            const int pn = np >> 8, bj = (np >> 7) & 1, t = np & 127;
            if (pn < 4) { col = (pn < 2 ? 0 : 512) + 128 * (2 * (pn & 1) + (t >> 6)) + 64 * bj + (t & 63); if (pn >= 2) cs = 0.08838834764831845f; }
            else if (pn >= 10) col = (bj ? 3072 : 2560) + 128 * (pn - 10) + t;
        }
        float v[8];
#pragma unroll
        for (int e = 0; e < 8; ++e) v[e] = W[(size_t)(k0 + e) * N + col] * (ksc ? ksc[k0 + e] : 1.f) * cs;
        u32x4 o; o.x = pk2(v[0], v[1]); o.y = pk2(v[2], v[3]); o.z = pk2(v[4], v[5]); o.w = pk2(v[6], v[7]);
        *(u32x4*)(Wt + (size_t)np * K + k0) = o;
    }
}
__device__ __forceinline__ float wave_sum(float v) {
#pragma unroll
    for (int o = 1; o < 64; o <<= 1) v += __shfl_xor(v, o);
    return v;
}

struct Args { const float* in[13]; float* out; unsigned char* ws; };

__global__ void __launch_bounds__(NTHR, 2) hymba_fwd(Args args) {
    extern __shared__ __attribute__((aligned(16))) unsigned char lds_raw[];
    LAS unsigned char* lds = (LAS unsigned char*)lds_raw;
    cg::grid_group grid = cg::this_grid();
    const int tid = threadIdx.x, lane = tid & 63, wave = __builtin_amdgcn_readfirstlane(tid >> 6);
    const int G = gridDim.x, bx = blockIdx.x;
    const int gtid = bx * NTHR + tid, nthr = G * NTHR, gw = bx * 8 + wave, ngw = G * 8;
    unsigned char* ws = args.ws;
    const float* x_prompt = args.in[0]; const float* x_sample = args.in[1]; const float* state_ret = args.in[2]; const float* state_conv = args.in[3];
    const float* ln1_w = args.in[4]; const float* w_in = args.in[5]; const float* conv_w = args.in[6]; const float* ret_norm_w = args.in[7];
    const float* w_out = args.in[8]; const float* ln2_w = args.in[9]; const float* w_up = args.in[10]; const float* w_dn = args.in[11]; const float* ln_f_w = args.in[12];
    float* out = args.out;
    bf16_t* WtIn = (bf16_t*)(ws + WS_WIN); bf16_t* WtOut = (bf16_t*)(ws + WS_WOUT); bf16_t* WtUp = (bf16_t*)(ws + WS_WUP); bf16_t* WtDn = (bf16_t*)(ws + WS_WDN);
    float* rcos = (float*)(ws + WS_COS); float* rsin = (float*)(ws + WS_SIN); float* ssp = (float*)(ws + WS_SSP); float* sseg = (float*)(ws + WS_SSEG);
    bf16_t* xb = (bf16_t*)(ws + WS_XB); bf16_t* proj = (bf16_t*)(ws + WS_PROJ); bf16_t* mix = (bf16_t*)(ws + WS_MIX); bf16_t* Hb = (bf16_t*)(ws + WS_H);
    unsigned* ctl = (unsigned*)(ws + WS_CTL); float* part = (float*)(ws + WS_PART);
    volatile LAS unsigned* MISC = (volatile LAS unsigned*)(lds + 131072 + 512);
    if (tid < 64) MISC[tid] = 0u;
    if (bx == 0) { for (int i = tid; i < CTL_WORDS; i += NTHR) ctl[i] = 0u; }
    __syncthreads();
    int kslice = 256; asm volatile("" : "+s"(kslice));
    float* X = out;

#pragma unroll 1
    for (int l = 0; l < DEPTH; ++l) {
        conv_weight(w_in + (size_t)l * DM * NIN, DM, NIN, WtIn + (size_t)l * NIN * DM, ln1_w + l * DM, 1, gtid, nthr);
        conv_weight(w_out + (size_t)l * DM * DM, DM, DM, WtOut + (size_t)l * DM * DM, nullptr, 0, gtid, nthr);
        conv_weight(w_up + (size_t)l * DM * DFF, DM, DFF, WtUp + (size_t)l * DFF * DM, ln2_w + l * DM, 0, gtid, nthr);
        conv_weight(w_dn + (size_t)l * DFF * DM, DFF, DM, WtDn + (size_t)l * DM * DFF, nullptr, 0, gtid, nthr);
    }
    for (int it = gtid; it < SEQ * 64; it += nthr) {
        const int pos = it >> 6, i = it & 63;
        const float inv = ex2(-(float)i * (13.287712379549449f / 64.0f));
        const float ang = (float)pos * inv;
        const double rev = (double)ang * 0.15915494309189535;
        const float fr = (float)(rev - __builtin_floor(rev));
        rcos[it] = __builtin_amdgcn_cosf(fr); rsin[it] = __builtin_amdgcn_sinf(fr);
    }
    for (int r = gw; r < MT; r += ngw) {
        const float* xr = r < MP ? x_prompt + (size_t)r * DM : x_sample + (size_t)(r - MP) * DM;
        float s = 0.f;
#pragma unroll
        for (int q = 0; q < 4; ++q) {
            const f32x4 v = *(const f32x4*)(xr + 256 * q + 4 * lane);
            u32x2 p; p.x = pk2(v[0], v[1]); p.y = pk2(v[2], v[3]);
            *(u32x2*)(xb + (size_t)r * DM + 256 * q + 4 * lane) = p;
            s += (v[0] * v[0] + v[1] * v[1]) + (v[2] * v[2] + v[3] * v[3]);
        }
        s = wave_sum(s);
        if (lane < 16) ssp[(size_t)r * 16 + lane] = lane == 0 ? s : 0.f;
    }
    grid.sync();
    XcdBarrier bar = xcd_barrier_post(ctl, MISC + 8);

#pragma unroll 1
    for (int l = 0; l < DEPTH; ++l) {
        {
            const bf16_t* Bw = WtIn + (size_t)l * NIN * DM;
            pg8::EpiIn E{proj, ssp, rcos, rsin, out + O_CONVP + (size_t)l * NBATCH * 1024, out + O_CONVS + (size_t)l * DBATCH * 1024};
            { pg8::Gemm g{xb, Bw, MP, NIN, DM, DM}; pg8::StaticOrder S; S.init(MP, NIN, G, bx); pg8::gemm_phase<pg8::EpiIn, pg8::StaticOrder, true, true>(lds, g, S, E); }
#pragma unroll 1
            for (int s = 0; s < DM / 256; ++s) {
                pg8::Gemm g{xb + s * 256, Bw + s * 256, MT, NIN, DM, kslice}; pg8::SliceOrder S{s * (NIN / 256), NIN / 256, bx};
                pg8::SplitEpi<pg8::EpiIn> E2{E, part, ctl + CW_CNT + (l * 4 + 0) * 128, s, DM / 256};
                pg8::gemm_phase<pg8::SplitEpi<pg8::EpiIn>, pg8::SliceOrder, false, true>(lds, g, S, E2);
            }
        }
        xcd_barrier(bar);
        for (int it = bx; it < 288; it += G) {
            if (it < 224) {
                const int b = it / 28, rem = it - b * 28, h = rem / 7, sg = rem - h * 7;
                ret_item(lds, proj, mix, b * SEQ + sg * 512, 8, 64, h, head_lg2(h), false, 0, nullptr, 0, sseg + (size_t)((b * 4 + h) * 8 + sg) * 16384, nullptr);
            } else {
                const int si = it - 224, b = si >> 2, h = si & 3;
                ret_item(lds, proj, mix, MP + b * DSEQ, 1, DSEQ, h, head_lg2(h), true, 2, state_ret + (size_t)((l * DBATCH + b) * 4 + h) * 16384, 0,
                         out + O_RETS + (size_t)((l * DBATCH + b) * 4 + h) * 16384, ret_norm_w + l * 512);
            }
        }
        conv_phase(proj, mix, conv_w + (size_t)l * 512 * 3, state_conv + (size_t)l * DBATCH * 1024, gtid, nthr);
        xcd_barrier(bar);
        for (int it = bx; it < 256; it += G) {
            const int b = it >> 5, h = (it >> 3) & 3, sg = it & 7;
            ret_item(lds, proj, mix, b * SEQ + sg * 512, 8, 64, h, head_lg2(h), true, sg > 0 ? 1 : 0, sseg + (size_t)((b * 4 + h) * 8) * 16384, sg,
                     sg == 7 ? out + O_RETP + (size_t)((l * NBATCH + b) * 4 + h) * 16384 : nullptr, ret_norm_w + l * 512);
        }
        xcd_barrier(bar);
        {
            const bf16_t* Bw = WtOut + (size_t)l * DM * DM;
            pg8::EpiRes E{l == 0 ? x_prompt : X, l == 0 ? x_sample : X + (size_t)MP * DM, X, xb, ssp};
            { pg8::Gemm g{mix, Bw, MP, DM, DM, DM}; pg8::StaticOrder S; S.init(MP, DM, G, bx); pg8::gemm_phase<pg8::EpiRes, pg8::StaticOrder, true, true>(lds, g, S, E); }
#pragma unroll 1
            for (int s = 0; s < DM / 256; ++s) {
                pg8::Gemm g{mix + s * 256, Bw + s * 256, MT, DM, DM, kslice}; pg8::SliceOrder S{s * (DM / 256), DM / 256, bx};
                pg8::SplitEpi<pg8::EpiRes> E2{E, part, ctl + CW_CNT + (l * 4 + 1) * 128, s, DM / 256};
                pg8::gemm_phase<pg8::SplitEpi<pg8::EpiRes>, pg8::SliceOrder, false, true>(lds, g, S, E2);
            }
        }
        xcd_barrier(bar);
        {
            const bf16_t* Bw = WtUp + (size_t)l * DFF * DM;
            pg8::EpiUp E{Hb, ssp};
            { pg8::Gemm g{xb, Bw, MP, DFF, DM, DM}; pg8::StaticOrder S; S.init(MP, DFF, G, bx); pg8::gemm_phase<pg8::EpiUp, pg8::StaticOrder, true, true>(lds, g, S, E); }
#pragma unroll 1
            for (int s = 0; s < DM / 256; ++s) {
                pg8::Gemm g{xb + s * 256, Bw + s * 256, MT, DFF, DM, kslice}; pg8::SliceOrder S{s * (DFF / 256), DFF / 256, bx};
                pg8::SplitEpi<pg8::EpiUp> E2{E, part, ctl + CW_CNT + (l * 4 + 2) * 128, s, DM / 256};
                pg8::gemm_phase<pg8::SplitEpi<pg8::EpiUp>, pg8::SliceOrder, false, true>(lds, g, S, E2);
            }
        }
        xcd_barrier(bar);
        {
            const bf16_t* Bw = WtDn + (size_t)l * DM * DFF;
            pg8::EpiRes E{X, X + (size_t)MP * DM, X, xb, ssp};
            { pg8::Gemm g{Hb, Bw, MP, DM, DFF, DFF}; pg8::StaticOrder S; S.init(MP, DM, G, bx); pg8::gemm_phase<pg8::EpiRes, pg8::StaticOrder, true, true>(lds, g, S, E); }
#pragma unroll 1
            for (int s = 0; s < 4; ++s) {
                pg8::Gemm g{Hb + s * 1024, Bw + s * 1024, MT, DM, DFF, 4 * kslice}; pg8::SliceOrder S{s * (DM / 256), DM / 256, bx};
                pg8::SplitEpi<pg8::EpiRes> E2{E, part, ctl + CW_CNT + (l * 4 + 3) * 128, s, 4};
                pg8::gemm_phase<pg8::SplitEpi<pg8::EpiRes>, pg8::SliceOrder, false, true>(lds, g, S, E2);
            }
        }
        xcd_barrier(bar);
    }
    for (int r = gw; r < MT; r += ngw) {
        const float rs = pg8::row_rstd(ssp, r);
        float* xr = X + (size_t)r * DM;
#pragma unroll
        for (int q = 0; q < 4; ++q) {
            const f32x4 v = *(const f32x4*)(xr + 256 * q + 4 * lane), wv = *(const f32x4*)(ln_f_w + 256 * q + 4 * lane);
            *(f32x4*)(xr + 256 * q + 4 * lane) = v * rs * wv;
        }
    }
}

extern "C" void kernel_launch(void* const* d_in, const int* in_sizes, int n_in, void* d_out, int out_size, void* d_ws, size_t ws_size, hipStream_t stream) {
    static int grid = 0;
    if (grid == 0) {
        int dev = 0, cus = 0, per_cu = 0;
        if (n_in != 13 || ws_size < WS_END) { fprintf(stderr, "kernel_launch: unexpected n_in %d / ws_size %zu (need %zu)\n", n_in, ws_size, (size_t)WS_END); grid = -1; return; }
        hipGetDevice(&dev);
        hipDeviceGetAttribute(&cus, hipDeviceAttributeMultiprocessorCount, dev);
        hipFuncSetAttribute((const void*)hymba_fwd, hipFuncAttributeMaxDynamicSharedMemorySize, LDS_BYTES);
        hipOccupancyMaxActiveBlocksPerMultiprocessor(&per_cu, (const void*)hymba_fwd, NTHR, LDS_BYTES);
        if (per_cu < 1) { fprintf(stderr, "kernel_launch: occupancy query says %d blocks/CU\n", per_cu); per_cu = 1; }
        (void)hipGetLastError();
        grid = cus;
    }
    if (grid < 0) return;
    Args a{};
    for (int i = 0; i < 13; ++i) a.in[i] = (const float*)d_in[i];
    a.out = (float*)d_out; a.ws = (unsigned char*)d_ws;
    void* kargs[] = {&a};
    hipError_t e = hipLaunchCooperativeKernel((const void*)hymba_fwd, dim3(grid), dim3(NTHR), kargs, LDS_BYTES, stream);
    if (e != hipSuccess) fprintf(stderr, "cooperative launch failed: %s (grid %d)\n", hipGetErrorString(e), grid);
}
```

```cpp
#include <hip/hip_runtime.h>
#include <hip/hip_cooperative_groups.h>
#include <cstdio>
#include <cstdint>
namespace cg = cooperative_groups;
namespace pg8 {
#define PG8_LAS __attribute__((address_space(3)))
typedef unsigned short bf16_t;
typedef short bf16x8 __attribute__((ext_vector_type(8)));
typedef float f32x4 __attribute__((ext_vector_type(4)));
typedef unsigned u32x4 __attribute__((ext_vector_type(4)));
constexpr int BM = 256, BK = 64, HALF = 128, HTB = HALF * BK * 2  , STAGE_BYTES = 8 * HTB, NXCD = 8, WGM = 8;

__host__ __device__ __forceinline__ int lds_byte(int r, int c) { const int st = (r >> 4) * 2 + (c >> 5), rr = r & 15, cc = c & 31, ob = rr * 64 + cc * 2; return st * 1024 + (ob ^ (((ob >> 9) & 1) << 5)); }
__host__ __device__ __forceinline__ void stage_rc(int b, int& R, int& C) { const int st = b / 1024, sb = b % 1024, swz = sb ^ (((sb >> 9) & 1) << 5); R = (st >> 1) * 16 + swz / 64; C = (st & 1) * 32 + (swz % 64) / 2; }
__host__ __device__ __forceinline__ int perm32(int rho) { const int n = rho >> 4, i = rho & 15; return 8 * (i >> 2) + 4 * n + (i & 3); }

struct Unit { int pm, pn, idx; };
struct Gemm { const bf16_t* A; const bf16_t* Bt; int M, N, K, Kloop; };

struct StaticOrder {
    int nM, nN, nwg, G, c;
    __host__ __device__ __forceinline__ void init(int M, int N, int G_, int c_) { nM = M / BM; nN = N / BM; nwg = nM * nN; G = G_; c = c_; }
    __host__ __device__ __forceinline__ void map(int L, int& pm, int& pn) const {
        int wgid = L; { const int q = nwg / NXCD, r = nwg % NXCD, xcd = wgid % NXCD, off = wgid / NXCD; wgid = (xcd < r ? xcd * (q + 1) : r * (q + 1) + (xcd - r) * q) + off; }
        const int nig = WGM * nN, gid = wgid / nig, fm = gid * WGM, gsz = (nM - fm) < WGM ? (nM - fm) : WGM;
        pm = fm + ((wgid % nig) % gsz); pn = (wgid % nig) / gsz;
    }
    __host__ __device__ __forceinline__ bool next(int i, Unit& u) const {
        const long L = (long)i * G + c; if (L >= nwg) return false;
        int wgid = (int)L; { const int q = nwg / NXCD, r = nwg % NXCD, xcd = wgid % NXCD, off = wgid / NXCD; wgid = (xcd < r ? xcd * (q + 1) : r * (q + 1) + (xcd - r) * q) + off; }
        const int nig = WGM * nN, gid = wgid / nig, fm = gid * WGM, gsz = (nM - fm) < WGM ? (nM - fm) : WGM;
        u.pm = fm + ((wgid % nig) % gsz); u.pn = (wgid % nig) / gsz; u.idx = i; return true;
    }
    __device__ __forceinline__ void a_ready(const Unit&) const {}
    __device__ __forceinline__ void done(const Unit&) const {}
};

__device__ __forceinline__ unsigned cvt_pk_bf16(float lo, float hi) { unsigned r; asm volatile("v_cvt_pk_bf16_f32 %0, %1, %2" : "=v"(r) : "v"(lo), "v"(hi)); return r; }
typedef float f32x2 __attribute__((ext_vector_type(2)));

constexpr int DM = 1024, NBATCH = 8, SEQ = 4096, DEPTH = 2, DBATCH = 16, DSEQ = 16, PAST = 2048;
constexpr int MP = NBATCH * SEQ, MS = DBATCH * DSEQ, MT = MP + MS;
constexpr int NIN = 3584, DFF = 4096, LDP = 3072;
constexpr float RMS_EPS = 1e-6f, GN_EPS = 1e-5f;

__device__ __forceinline__ void store8bf(bf16_t* p, const f32x4 a, const f32x4 b) {
    u32x4 w; w.x = cvt_pk_bf16(a[0], a[1]); w.y = cvt_pk_bf16(a[2], a[3]); w.z = cvt_pk_bf16(b[0], b[1]); w.w = cvt_pk_bf16(b[2], b[3]);
    *(u32x4*)p = w;
}
__device__ __forceinline__ float row_rstd(const float* ssp, int r) {
    const f32x4* sp = (const f32x4*)(ssp + (size_t)r * 16);
    const f32x4 s0 = sp[0], s1 = sp[1], s2 = sp[2], s3 = sp[3];
    const f32x4 s = (s0 + s1) + (s2 + s3);
    const float tot = (s[0] + s[1]) + (s[2] + s[3]);
    return __builtin_amdgcn_rsqf(tot * (1.0f / DM) + RMS_EPS);
}
__device__ __forceinline__ float silu_f(float x) { return x * __builtin_amdgcn_rcpf(1.0f + __builtin_amdgcn_exp2f(-1.4426950408889634f * x)); }

struct EpiIn {
    static constexpr bool PERM = true, AFTER_DRAIN = false;
    bf16_t* proj; const PG8_LAS float* rbuf; float* nconv_p; float* nconv_s;
    __device__ __forceinline__ void operator()(f32x4 (&acc)[2][2][4][2], const Unit& u, int wr, int wc, int fr, int fq) const {
        const int pn = u.pn, tcol = wc * 32 + 8 * fq;
        const PG8_LAS float* rb = rbuf + u.idx * BM + wr * 64 + fr;
        if (pn < 4) {
            const int i0 = 32 * (wc & 1) + 8 * fq;
            float ir[8];
#pragma unroll
            for (int e = 0; e < 8; ++e) ir[e] = __builtin_amdgcn_exp2f(-(float)(i0 + e) * (13.287712379549449f / 64.0f)) * 0.15915494309189535f;
            const int dcol = (pn < 2 ? 0 : 512) + 128 * (2 * (pn & 1) + (wc >> 1)) + i0;
#pragma unroll
            for (int ai = 0; ai < 2; ++ai)
#pragma unroll
                for (int m = 0; m < 4; ++m) {
                    const int r = u.pm * BM + ai * HALF + wr * 64 + m * 16 + fr;
                    const float rs = rb[ai * HALF + m * 16];
                    float fp = (float)(r < MP ? (r & (SEQ - 1)) : PAST + (r & (DSEQ - 1)));
                    asm volatile("" : "+v"(fp) :: "memory");
                    f32x4 o1[2], o2[2];
#pragma unroll
                    for (int n = 0; n < 2; ++n)
#pragma unroll
                        for (int e = 0; e < 4; ++e) {
                            const float rev = fp * ir[4 * n + e], f = __builtin_amdgcn_fractf(rev);
                            const float c = __builtin_amdgcn_cosf(f), s = __builtin_amdgcn_sinf(f);
                            const float x1 = acc[ai][0][m][n][e] * rs, x2 = acc[ai][1][m][n][e] * rs;
                            o1[n][e] = x1 * c - x2 * s; o2[n][e] = x1 * s + x2 * c;
                        }
                    bf16_t* prow = proj + (size_t)r * LDP + dcol;
                    store8bf(prow, o1[0], o1[1]); store8bf(prow + 64, o2[0], o2[1]);
                }
        } else {
#pragma unroll
            for (int ai = 0; ai < 2; ++ai)
#pragma unroll
                for (int m = 0; m < 4; ++m) {
                    const int r = u.pm * BM + ai * HALF + wr * 64 + m * 16 + fr;
                    const float rs = rb[ai * HALF + m * 16];
                    const f32x4 a0 = acc[ai][0][m][0] * rs, a1 = acc[ai][0][m][1] * rs, b0 = acc[ai][1][m][0] * rs, b1 = acc[ai][1][m][1] * rs;
                    bf16_t* prow = proj + (size_t)r * LDP;
                    if (pn < 10) {
                        f32x4 x0 = a0, x1 = a1, y0 = b0, y1 = b1;
                        if (pn == 6 || pn == 7) {
#pragma unroll
                            for (int e = 0; e < 4; ++e) { x0[e] = silu_f(x0[e]); x1[e] = silu_f(x1[e]); y0[e] = silu_f(y0[e]); y1[e] = silu_f(y1[e]); }
                        }
                        const int dcol = 256 * pn + tcol;
                        store8bf(prow + dcol, x0, x1); store8bf(prow + dcol + 128, y0, y1);
                    } else {
                        const f32x4 u0 = a0 * b0, u1 = a1 * b1;
                        const int cc = 128 * (pn - 10) + tcol;
                        store8bf(prow + 2560 + cc, u0, u1);
                        if (r < MP) { const int t = r & (SEQ - 1); if (t >= SEQ - 2) { float* d = nconv_p + (size_t)((r >> 12) * 2 + (t - (SEQ - 2))) * 512 + cc; *(f32x4*)d = u0; *(f32x4*)(d + 4) = u1; } }
                        else { const int t = r & (DSEQ - 1); if (t >= DSEQ - 2) { float* d = nconv_s + (size_t)(((r - MP) >> 4) * 2 + (t - (DSEQ - 2))) * 512 + cc; *(f32x4*)d = u0; *(f32x4*)(d + 4) = u1; } }
                    }
                }
        }
    }
};
struct EpiRes {
    static constexpr bool PERM = false, AFTER_DRAIN = false;
    const float* xs_main; const float* xs_tail; float* X; bf16_t* xb; float* ssp;
    __device__ __forceinline__ void operator()(f32x4 (&acc)[2][2][4][2], const Unit& u, int wr, int wc, int fr, int fq) const {
        typedef unsigned u32x2v __attribute__((ext_vector_type(2)));
        const int cb = u.pn * BM + wc * 32 + 4 * fq;
#pragma unroll
        for (int g = 0; g < 4; ++g) {
            const int ai = g >> 1, mb = (g & 1) * 2;
            const int r0 = u.pm * BM + ai * HALF + wr * 64 + mb * 16 + fr;
            const float* xs = (r0 < MP ? xs_main + (size_t)r0 * DM : xs_tail + (size_t)(r0 - MP) * DM) + cb;
            f32x4 xv[2][2][2];
#pragma unroll
            for (int m = 0; m < 2; ++m)
#pragma unroll
                for (int bj = 0; bj < 2; ++bj)
#pragma unroll
                    for (int n = 0; n < 2; ++n) xv[m][bj][n] = *(const f32x4*)(xs + (size_t)m * 16 * DM + bj * HALF + n * 16);
#pragma unroll
            for (int m = 0; m < 2; ++m) {
                const int r = r0 + m * 16;
                float ss = 0.f;
#pragma unroll
                for (int bj = 0; bj < 2; ++bj)
#pragma unroll
                    for (int n = 0; n < 2; ++n) {
                        const int c = cb + bj * HALF + n * 16;
                        const f32x4 v = xv[m][bj][n] + acc[ai][bj][mb + m][n];
                        *(f32x4*)(X + (size_t)r * DM + c) = v;
                        u32x2v w; w.x = cvt_pk_bf16(v[0], v[1]); w.y = cvt_pk_bf16(v[2], v[3]);
                        *(u32x2v*)(xb + (size_t)r * DM + c) = w;
                        ss += (v[0] * v[0] + v[1] * v[1]) + (v[2] * v[2] + v[3] * v[3]);
                    }
                ss += __shfl_xor(ss, 16); ss += __shfl_xor(ss, 32);
                if (fq == 0) ssp[(size_t)r * 16 + 4 * u.pn + wc] = ss;
            }
            asm volatile("" ::: "memory");
        }
    }
};
struct EpiUp {
    static constexpr bool PERM = true, AFTER_DRAIN = false;
    bf16_t* H; const PG8_LAS float* rbuf;
    __device__ __forceinline__ void operator()(f32x4 (&acc)[2][2][4][2], const Unit& u, int wr, int wc, int fr, int fq) const {
        const PG8_LAS float* rb = rbuf + u.idx * BM + wr * 64 + fr;
#pragma unroll
        for (int ai = 0; ai < 2; ++ai)
#pragma unroll
            for (int m = 0; m < 4; ++m) {
                const int r = u.pm * BM + ai * HALF + wr * 64 + m * 16 + fr;
                const float rs = rb[ai * HALF + m * 16];
                bf16_t* hrow = H + (size_t)r * DFF + u.pn * BM + wc * 32 + 8 * fq;
#pragma unroll
                for (int bj = 0; bj < 2; ++bj) {
                    f32x4 v0 = acc[ai][bj][m][0] * rs, v1 = acc[ai][bj][m][1] * rs;
#pragma unroll
                    for (int e = 0; e < 4; ++e) { const float p = fmaxf(v0[e], 0.f), q = fmaxf(v1[e], 0.f); v0[e] = p * p; v1[e] = q * q; }
                    store8bf(hrow + bj * HALF, v0, v1);
                }
            }
    }
};
template <class Sched> __device__ __forceinline__ void rstd_prepass(PG8_LAS float* rbuf, const float* ssp, const Sched& S) {
    int tid = threadIdx.x; asm volatile("" : "+v"(tid));
    const int row = tid >> 1, half = tid & 1;
    Unit u;
    for (int i = 0; S.next(i, u); ++i) {
        const f32x4* sp = (const f32x4*)(ssp + (size_t)(u.pm * BM + row) * 16 + half * 8);
        const f32x4 a = sp[0], b = sp[1];
        float t = ((a[0] + a[1]) + (a[2] + a[3])) + ((b[0] + b[1]) + (b[2] + b[3]));
        t += __shfl_xor(t, 1);
        if (half == 0) rbuf[i * BM + row] = __builtin_amdgcn_rsqf(t * (1.0f / DM) + RMS_EPS);
    }
    __syncthreads();
}
struct SliceOrder {
    int first, nN, c;
    __device__ __forceinline__ bool next(int i, Unit& u) const { const int idx = c - first; u.pm = MP / BM; u.pn = idx; u.idx = 0; return i == 0 && idx >= 0 && idx < nN; }
    __device__ __forceinline__ void a_ready(const Unit&) const {}
    __device__ __forceinline__ void done(const Unit&) const {}
};
__device__ __forceinline__ void ld16_coh(const f32x4* p, f32x4 (&t)[16]) {
    const f32x4 *p0 = p, *p1 = p + 256, *p2 = p + 512, *p3 = p + 768;
    asm volatile(
        "global_load_dwordx4 %0, %16, off sc1\n\tglobal_load_dwordx4 %1, %16, off offset:1024 sc1\n\tglobal_load_dwordx4 %2, %16, off offset:2048 sc1\n\tglobal_load_dwordx4 %3, %16, off offset:3072 sc1\n\t"
        "global_load_dwordx4 %4, %17, off sc1\n\tglobal_load_dwordx4 %5, %17, off offset:1024 sc1\n\tglobal_load_dwordx4 %6, %17, off offset:2048 sc1\n\tglobal_load_dwordx4 %7, %17, off offset:3072 sc1\n\t"
        "global_load_dwordx4 %8, %18, off sc1\n\tglobal_load_dwordx4 %9, %18, off offset:1024 sc1\n\tglobal_load_dwordx4 %10, %18, off offset:2048 sc1\n\tglobal_load_dwordx4 %11, %18, off offset:3072 sc1\n\t"
        "global_load_dwordx4 %12, %19, off sc1\n\tglobal_load_dwordx4 %13, %19, off offset:1024 sc1\n\tglobal_load_dwordx4 %14, %19, off offset:2048 sc1\n\tglobal_load_dwordx4 %15, %19, off offset:3072 sc1\n\t"
        "s_waitcnt vmcnt(0)"
        : "=&v"(t[0]), "=&v"(t[1]), "=&v"(t[2]), "=&v"(t[3]), "=&v"(t[4]), "=&v"(t[5]), "=&v"(t[6]), "=&v"(t[7]),
          "=&v"(t[8]), "=&v"(t[9]), "=&v"(t[10]), "=&v"(t[11]), "=&v"(t[12]), "=&v"(t[13]), "=&v"(t[14]), "=&v"(t[15])
        : "v"(p0), "v"(p1), "v"(p2), "v"(p3) : "memory");
}
template <class E> struct SplitEpi {
    static constexpr bool PERM = E::PERM, AFTER_DRAIN = false;
    E e; float* part; unsigned* cnt; int slice, nsl;
    __device__ __forceinline__ void operator()(f32x4 (&acc)[2][2][4][2], const Unit& u, int wr, int wc, int fr, int fq) const {
        const int wid = wr * 4 + wc, lane = fq * 16 + fr;
        f32x4* base = (f32x4*)part + (size_t)(u.pn * 8 + wid) * 32 * 64 + lane;
        const size_t sstride = (size_t)16 * 8 * 32 * 64;
        f32x4* dst = base + (size_t)slice * sstride;
#pragma unroll
        for (int q = 0; q < 32; ++q) asm volatile("global_store_dwordx4 %0, %1, off sc1\n\ts_nop 2" :: "v"(dst + q * 64), "v"(acc[q >> 4][(q >> 3) & 1][(q >> 1) & 3][q & 1]) : "memory");
        asm volatile("s_waitcnt vmcnt(0)" ::: "memory");
        unsigned old = 0u;
        if (lane == 0) old = __hip_atomic_fetch_add(cnt + u.pn * 8 + wid, 1u, __ATOMIC_RELAXED, __HIP_MEMORY_SCOPE_AGENT);
        old = (unsigned)__builtin_amdgcn_readfirstlane((int)old);
        if (old + 1u == (unsigned)nsl) {
            __builtin_amdgcn_fence(__ATOMIC_ACQUIRE, "agent");
#pragma unroll
            for (int q = 0; q < 32; ++q) acc[q >> 4][(q >> 3) & 1][(q >> 1) & 3][q & 1] = (f32x4){0.f, 0.f, 0.f, 0.f};
#pragma unroll 1
            for (int sl = 0; sl < nsl; ++sl) {
                const f32x4* src = base + (size_t)sl * sstride;
#pragma unroll
                for (int hb = 0; hb < 2; ++hb) {
                    f32x4 t[16]; ld16_coh(src + hb * 16 * 64, t);
#pragma unroll
                    for (int i = 0; i < 16; ++i) { const int q = hb * 16 + i; acc[q >> 4][(q >> 3) & 1][(q >> 1) & 3][q & 1] += t[i]; }
                }
            }
            e(acc, u, wr, wc, fr, fq);
        }
    }
};
template <class Epi, class Sched, bool ALIGN_EPI = false, bool SP2 = false>
__device__ __forceinline__ void gemm_phase(PG8_LAS unsigned char* lds, const Gemm g, const Sched& S, const Epi& E) {
    int tid_o = threadIdx.x; asm volatile("" : "+v"(tid_o));
    const int tid = tid_o, wid = __builtin_amdgcn_readfirstlane(tid >> 6), lane = tid & 63, wr = wid >> 2, wc = wid & 3, fr = lane & 15, fq = lane >> 4;
    const int K = g.K, nt = g.Kloop / BK;
    unsigned voffA[2], voffB[2];
#pragma unroll
    for (int i = 0; i < 2; ++i) { int R, C; stage_rc(tid * 16 + i * 8192, R, C); const int Rb = Epi::PERM ? ((R & ~31) + perm32(R & 31)) : R;
        voffA[i] = (unsigned)(R * K + C) * 2u; voffB[i] = (unsigned)(Rb * K + C) * 2u; }
    const size_t kstep = (size_t)(BK * 2);
    const size_t hstep = (size_t)HALF * K * 2;
    const size_t tstep = 2 * hstep;
    const unsigned ldsw = (unsigned)wid * 1024u;
    const int aoff = lds_byte(wr * 64 + fr, fq * 8), boff = lds_byte(wc * 32 + fr, fq * 8);
#define PG8_SA(b, h) (((b) * 2 + (h)) * HTB)
#define PG8_SB(b, h) ((4 + (b) * 2 + (h)) * HTB)
#define PG8_STAGE(bufoff, gbase, voff) do { _Pragma("unroll") for (int _i = 0; _i < 2; ++_i) \
        __builtin_amdgcn_global_load_lds((const unsigned*)((const char*)(gbase) + (voff)[_i]), (PG8_LAS unsigned*)(lds + (bufoff) + ldsw + _i * 8192), 16, 0, 0); } while (0)
#define PG8_LDA(dst, b, h) do { _Pragma("unroll") for (int m = 0; m < 4; ++m) _Pragma("unroll") for (int k = 0; k < 2; ++k) dst[m][k] = *(const PG8_LAS bf16x8*)(lds + PG8_SA(b, h) + aoff + m * 2048 + k * 1024); } while (0)
#define PG8_LDB(dst, b, h) do { _Pragma("unroll") for (int n = 0; n < 2; ++n) _Pragma("unroll") for (int k = 0; k < 2; ++k) dst[n][k] = *(const PG8_LAS bf16x8*)(lds + PG8_SB(b, h) + boff + n * 2048 + k * 1024); } while (0)
#define PG8_MMA(ai, bj, At, Bt) do { __builtin_amdgcn_s_setprio(1); _Pragma("unroll") for (int m = 0; m < 4; ++m) _Pragma("unroll") for (int n = 0; n < 2; ++n) _Pragma("unroll") for (int k = 0; k < 2; ++k) \
        acc[ai][bj][m][n] = __builtin_amdgcn_mfma_f32_16x16x32_bf16(Bt[n][k], At[m][k], acc[ai][bj][m][n], 0, 0, 0); __builtin_amdgcn_s_setprio(0); } while (0)
#define PG8_WAIT_V(n) asm volatile("s_waitcnt vmcnt(" #n ")" ::: "memory")
#define PG8_WAIT_L(n) asm volatile("s_waitcnt lgkmcnt(" #n ")" ::: "memory")
#define PG8_BAR __builtin_amdgcn_s_barrier()
#define PG8_SCHED __builtin_amdgcn_sched_barrier(0)
    Unit cur, nxt; int ui = 0;
    if (!S.next(0, cur)) return;
    f32x4 acc[2][2][4][2];
#pragma unroll
    for (int a = 0; a < 2; ++a)
#pragma unroll
        for (int b = 0; b < 2; ++b)
#pragma unroll
            for (int m = 0; m < 4; ++m)
#pragma unroll
                for (int n = 0; n < 2; ++n) acc[a][b][m][n] = (f32x4){0.f, 0.f, 0.f, 0.f};
    bf16x8 At[4][2], B0[2][2], B1[2][2];
    const char* cA = (const char*)g.A + (size_t)cur.pm * tstep; const char* cB = (const char*)g.Bt + (size_t)cur.pn * tstep;
    S.a_ready(cur);
    if constexpr (SP2) {
        PG8_STAGE(PG8_SB(0, 0), cB, voffB); PG8_STAGE(PG8_SB(0, 1), cB + hstep, voffB); PG8_STAGE(PG8_SA(0, 0), cA, voffA); PG8_STAGE(PG8_SA(0, 1), cA + hstep, voffA);
        if (wr == 1) PG8_BAR;
        PG8_WAIT_V(2); PG8_BAR;
        PG8_STAGE(PG8_SB(1, 0), cB + kstep, voffB); PG8_STAGE(PG8_SA(1, 0), cA + kstep, voffA); PG8_STAGE(PG8_SB(1, 1), cB + hstep + kstep, voffB);
        PG8_WAIT_V(6); PG8_BAR;
    } else {
        PG8_STAGE(PG8_SB(0, 0), cB, voffB); PG8_STAGE(PG8_SA(0, 0), cA, voffA); PG8_STAGE(PG8_SB(0, 1), cB + hstep, voffB); PG8_STAGE(PG8_SA(0, 1), cA + hstep, voffA);
        if (wr == 1) PG8_BAR;
        PG8_WAIT_V(4); PG8_BAR;
        PG8_STAGE(PG8_SB(1, 0), cB + kstep, voffB); PG8_STAGE(PG8_SA(1, 0), cA + kstep, voffA); PG8_STAGE(PG8_SB(1, 1), cB + hstep + kstep, voffB);
        PG8_WAIT_V(6); PG8_BAR;
    }
    for (;;) {
        const bool has_next = S.next(ui + 1, nxt);
        const char* nA = has_next ? (const char*)g.A + (size_t)nxt.pm * tstep : cA; const char* nB = has_next ? (const char*)g.Bt + (size_t)nxt.pn * tstep : cB;
        for (int t = 0; t < nt; t += 2) {
            const bool last = (t == nt - 2);
            const char* a1 = cA + (size_t)(t + 1) * kstep;
            const char* a2 = last ? nA : cA + (size_t)(t + 2) * kstep; const char* b2 = last ? nB : cB + (size_t)(t + 2) * kstep;
            const char* a3 = a2 + kstep; const char* b3 = b2 + kstep;
            if (last && has_next) S.a_ready(nxt);
            if constexpr (SP2) {
            PG8_LDB(B0, 0, 0); PG8_LDB(B1, 0, 1); PG8_SCHED; PG8_LDA(At, 0, 0); PG8_STAGE(PG8_SA(1, 1), a1 + hstep, voffA);
            PG8_WAIT_V(8); PG8_WAIT_L(0); PG8_BAR; PG8_MMA(0, 0, At, B0); PG8_MMA(0, 1, At, B1); PG8_BAR; PG8_SCHED;
            PG8_LDA(At, 0, 1); PG8_STAGE(PG8_SB(0, 0), b2, voffB); PG8_STAGE(PG8_SB(0, 1), b2 + hstep, voffB); PG8_STAGE(PG8_SA(0, 0), a2, voffA);
            PG8_WAIT_V(8); PG8_WAIT_L(0); PG8_BAR; PG8_MMA(1, 0, At, B0); PG8_MMA(1, 1, At, B1); PG8_BAR; PG8_SCHED;
            PG8_LDB(B0, 1, 0); PG8_LDB(B1, 1, 1); PG8_SCHED; PG8_LDA(At, 1, 0); PG8_STAGE(PG8_SA(0, 1), a2 + hstep, voffA);
            PG8_WAIT_V(8); PG8_WAIT_L(0); PG8_BAR; PG8_MMA(0, 0, At, B0); PG8_MMA(0, 1, At, B1); PG8_BAR; PG8_SCHED;
            PG8_LDA(At, 1, 1); PG8_STAGE(PG8_SB(1, 0), b3, voffB); PG8_STAGE(PG8_SB(1, 1), b3 + hstep, voffB); PG8_STAGE(PG8_SA(1, 0), a3, voffA);
            PG8_WAIT_V(8); PG8_WAIT_L(0); PG8_BAR; PG8_MMA(1, 0, At, B0); PG8_MMA(1, 1, At, B1); PG8_BAR; PG8_SCHED;
            } else {
            PG8_LDB(B0, 0, 0); PG8_SCHED; PG8_LDA(At, 0, 0); PG8_STAGE(PG8_SA(1, 1), a1 + hstep, voffA);
            PG8_WAIT_L(8); PG8_BAR; PG8_WAIT_L(0); PG8_MMA(0, 0, At, B0); PG8_BAR; PG8_SCHED;
            PG8_LDB(B1, 0, 1); PG8_STAGE(PG8_SB(0, 0), b2, voffB);
            PG8_BAR; PG8_WAIT_L(0); PG8_MMA(0, 1, At, B1); PG8_BAR;
            PG8_LDA(At, 0, 1); PG8_STAGE(PG8_SA(0, 0), a2, voffA);
            PG8_BAR; PG8_WAIT_L(0); PG8_MMA(1, 0, At, B0); PG8_BAR; PG8_SCHED;
            PG8_STAGE(PG8_SB(0, 1), b2 + hstep, voffB);
            PG8_WAIT_V(6); PG8_BAR; PG8_MMA(1, 1, At, B1); PG8_BAR;
            PG8_LDB(B0, 1, 0); PG8_SCHED; PG8_LDA(At, 1, 0); PG8_STAGE(PG8_SA(0, 1), a2 + hstep, voffA);
            PG8_WAIT_L(8); PG8_BAR; PG8_WAIT_L(0); PG8_MMA(0, 0, At, B0); PG8_BAR; PG8_SCHED;
            PG8_LDB(B1, 1, 1); PG8_STAGE(PG8_SB(1, 0), b3, voffB);
            PG8_BAR; PG8_WAIT_L(0); PG8_MMA(0, 1, At, B1); PG8_BAR;
            PG8_LDA(At, 1, 1); PG8_STAGE(PG8_SA(1, 0), a3, voffA);
            PG8_BAR; PG8_WAIT_L(0); PG8_MMA(1, 0, At, B0); PG8_BAR; PG8_SCHED;
            PG8_STAGE(PG8_SB(1, 1), b3 + hstep, voffB);
            PG8_WAIT_V(6); PG8_BAR; PG8_MMA(1, 1, At, B1); PG8_BAR;
            }
        }
        if constexpr (ALIGN_EPI) { if (wr == 0) PG8_BAR; }
        if constexpr (!Epi::AFTER_DRAIN) { E(acc, cur, wr, wc, fr, fq); S.done(cur); }
        if (!has_next) break;
#pragma unroll
        for (int a = 0; a < 2; ++a)
#pragma unroll
            for (int b = 0; b < 2; ++b)
#pragma unroll
                for (int m = 0; m < 4; ++m)
#pragma unroll
                    for (int n = 0; n < 2; ++n) acc[a][b][m][n] = (f32x4){0.f, 0.f, 0.f, 0.f};
        cur = nxt; cA = nA; cB = nB; ++ui;
        if constexpr (ALIGN_EPI) { if (wr == 1) PG8_BAR; }
    }
    PG8_WAIT_V(0);
    if constexpr (!ALIGN_EPI) { if (wr == 0) PG8_BAR; }
    PG8_BAR;
    if constexpr (Epi::AFTER_DRAIN) { E.fused(acc, cur, wr, wc, fr, fq, lds, wid, lane); S.done(cur); }
#undef PG8_SA
#undef PG8_SB
#undef PG8_STAGE
#undef PG8_LDA
#undef PG8_LDB
#undef PG8_MMA
#undef PG8_WAIT_V
#undef PG8_WAIT_L
#undef PG8_BAR
#undef PG8_SCHED
}
}
#define LAS __attribute__((address_space(3)))
#define XB_TMO      128
#define XB_XCNT(j)  (256  + 64 * (j))
#define XB_XSUB(j)  (1280 + 64 * (j))
#define XB_XGEN(j)  (2304 + 64 * (j))
#define XB_TOP      3328
#define XB_TOPGEN   3392
#define XCD_BAR_WORDS 3456
#define XB_SPIN_CAP (1u << 18)

__device__ __forceinline__ unsigned xb_ld(unsigned* p)              { return __hip_atomic_load(p, __ATOMIC_RELAXED, __HIP_MEMORY_SCOPE_AGENT); }
__device__ __forceinline__ unsigned xb_add(unsigned* p, unsigned v) { return __hip_atomic_fetch_add(p, v, __ATOMIC_RELAXED, __HIP_MEMORY_SCOPE_AGENT); }
__device__ __forceinline__ unsigned xb_xcc_id() { return (unsigned)__builtin_amdgcn_s_getreg((3 << 11) | 20) & 0xFu; }
#define XB_SPIN(cond, bar) do { unsigned _sp = 0; while (cond) { __builtin_amdgcn_s_sleep(1); \
    if ((++_sp & 255u) == 0u) { if (xb_ld(&(bar)[XB_TMO])) break; if (_sp > XB_SPIN_CAP) { atomicAdd(&(bar)[XB_TMO], 1u); break; } } } } while (0)

struct XcdBarrier {
    unsigned* bar; unsigned x;
    volatile LAS unsigned* st;
};

__device__ __forceinline__ XcdBarrier xcd_barrier_post(unsigned* bar, volatile LAS unsigned* st) {
    XcdBarrier b; b.bar = bar; b.x = xb_xcc_id(); b.st = st;
    if (threadIdx.x == 0) (void)xb_add(&bar[XB_XCNT(b.x)], 1u);
    return b;
}
__device__ __forceinline__ void xcd_barrier_complete(unsigned* bar, unsigned x, unsigned& nloc, unsigned& nx) {
    const unsigned G = gridDim.x * gridDim.y * gridDim.z;
    unsigned sum, cnt, mine, sp = 0u;
    for (;;) {
        sum = 0u; cnt = 0u; mine = 0u;
#pragma unroll
        for (unsigned j = 0; j < 16; ++j) { const unsigned c = xb_ld(&bar[XB_XCNT(j)]); sum += c; cnt += (c > 0u) ? 1u : 0u; mine = (j == x) ? c : mine; }
        if (sum == G) break;
        __builtin_amdgcn_s_sleep(1);
        if ((++sp & 255u) == 0u) { if (xb_ld(&bar[XB_TMO])) break; if (sp > XB_SPIN_CAP) { atomicAdd(&bar[XB_TMO], 1u); break; } }
    }
    nloc = mine > 0u ? mine : 1u; nx = cnt > 0u ? cnt : 1u;
}

__device__ __forceinline__ void xcd_barrier(const XcdBarrier& b) {
    asm volatile("s_waitcnt vmcnt(0)" ::: "memory");
    __syncthreads();
    if (threadIdx.x == 0) {
        unsigned* bar = b.bar;
        __builtin_amdgcn_s_waitcnt(0);
        unsigned nloc = b.st[0], nx = b.st[1];
        if (nloc == 0u) { xcd_barrier_complete(bar, b.x, nloc, nx); b.st[0] = nloc; b.st[1] = nx; }
        const unsigned old = xb_add(&bar[XB_XSUB(b.x)], 1u);
        const unsigned gen = old / nloc;
        if (old + 1u == (gen + 1u) * nloc) {
            __builtin_amdgcn_fence(__ATOMIC_RELEASE, "agent");
            asm volatile("s_waitcnt vmcnt(0)" ::: "memory");
            const unsigned og = xb_add(&bar[XB_TOP], 1u);
            const unsigned tg = og / nx;
            if (og + 1u == (tg + 1u) * nx) xb_add(&bar[XB_TOPGEN], 1u);
            else XB_SPIN(xb_ld(&bar[XB_TOPGEN]) == tg, bar);
            __builtin_amdgcn_fence(__ATOMIC_ACQUIRE, "agent");
            xb_add(&bar[XB_XGEN(b.x)], 1u);
            asm volatile("s_waitcnt vmcnt(0)" ::: "memory");
        } else {
            XB_SPIN(xb_ld(&bar[XB_XGEN(b.x)]) == gen, bar);
            __builtin_amdgcn_fence(__ATOMIC_ACQUIRE, "agent");
            asm volatile("s_waitcnt vmcnt(0)" ::: "memory");
        }
    }
    __syncthreads();
}

using pg8::bf16_t; using pg8::bf16x8; using pg8::f32x4; using pg8::u32x4;
using pg8::DM; using pg8::MP; using pg8::MS; using pg8::MT; using pg8::NIN; using pg8::DFF; using pg8::LDP; using pg8::SEQ; using pg8::DSEQ;
using pg8::NBATCH; using pg8::DBATCH; using pg8::DEPTH;
#define LAS __attribute__((address_space(3)))
typedef unsigned u32x2 __attribute__((ext_vector_type(2)));
typedef float f32x2 __attribute__((ext_vector_type(2)));

constexpr int NTHR = 512;
constexpr int LDS_BYTES = 147456;
constexpr size_t O_YP = 0, O_YS = (size_t)MP * DM, O_RETP = O_YS + (size_t)MS * DM, O_CONVP = O_RETP + (size_t)DEPTH * NBATCH * 4 * 16384,
                 O_RETS = O_CONVP + (size_t)DEPTH * NBATCH * 2 * 512, O_CONVS = O_RETS + (size_t)DEPTH * DBATCH * 4 * 16384;
constexpr size_t MiB = 1u << 20;
constexpr size_t WS_WIN = 0, WS_WOUT = 14 * MiB, WS_WUP = 18 * MiB, WS_WDN = 34 * MiB;
constexpr size_t WS_COS = 50 * MiB, WS_SIN = 51 * MiB, WS_SSP = 52 * MiB, WS_SSEG = 55 * MiB;
constexpr size_t WS_CTL = 54 * MiB + 512 * 1024;
constexpr int CTL_WORDS = 8192, CW_CNT = 4096;
constexpr size_t WS_PART = 400 * MiB;
constexpr size_t WS_XB = 71 * MiB;
constexpr size_t WS_PROJ = 136 * MiB;
constexpr size_t WS_MIX = WS_PROJ + (size_t)MT * LDP * 2;
constexpr size_t WS_H = WS_PROJ;
constexpr size_t WS_END = WS_MIX + (size_t)MT * DM * 2;
static_assert(WS_END <= WS_PART && WS_PART + 64 * MiB <= 512 * MiB && WS_XB + (size_t)MT * DM * 2 <= WS_PROJ && WS_END <= 512 * MiB && WS_H + (size_t)MT * DFF * 2 <= WS_END, "ws map");

__device__ __forceinline__ float bf2f(unsigned b) { return __uint_as_float(b << 16); }
__device__ __forceinline__ unsigned pk2(float lo, float hi) { return pg8::cvt_pk_bf16(lo, hi); }
__device__ __forceinline__ float ex2(float x) { return __builtin_amdgcn_exp2f(x); }
__device__ __forceinline__ f32x4 mma(const bf16x8 x, const bf16x8 y, const f32x4 c) { return __builtin_amdgcn_mfma_f32_16x16x32_bf16(x, y, c, 0, 0, 0); }
__device__ __forceinline__ bf16x8 frag(LAS unsigned char* base, int row, int stride, int kg, int kb) { return *(const LAS bf16x8*)(base + row * stride + 16 * kg + 64 * kb); }

constexpr int R_Q = 0, R_K = 17408, R_KT = 34816, R_VT = 53248, R_SP = 71680, R_RT = 80896, R_ST = 115712;
constexpr int SQ = 272, ST = 144;
__device__ __forceinline__ void ret_item(LAS unsigned char* lds, const bf16_t* proj, bf16_t* mix, int row0, int nchunks, int CL, int h, float lg2, bool full,
                                         int rinit, const float* rsrc, int nprefix, float* rdst, const float* gnw) {
    int tid_o = threadIdx.x; asm volatile("" : "+v"(tid_o));
    const int tid = tid_o, w = __builtin_amdgcn_readfirstlane(tid >> 6), lane = tid & 63, j = lane & 15, ig = lane >> 4;
    f32x4 R[8];
#pragma unroll
    for (int dt = 0; dt < 8; ++dt) {
#pragma unroll
        for (int t = 0; t < 4; ++t) {
            const int idx = (16 * dt + 4 * ig + t) * 128 + 16 * w + j;
            float v = 0.f;
            if (rinit == 2) v = rsrc[idx];
            else if (rinit == 1) { for (int s = 0; s < nprefix; ++s) v += rsrc[(size_t)s * 16384 + idx] * ex2(lg2 * 512.f * (float)(nprefix - 1 - s)); }
            R[dt][t] = v;
        }
    }
    if (full) {
#pragma unroll
        for (int dt = 0; dt < 8; ++dt) { u32x2 p; p.x = pk2(R[dt][0], R[dt][1]); p.y = pk2(R[dt][2], R[dt][3]); *(LAS u32x2*)(lds + R_RT + (16 * w + j) * SQ + (16 * dt + 4 * ig) * 2) = p; }
    }
    const float cdec = ex2(lg2 * (float)CL);
    const float kdec = ex2(lg2 * (float)(CL - 1 - lane));
    u32x4 qreg[2], kreg[2], vreg[2];
    const u32x4 zero4 = (u32x4){0u, 0u, 0u, 0u};
#define RET_LOAD(c) do { _Pragma("unroll") for (int it = 0; it < 2; ++it) { \
        const int qm = (tid + NTHR * it) >> 4, qd = (tid + NTHR * it) & 15, kd = w + 8 * it; \
        const bf16_t* rb = proj + (size_t)(row0 + (c) * 64) * LDP + h * 128; \
        qreg[it] = (full && qm < CL) ? *(const u32x4*)(rb + (size_t)qm * LDP + 8 * qd) : zero4; \
        kreg[it] = (lane < CL) ? *(const u32x4*)(rb + (size_t)lane * LDP + 512 + 8 * kd) : zero4; \
        vreg[it] = (lane < CL) ? *(const u32x4*)(rb + (size_t)lane * LDP + 1024 + 8 * kd) : zero4; } } while (0)
    RET_LOAD(0);
    for (int c = 0; c < nchunks; ++c) {
#pragma unroll
        for (int it = 0; it < 2; ++it) {
            const int qm = (tid + NTHR * it) >> 4, qd = (tid + NTHR * it) & 15, kd = w + 8 * it;
            if (full) { *(LAS u32x4*)(lds + R_Q + qm * SQ + 16 * qd) = qreg[it]; *(LAS u32x4*)(lds + R_K + lane * SQ + 16 * kd) = kreg[it]; }
#pragma unroll
            for (int e = 0; e < 4; ++e) {
                const unsigned kw = kreg[it][e], vw = vreg[it][e];
                const unsigned kp = pk2(bf2f(kw & 0xffffu) * kdec, bf2f(kw >> 16) * kdec);
                *(LAS unsigned short*)(lds + R_KT + (8 * kd + 2 * e) * ST + 2 * lane) = (unsigned short)(kp & 0xffffu);
                *(LAS unsigned short*)(lds + R_KT + (8 * kd + 2 * e + 1) * ST + 2 * lane) = (unsigned short)(kp >> 16);
                *(LAS unsigned short*)(lds + R_VT + (8 * kd + 2 * e) * ST + 2 * lane) = (unsigned short)(vw & 0xffffu);
                *(LAS unsigned short*)(lds + R_VT + (8 * kd + 2 * e + 1) * ST + 2 * lane) = (unsigned short)(vw >> 16);
            }
        }
        if (c + 1 < nchunks) RET_LOAD(c + 1);
        __syncthreads();
        f32x4 o[4];
        if (full) {
            const int mt = w & 3;
#pragma unroll
            for (int q2 = 0; q2 < 2; ++q2) {
                const int nt = 2 * (w >> 2) + q2;
                f32x4 s = (f32x4){0.f, 0.f, 0.f, 0.f};
#pragma unroll
                for (int kb = 0; kb < 4; ++kb) s = mma(frag(lds + R_K, 16 * mt + j, SQ, ig, kb), frag(lds + R_Q, 16 * nt + j, SQ, ig, kb), s);
                const int n = 16 * nt + j, m0 = 16 * mt + 4 * ig;
#pragma unroll
                for (int t = 0; t < 4; ++t) { const int df = n - (m0 + t); s[t] = df >= 0 ? s[t] * ex2(lg2 * (float)df) : 0.f; }
                u32x2 p; p.x = pk2(s[0], s[1]); p.y = pk2(s[2], s[3]);
                *(LAS u32x2*)(lds + R_SP + n * ST + m0 * 2) = p;
            }
            __syncthreads();
            bf16x8 rt[4], vt[2];
#pragma unroll
            for (int kb = 0; kb < 4; ++kb) rt[kb] = frag(lds + R_RT, 16 * w + j, SQ, ig, kb);
#pragma unroll
            for (int kb = 0; kb < 2; ++kb) vt[kb] = frag(lds + R_VT, 16 * w + j, ST, ig, kb);
#pragma unroll
            for (int nt = 0; nt < 4; ++nt) {
                f32x4 a = (f32x4){0.f, 0.f, 0.f, 0.f}, b = (f32x4){0.f, 0.f, 0.f, 0.f};
#pragma unroll
                for (int kb = 0; kb < 4; ++kb) a = mma(rt[kb], frag(lds + R_Q, 16 * nt + j, SQ, ig, kb), a);
#pragma unroll
                for (int kb = 0; kb < 2; ++kb) b = mma(vt[kb], frag(lds + R_SP, 16 * nt + j, ST, ig, kb), b);
                const float qd = ex2(lg2 * (float)(16 * nt + j + 1));
                o[nt] = b + a * qd;
                float s1 = (o[nt][0] + o[nt][1]) + (o[nt][2] + o[nt][3]);
                float s2 = (o[nt][0] * o[nt][0] + o[nt][1] * o[nt][1]) + (o[nt][2] * o[nt][2] + o[nt][3] * o[nt][3]);
                s1 += __shfl_xor(s1, 16); s1 += __shfl_xor(s1, 32); s2 += __shfl_xor(s2, 16); s2 += __shfl_xor(s2, 32);
                if (ig == 0) *(LAS f32x2*)(lds + R_ST + ((16 * nt + j) * 8 + w) * 8) = (f32x2){s1, s2};
            }
        }
        {
            bf16x8 vt[2];
#pragma unroll
            for (int kb = 0; kb < 2; ++kb) vt[kb] = frag(lds + R_VT, 16 * w + j, ST, ig, kb);
#pragma unroll
            for (int dt = 0; dt < 8; ++dt) {
                R[dt] = R[dt] * cdec;
#pragma unroll
                for (int kb = 0; kb < 2; ++kb) R[dt] = mma(frag(lds + R_KT, 16 * dt + j, ST, ig, kb), vt[kb], R[dt]);
            }
        }
        if (full && c + 1 < nchunks) {
#pragma unroll
            for (int dt = 0; dt < 8; ++dt) { u32x2 p; p.x = pk2(R[dt][0], R[dt][1]); p.y = pk2(R[dt][2], R[dt][3]); *(LAS u32x2*)(lds + R_RT + (16 * w + j) * SQ + (16 * dt + 4 * ig) * 2) = p; }
        }
        __syncthreads();
        if (full) {
            const f32x4 gw = *(const f32x4*)(gnw + h * 128 + 16 * w + 4 * ig);
#pragma unroll
            for (int nt = 0; nt < 4; ++nt) {
                const int n = 16 * nt + j;
                if (n < CL) {
                    const LAS f32x4* sp = (const LAS f32x4*)(lds + R_ST + n * 64);
                    const f32x4 p0 = sp[0], p1 = sp[1], p2 = sp[2], p3 = sp[3];
                    const float s1 = (p0[0] + p0[2]) + (p1[0] + p1[2]) + (p2[0] + p2[2]) + (p3[0] + p3[2]);
                    const float s2 = (p0[1] + p0[3]) + (p1[1] + p1[3]) + (p2[1] + p2[3]) + (p3[1] + p3[3]);
                    const float mean = s1 * (1.0f / 128.0f);
                    const float var = fmaxf(s2 * (1.0f / 128.0f) - mean * mean, 0.f);
                    const float rstd = __builtin_amdgcn_rsqf(var + pg8::GN_EPS);
                    const size_t row = (size_t)(row0 + c * 64 + n);
                    const u32x2 sg = *(const u32x2*)(proj + row * LDP + 1536 + h * 128 + 16 * w + 4 * ig);
                    const float g0 = bf2f(sg.x & 0xffffu), g1 = bf2f(sg.x >> 16), g2 = bf2f(sg.y & 0xffffu), g3 = bf2f(sg.y >> 16);
                    u32x2 p;
                    p.x = pk2((o[nt][0] - mean) * rstd * gw[0] * g0, (o[nt][1] - mean) * rstd * gw[1] * g1);
                    p.y = pk2((o[nt][2] - mean) * rstd * gw[2] * g2, (o[nt][3] - mean) * rstd * gw[3] * g3);
                    *(u32x2*)(mix + row * DM + h * 128 + 16 * w + 4 * ig) = p;
                }
            }
        }
    }
#undef RET_LOAD
    if (rdst) {
#pragma unroll
        for (int dt = 0; dt < 8; ++dt)
#pragma unroll
            for (int t = 0; t < 4; ++t) rdst[(16 * dt + 4 * ig + t) * 128 + 16 * w + j] = R[dt][t];
    }
    __syncthreads();
}
__device__ __forceinline__ float head_lg2(int h) { return h == 0 ? -0.04580368961312479f : h == 1 ? -0.02272007650008353f : h == 2 ? -0.011315313227834146f : -0.005646563141142063f; }

__device__ __forceinline__ void conv_phase(const bf16_t* proj, bf16_t* mix, const float* conv_w  , const float* sconv  , int bx_, int nthr) {
    int tid_o = threadIdx.x; asm volatile("" : "+v"(tid_o));
    const int gtid = bx_ * NTHR + tid_o;
    const int nitems = (MT / 16) * 64;
    for (int it = gtid; it < nitems; it += nthr) {
        const int co = it & 63, rb = it >> 6, r0 = rb * 16, c0 = co * 8;
        float w0[8], w1[8], w2[8], um2[8], um1[8];
#pragma unroll
        for (int e = 0; e < 8; ++e) { w0[e] = conv_w[(c0 + e) * 3 + 0]; w1[e] = conv_w[(c0 + e) * 3 + 1]; w2[e] = conv_w[(c0 + e) * 3 + 2]; }
        const bool seq_start = r0 < MP ? ((r0 & (SEQ - 1)) == 0) : true;
        if (seq_start) {
            if (r0 < MP) {
#pragma unroll
                for (int e = 0; e < 8; ++e) { um2[e] = 0.f; um1[e] = 0.f; }
            } else {
                const float* sb = sconv + (size_t)((r0 - MP) >> 4) * 1024 + c0;
#pragma unroll
                for (int e = 0; e < 8; ++e) { um2[e] = sb[e]; um1[e] = sb[512 + e]; }
            }
        } else {
            const u32x4 a = *(const u32x4*)(proj + (size_t)(r0 - 2) * LDP + 2560 + c0), b = *(const u32x4*)(proj + (size_t)(r0 - 1) * LDP + 2560 + c0);
#pragma unroll
            for (int e = 0; e < 4; ++e) { um2[2 * e] = bf2f(a[e] & 0xffffu); um2[2 * e + 1] = bf2f(a[e] >> 16); um1[2 * e] = bf2f(b[e] & 0xffffu); um1[2 * e + 1] = bf2f(b[e] >> 16); }
        }
#pragma unroll 4
        for (int i = 0; i < 16; ++i) {
            const size_t row = (size_t)(r0 + i);
            const u32x4 uu = *(const u32x4*)(proj + row * LDP + 2560 + c0), bb = *(const u32x4*)(proj + row * LDP + 2048 + c0);
            float res[8];
#pragma unroll
            for (int e = 0; e < 4; ++e) {
                const float u0 = bf2f(uu[e] & 0xffffu), u1 = bf2f(uu[e] >> 16), b0 = bf2f(bb[e] & 0xffffu), b1 = bf2f(bb[e] >> 16);
                res[2 * e] = b0 * (w0[2 * e] * um2[2 * e] + w1[2 * e] * um1[2 * e] + w2[2 * e] * u0);
                res[2 * e + 1] = b1 * (w0[2 * e + 1] * um2[2 * e + 1] + w1[2 * e + 1] * um1[2 * e + 1] + w2[2 * e + 1] * u1);
                um2[2 * e] = um1[2 * e]; um1[2 * e] = u0; um2[2 * e + 1] = um1[2 * e + 1]; um1[2 * e + 1] = u1;
            }
            u32x4 o; o.x = pk2(res[0], res[1]); o.y = pk2(res[2], res[3]); o.z = pk2(res[4], res[5]); o.w = pk2(res[6], res[7]);
            *(u32x4*)(mix + row * DM + 512 + c0) = o;
        }
    }
}

__device__ __forceinline__ void conv_weight(const float* W, int K, int N, bf16_t* Wt, const float* ksc, int mode, int gtid, int nthr) {
    const int nitems = (K / 8) * N;
    for (int it = gtid; it < nitems; it += nthr) {
        const int ko = it / N, np = it - ko * N, k0 = ko * 8;
        int col = np; float cs = 1.f;
        if (mode == 1) {
            const int pn = np >> 8, bj = (np >> 7) & 1, t = np & 127;
            if (pn < 4) { col = (pn < 2 ? 0 : 512) + 128 * (2 * (pn & 1) + (t >> 6)) + 64 * bj + (t & 63); if (pn >= 2) cs = 0.08838834764831845f; }
            else if (pn >= 10) col = (bj ? 3072 : 2560) + 128 * (pn - 10) + t;
        }
        float v[8];
#pragma unroll
        for (int e = 0; e < 8; ++e) v[e] = W[(size_t)(k0 + e) * N + col] * (ksc ? ksc[k0 + e] : 1.f) * cs;
        u32x4 o; o.x = pk2(v[0], v[1]); o.y = pk2(v[2], v[3]); o.z = pk2(v[4], v[5]); o.w = pk2(v[6], v[7]);
        *(u32x4*)(Wt + (size_t)np * K + k0) = o;
    }
}
__device__ __forceinline__ float wave_sum(float v) {
#pragma unroll
    for (int o = 1; o < 64; o <<= 1) v += __shfl_xor(v, o);
    return v;
}

struct Args { const float* in[13]; float* out; unsigned char* ws; };

__global__ void __launch_bounds__(NTHR, 2) hymba_fwd(Args args) {
    extern __shared__ __attribute__((aligned(16))) unsigned char lds_raw[];
    LAS unsigned char* lds = (LAS unsigned char*)lds_raw;
    cg::grid_group grid = cg::this_grid();
    const int tid = threadIdx.x, lane = tid & 63, wave = __builtin_amdgcn_readfirstlane(tid >> 6);
    const int G = gridDim.x, bx = blockIdx.x;
    const int gtid = bx * NTHR + tid, nthr = G * NTHR, gw = bx * 8 + wave, ngw = G * 8;
    unsigned char* ws = args.ws;
    const float* x_prompt = args.in[0]; const float* x_sample = args.in[1]; const float* state_ret = args.in[2]; const float* state_conv = args.in[3];
    const float* ln1_w = args.in[4]; const float* w_in = args.in[5]; const float* conv_w = args.in[6]; const float* ret_norm_w = args.in[7];
    const float* w_out = args.in[8]; const float* ln2_w = args.in[9]; const float* w_up = args.in[10]; const float* w_dn = args.in[11]; const float* ln_f_w = args.in[12];
    float* out = args.out;
    bf16_t* WtIn = (bf16_t*)(ws + WS_WIN); bf16_t* WtOut = (bf16_t*)(ws + WS_WOUT); bf16_t* WtUp = (bf16_t*)(ws + WS_WUP); bf16_t* WtDn = (bf16_t*)(ws + WS_WDN);
    float* ssp = (float*)(ws + WS_SSP); float* sseg = (float*)(ws + WS_SSEG);
    bf16_t* xb = (bf16_t*)(ws + WS_XB); bf16_t* proj = (bf16_t*)(ws + WS_PROJ); bf16_t* mix = (bf16_t*)(ws + WS_MIX); bf16_t* Hb = (bf16_t*)(ws + WS_H);
    unsigned* ctl = (unsigned*)(ws + WS_CTL); float* part = (float*)(ws + WS_PART);
    volatile LAS unsigned* MISC = (volatile LAS unsigned*)(lds + 131072 + 512);
    if (tid < 64) MISC[tid] = 0u;
    if (bx == 0) { for (int i = tid; i < CTL_WORDS; i += NTHR) ctl[i] = 0u; }
    __syncthreads();
    int kslice = 256; asm volatile("" : "+s"(kslice));
    LAS float* rbuf = (LAS float*)(lds + 131072 + 1024);
    float* X = out;

#pragma unroll 1
    for (int l = 0; l < DEPTH; ++l) {
        conv_weight(w_in + (size_t)l * DM * NIN, DM, NIN, WtIn + (size_t)l * NIN * DM, ln1_w + l * DM, 1, gtid, nthr);
        conv_weight(w_out + (size_t)l * DM * DM, DM, DM, WtOut + (size_t)l * DM * DM, nullptr, 0, gtid, nthr);
        conv_weight(w_up + (size_t)l * DM * DFF, DM, DFF, WtUp + (size_t)l * DFF * DM, ln2_w + l * DM, 0, gtid, nthr);
        conv_weight(w_dn + (size_t)l * DFF * DM, DFF, DM, WtDn + (size_t)l * DM * DFF, nullptr, 0, gtid, nthr);
    }
    for (int r = gw; r < MT; r += ngw) {
        const float* xr = r < MP ? x_prompt + (size_t)r * DM : x_sample + (size_t)(r - MP) * DM;
        float s = 0.f;
#pragma unroll
        for (int q = 0; q < 4; ++q) {
            const f32x4 v = *(const f32x4*)(xr + 256 * q + 4 * lane);
            u32x2 p; p.x = pk2(v[0], v[1]); p.y = pk2(v[2], v[3]);
            *(u32x2*)(xb + (size_t)r * DM + 256 * q + 4 * lane) = p;
            s += (v[0] * v[0] + v[1] * v[1]) + (v[2] * v[2] + v[3] * v[3]);
        }
        s = wave_sum(s);
        if (lane < 16) ssp[(size_t)r * 16 + lane] = lane == 0 ? s : 0.f;
    }
    grid.sync();
    XcdBarrier bar = xcd_barrier_post(ctl, MISC + 8);

#pragma unroll 1
    for (int l = 0; l < DEPTH; ++l) {
        {
            const bf16_t* Bw = WtIn + (size_t)l * NIN * DM;
            pg8::EpiIn E{proj, rbuf, out + O_CONVP + (size_t)l * NBATCH * 1024, out + O_CONVS + (size_t)l * DBATCH * 1024};
            { pg8::Gemm g{xb, Bw, MP, NIN, DM, DM}; pg8::StaticOrder S; S.init(MP, NIN, G, bx); pg8::rstd_prepass(rbuf, ssp, S); pg8::gemm_phase<pg8::EpiIn, pg8::StaticOrder, true, true>(lds, g, S, E); }
#pragma unroll 1
            for (int s = 0; s < DM / 256; ++s) {
                pg8::Gemm g{xb + s * 256, Bw + s * 256, MT, NIN, DM, kslice}; pg8::SliceOrder S{s * (NIN / 256), NIN / 256, bx}; pg8::rstd_prepass(rbuf, ssp, S);
                pg8::SplitEpi<pg8::EpiIn> E2{E, part, ctl + CW_CNT + (l * 4 + 0) * 128, s, DM / 256};
                pg8::gemm_phase<pg8::SplitEpi<pg8::EpiIn>, pg8::SliceOrder, false, true>(lds, g, S, E2);
            }
        }
        xcd_barrier(bar);
        for (int it = bx; it < 288; it += G) {
            if (it < 224) {
                const int b = it / 28, rem = it - b * 28, h = rem / 7, sg = rem - h * 7;
                ret_item(lds, proj, mix, b * SEQ + sg * 512, 8, 64, h, head_lg2(h), false, 0, nullptr, 0, sseg + (size_t)((b * 4 + h) * 8 + sg) * 16384, nullptr);
            } else {
                const int si = it - 224, b = si >> 2, h = si & 3;
                ret_item(lds, proj, mix, MP + b * DSEQ, 1, DSEQ, h, head_lg2(h), true, 2, state_ret + (size_t)((l * DBATCH + b) * 4 + h) * 16384, 0,
                         out + O_RETS + (size_t)((l * DBATCH + b) * 4 + h) * 16384, ret_norm_w + l * 512);
            }
        }
        conv_phase(proj, mix, conv_w + (size_t)l * 512 * 3, state_conv + (size_t)l * DBATCH * 1024, bx, nthr);
        xcd_barrier(bar);
        for (int it = bx; it < 256; it += G) {
            const int b = it >> 5, h = (it >> 3) & 3, sg = it & 7;
            ret_item(lds, proj, mix, b * SEQ + sg * 512, 8, 64, h, head_lg2(h), true, sg > 0 ? 1 : 0, sseg + (size_t)((b * 4 + h) * 8) * 16384, sg,
                     sg == 7 ? out + O_RETP + (size_t)((l * NBATCH + b) * 4 + h) * 16384 : nullptr, ret_norm_w + l * 512);
        }
        xcd_barrier(bar);
        {
            const bf16_t* Bw = WtOut + (size_t)l * DM * DM;
            pg8::EpiRes E{l == 0 ? x_prompt : X, l == 0 ? x_sample : X + (size_t)MP * DM, X, xb, ssp};
            { pg8::Gemm g{mix, Bw, MP, DM, DM, DM}; pg8::StaticOrder S; S.init(MP, DM, G, bx); pg8::gemm_phase<pg8::EpiRes, pg8::StaticOrder, true, true>(lds, g, S, E); }
#pragma unroll 1
            for (int s = 0; s < DM / 256; ++s) {
                pg8::Gemm g{mix + s * 256, Bw + s * 256, MT, DM, DM, kslice}; pg8::SliceOrder S{s * (DM / 256), DM / 256, bx};
                pg8::SplitEpi<pg8::EpiRes> E2{E, part, ctl + CW_CNT + (l * 4 + 1) * 128, s, DM / 256};
                pg8::gemm_phase<pg8::SplitEpi<pg8::EpiRes>, pg8::SliceOrder, false, true>(lds, g, S, E2);
            }
        }
        xcd_barrier(bar);
        {
            const bf16_t* Bw = WtUp + (size_t)l * DFF * DM;
            pg8::EpiUp E{Hb, rbuf};
            { pg8::Gemm g{xb, Bw, MP, DFF, DM, DM}; pg8::StaticOrder S; S.init(MP, DFF, G, bx); pg8::rstd_prepass(rbuf, ssp, S); pg8::gemm_phase<pg8::EpiUp, pg8::StaticOrder, true, true>(lds, g, S, E); }
#pragma unroll 1
            for (int s = 0; s < DM / 256; ++s) {
                pg8::Gemm g{xb + s * 256, Bw + s * 256, MT, DFF, DM, kslice}; pg8::SliceOrder S{s * (DFF / 256), DFF / 256, bx}; pg8::rstd_prepass(rbuf, ssp, S);
                pg8::SplitEpi<pg8::EpiUp> E2{E, part, ctl + CW_CNT + (l * 4 + 2) * 128, s, DM / 256};
                pg8::gemm_phase<pg8::SplitEpi<pg8::EpiUp>, pg8::SliceOrder, false, true>(lds, g, S, E2);
            }
        }
        xcd_barrier(bar);
        {
            const bf16_t* Bw = WtDn + (size_t)l * DM * DFF;
            pg8::EpiRes E{X, X + (size_t)MP * DM, X, xb, ssp};
            { pg8::Gemm g{Hb, Bw, MP, DM, DFF, DFF}; pg8::StaticOrder S; S.init(MP, DM, G, bx); pg8::gemm_phase<pg8::EpiRes, pg8::StaticOrder, true, true>(lds, g, S, E); }
#pragma unroll 1
            for (int s = 0; s < 4; ++s) {
                pg8::Gemm g{Hb + s * 1024, Bw + s * 1024, MT, DM, DFF, 4 * kslice}; pg8::SliceOrder S{s * (DM / 256), DM / 256, bx};
                pg8::SplitEpi<pg8::EpiRes> E2{E, part, ctl + CW_CNT + (l * 4 + 3) * 128, s, 4};
                pg8::gemm_phase<pg8::SplitEpi<pg8::EpiRes>, pg8::SliceOrder, false, true>(lds, g, S, E2);
            }
        }
        xcd_barrier(bar);
    }
    int tid2 = threadIdx.x; asm volatile("" : "+v"(tid2));
    const int lane2 = tid2 & 63, gw2 = bx * 8 + __builtin_amdgcn_readfirstlane(tid2 >> 6);
    for (int r = gw2; r < MT; r += ngw) {
        const float rs = pg8::row_rstd(ssp, r);
        float* xr = X + (size_t)r * DM;
#pragma unroll
        for (int q = 0; q < 4; ++q) {
            const f32x4 v = *(const f32x4*)(xr + 256 * q + 4 * lane2), wv = *(const f32x4*)(ln_f_w + 256 * q + 4 * lane2);
            *(f32x4*)(xr + 256 * q + 4 * lane2) = v * rs * wv;
        }
    }
}

extern "C" void kernel_launch(void* const* d_in, const int* in_sizes, int n_in, void* d_out, int out_size, void* d_ws, size_t ws_size, hipStream_t stream) {
    static int grid = 0;
    if (grid == 0) {
        int dev = 0, cus = 0, per_cu = 0;
        if (n_in != 13 || ws_size < WS_END) { fprintf(stderr, "kernel_launch: unexpected n_in %d / ws_size %zu (need %zu)\n", n_in, ws_size, (size_t)WS_END); grid = -1; return; }
        hipGetDevice(&dev);
        hipDeviceGetAttribute(&cus, hipDeviceAttributeMultiprocessorCount, dev);
        hipFuncSetAttribute((const void*)hymba_fwd, hipFuncAttributeMaxDynamicSharedMemorySize, LDS_BYTES);
        hipOccupancyMaxActiveBlocksPerMultiprocessor(&per_cu, (const void*)hymba_fwd, NTHR, LDS_BYTES);
        if (per_cu < 1) { fprintf(stderr, "kernel_launch: occupancy query says %d blocks/CU\n", per_cu); per_cu = 1; }
        (void)hipGetLastError();
        grid = cus;
    }
    if (grid < 0) return;
    Args a{};
    for (int i = 0; i < 13; ++i) a.in[i] = (const float*)d_in[i];
    a.out = (float*)d_out; a.ws = (unsigned char*)d_ws;
    void* kargs[] = {&a};
    hipError_t e = hipLaunchCooperativeKernel((const void*)hymba_fwd, dim3(grid), dim3(NTHR), kargs, LDS_BYTES, stream);
    if (e != hipSuccess) fprintf(stderr, "cooperative launch failed: %s (grid %d)\n", hipGetErrorString(e), grid);
}
```

```cpp
#include <hip/hip_runtime.h>
#include <hip/hip_cooperative_groups.h>
#include <cstdio>
#include <cstdint>
namespace cg = cooperative_groups;
namespace pg8 {
#define PG8_LAS __attribute__((address_space(3)))
typedef unsigned short bf16_t;
typedef short bf16x8 __attribute__((ext_vector_type(8)));
typedef float f32x4 __attribute__((ext_vector_type(4)));
typedef unsigned u32x4 __attribute__((ext_vector_type(4)));
constexpr int BM = 256, BK = 64, HALF = 128, HTB = HALF * BK * 2  , STAGE_BYTES = 8 * HTB, NXCD = 8, WGM = 8;

__host__ __device__ __forceinline__ int lds_byte(int r, int c) { const int st = (r >> 4) * 2 + (c >> 5), rr = r & 15, cc = c & 31, ob = rr * 64 + cc * 2; return st * 1024 + (ob ^ (((ob >> 9) & 1) << 5)); }
__host__ __device__ __forceinline__ void stage_rc(int b, int& R, int& C) { const int st = b / 1024, sb = b % 1024, swz = sb ^ (((sb >> 9) & 1) << 5); R = (st >> 1) * 16 + swz / 64; C = (st & 1) * 32 + (swz % 64) / 2; }
__host__ __device__ __forceinline__ int perm32(int rho) { const int n = rho >> 4, i = rho & 15; return 8 * (i >> 2) + 4 * n + (i & 3); }

struct Unit { int pm, pn, idx; };
struct Gemm { const bf16_t* A; const bf16_t* Bt; int M, N, K, Kloop; };

struct StaticOrder {
    int nM, nN, nwg, G, c;
    __host__ __device__ __forceinline__ void init(int M, int N, int G_, int c_) { nM = M / BM; nN = N / BM; nwg = nM * nN; G = G_; c = c_; }
    __host__ __device__ __forceinline__ void map(int L, int& pm, int& pn) const {
        int wgid = L; { const int q = nwg / NXCD, r = nwg % NXCD, xcd = wgid % NXCD, off = wgid / NXCD; wgid = (xcd < r ? xcd * (q + 1) : r * (q + 1) + (xcd - r) * q) + off; }
        const int nig = WGM * nN, gid = wgid / nig, fm = gid * WGM, gsz = (nM - fm) < WGM ? (nM - fm) : WGM;
        pm = fm + ((wgid % nig) % gsz); pn = (wgid % nig) / gsz;
    }
    __host__ __device__ __forceinline__ bool next(int i, Unit& u) const {
        const long L = (long)i * G + c; if (L >= nwg) return false;
        int wgid = (int)L; { const int q = nwg / NXCD, r = nwg % NXCD, xcd = wgid % NXCD, off = wgid / NXCD; wgid = (xcd < r ? xcd * (q + 1) : r * (q + 1) + (xcd - r) * q) + off; }
        const int nig = WGM * nN, gid = wgid / nig, fm = gid * WGM, gsz = (nM - fm) < WGM ? (nM - fm) : WGM;
        u.pm = fm + ((wgid % nig) % gsz); u.pn = (wgid % nig) / gsz; u.idx = i; return true;
    }
    __device__ __forceinline__ void a_ready(const Unit&) const {}
    __device__ __forceinline__ void done(const Unit&) const {}
};

__device__ __forceinline__ unsigned cvt_pk_bf16(float lo, float hi) { unsigned r; asm volatile("v_cvt_pk_bf16_f32 %0, %1, %2" : "=v"(r) : "v"(lo), "v"(hi)); return r; }
typedef float f32x2 __attribute__((ext_vector_type(2)));

constexpr int DM = 1024, NBATCH = 8, SEQ = 4096, DEPTH = 2, DBATCH = 16, DSEQ = 16, PAST = 2048;
constexpr int MP = NBATCH * SEQ, MS = DBATCH * DSEQ, MT = MP + MS;
constexpr int NIN = 3584, DFF = 4096, LDP = 3072;
constexpr float RMS_EPS = 1e-6f, GN_EPS = 1e-5f;

__device__ __forceinline__ void store8bf(bf16_t* p, const f32x4 a, const f32x4 b) {
    u32x4 w; w.x = cvt_pk_bf16(a[0], a[1]); w.y = cvt_pk_bf16(a[2], a[3]); w.z = cvt_pk_bf16(b[0], b[1]); w.w = cvt_pk_bf16(b[2], b[3]);
    *(u32x4*)p = w;
}
__device__ __forceinline__ float row_rstd(const float* ssp, int r) {
    const f32x4* sp = (const f32x4*)(ssp + (size_t)r * 16);
    const f32x4 s0 = sp[0], s1 = sp[1], s2 = sp[2], s3 = sp[3];
    const f32x4 s = (s0 + s1) + (s2 + s3);
    const float tot = (s[0] + s[1]) + (s[2] + s[3]);
    return __builtin_amdgcn_rsqf(tot * (1.0f / DM) + RMS_EPS);
}
__device__ __forceinline__ float silu_f(float x) { return x * __builtin_amdgcn_rcpf(1.0f + __builtin_amdgcn_exp2f(-1.4426950408889634f * x)); }

struct EpiIn {
    static constexpr bool PERM = true, AFTER_DRAIN = false;
    bf16_t* proj; const PG8_LAS float* rbuf; float* nconv_p; float* nconv_s;
    __device__ __forceinline__ void operator()(f32x4 (&acc)[2][2][4][2], const Unit& u, int wr, int wc, int fr, int fq) const {
        const int pn = u.pn, tcol = wc * 32 + 8 * fq;
        const PG8_LAS float* rb = rbuf + u.idx * BM + wr * 64 + fr;
        if (pn < 4) {
            const int i0 = 32 * (wc & 1) + 8 * fq;
            float ir[8];
#pragma unroll
            for (int e = 0; e < 8; ++e) ir[e] = __builtin_amdgcn_exp2f(-(float)(i0 + e) * (13.287712379549449f / 64.0f)) * 0.15915494309189535f;
            const int dcol = (pn < 2 ? 0 : 512) + 128 * (2 * (pn & 1) + (wc >> 1)) + i0;
#pragma unroll
            for (int ai = 0; ai < 2; ++ai)
#pragma unroll
                for (int m = 0; m < 4; ++m) {
                    const int r = u.pm * BM + ai * HALF + wr * 64 + m * 16 + fr;
                    const float rs = rb[ai * HALF + m * 16];
                    float fp = (float)(r < MP ? (r & (SEQ - 1)) : PAST + (r & (DSEQ - 1)));
                    asm volatile("" : "+v"(fp) :: "memory");
                    f32x4 o1[2], o2[2];
#pragma unroll
                    for (int n = 0; n < 2; ++n)
#pragma unroll
                        for (int e = 0; e < 4; ++e) {
                            const float rev = fp * ir[4 * n + e], f = __builtin_amdgcn_fractf(rev);
                            const float c = __builtin_amdgcn_cosf(f), s = __builtin_amdgcn_sinf(f);
                            const float x1 = acc[ai][0][m][n][e] * rs, x2 = acc[ai][1][m][n][e] * rs;
                            o1[n][e] = x1 * c - x2 * s; o2[n][e] = x1 * s + x2 * c;
                        }
                    bf16_t* prow = proj + (size_t)r * LDP + dcol;
                    store8bf(prow, o1[0], o1[1]); store8bf(prow + 64, o2[0], o2[1]);
                }
        } else {
#pragma unroll
            for (int ai = 0; ai < 2; ++ai)
#pragma unroll
                for (int m = 0; m < 4; ++m) {
                    const int r = u.pm * BM + ai * HALF + wr * 64 + m * 16 + fr;
                    const float rs = rb[ai * HALF + m * 16];
                    const f32x4 a0 = acc[ai][0][m][0] * rs, a1 = acc[ai][0][m][1] * rs, b0 = acc[ai][1][m][0] * rs, b1 = acc[ai][1][m][1] * rs;
                    bf16_t* prow = proj + (size_t)r * LDP;
                    if (pn < 10) {
                        f32x4 x0 = a0, x1 = a1, y0 = b0, y1 = b1;
                        if (pn == 6 || pn == 7) {
#pragma unroll
                            for (int e = 0; e < 4; ++e) { x0[e] = silu_f(x0[e]); x1[e] = silu_f(x1[e]); y0[e] = silu_f(y0[e]); y1[e] = silu_f(y1[e]); }
                        }
                        const int dcol = 256 * pn + tcol;
                        store8bf(prow + dcol, x0, x1); store8bf(prow + dcol + 128, y0, y1);
                    } else {
                        const f32x4 u0 = a0 * b0, u1 = a1 * b1;
                        const int cc = 128 * (pn - 10) + tcol;
                        store8bf(prow + 2560 + cc, u0, u1);
                        if (r < MP) { const int t = r & (SEQ - 1); if (t >= SEQ - 2) { float* d = nconv_p + (size_t)((r >> 12) * 2 + (t - (SEQ - 2))) * 512 + cc; *(f32x4*)d = u0; *(f32x4*)(d + 4) = u1; } }
                        else { const int t = r & (DSEQ - 1); if (t >= DSEQ - 2) { float* d = nconv_s + (size_t)(((r - MP) >> 4) * 2 + (t - (DSEQ - 2))) * 512 + cc; *(f32x4*)d = u0; *(f32x4*)(d + 4) = u1; } }
                    }
                }
        }
    }
};
struct EpiRes {
    static constexpr bool PERM = false, AFTER_DRAIN = false;
    const float* xs_main; const float* xs_tail; float* X; bf16_t* xb; float* ssp;
    __device__ __forceinline__ void operator()(f32x4 (&acc)[2][2][4][2], const Unit& u, int wr, int wc, int fr, int fq) const {
        typedef unsigned u32x2v __attribute__((ext_vector_type(2)));
        const int cb = u.pn * BM + wc * 32 + 4 * fq;
#pragma unroll
        for (int g = 0; g < 4; ++g) {
            const int ai = g >> 1, mb = (g & 1) * 2;
            const int r0 = u.pm * BM + ai * HALF + wr * 64 + mb * 16 + fr;
            const float* xs = (r0 < MP ? xs_main + (size_t)r0 * DM : xs_tail + (size_t)(r0 - MP) * DM) + cb;
            f32x4 xv[2][2][2];
#pragma unroll
            for (int m = 0; m < 2; ++m)
#pragma unroll
                for (int bj = 0; bj < 2; ++bj)
#pragma unroll
                    for (int n = 0; n < 2; ++n) xv[m][bj][n] = *(const f32x4*)(xs + (size_t)m * 16 * DM + bj * HALF + n * 16);
#pragma unroll
            for (int m = 0; m < 2; ++m) {
                const int r = r0 + m * 16;
                float ss = 0.f;
#pragma unroll
                for (int bj = 0; bj < 2; ++bj)
#pragma unroll
                    for (int n = 0; n < 2; ++n) {
                        const int c = cb + bj * HALF + n * 16;
                        const f32x4 v = xv[m][bj][n] + acc[ai][bj][mb + m][n];
                        *(f32x4*)(X + (size_t)r * DM + c) = v;
                        u32x2v w; w.x = cvt_pk_bf16(v[0], v[1]); w.y = cvt_pk_bf16(v[2], v[3]);
                        *(u32x2v*)(xb + (size_t)r * DM + c) = w;
                        ss += (v[0] * v[0] + v[1] * v[1]) + (v[2] * v[2] + v[3] * v[3]);
                    }
                ss += __shfl_xor(ss, 16); ss += __shfl_xor(ss, 32);
                if (fq == 0) ssp[(size_t)r * 16 + 4 * u.pn + wc] = ss;
            }
            asm volatile("" ::: "memory");
        }
    }
};
struct EpiUp {
    static constexpr bool PERM = true, AFTER_DRAIN = false;
    bf16_t* H; const PG8_LAS float* rbuf;
    __device__ __forceinline__ void operator()(f32x4 (&acc)[2][2][4][2], const Unit& u, int wr, int wc, int fr, int fq) const {
        const PG8_LAS float* rb = rbuf + u.idx * BM + wr * 64 + fr;
#pragma unroll
        for (int ai = 0; ai < 2; ++ai)
#pragma unroll
            for (int m = 0; m < 4; ++m) {
                const int r = u.pm * BM + ai * HALF + wr * 64 + m * 16 + fr;
                const float rs = rb[ai * HALF + m * 16];
                bf16_t* hrow = H + (size_t)r * DFF + u.pn * BM + wc * 32 + 8 * fq;
#pragma unroll
                for (int bj = 0; bj < 2; ++bj) {
                    f32x4 v0 = acc[ai][bj][m][0] * rs, v1 = acc[ai][bj][m][1] * rs;
#pragma unroll
                    for (int e = 0; e < 4; ++e) { const float p = fmaxf(v0[e], 0.f), q = fmaxf(v1[e], 0.f); v0[e] = p * p; v1[e] = q * q; }
                    store8bf(hrow + bj * HALF, v0, v1);
                }
            }
    }
};
template <class Sched> __device__ __forceinline__ void rstd_prepass(PG8_LAS float* rbuf, const float* ssp, const Sched& S) {
    int tid = threadIdx.x; asm volatile("" : "+v"(tid));
    const int row = tid >> 1, half = tid & 1;
    Unit u;
    for (int i = 0; S.next(i, u); ++i) {
        const f32x4* sp = (const f32x4*)(ssp + (size_t)(u.pm * BM + row) * 16 + half * 8);
        const f32x4 a = sp[0], b = sp[1];
        float t = ((a[0] + a[1]) + (a[2] + a[3])) + ((b[0] + b[1]) + (b[2] + b[3]));
        t += __shfl_xor(t, 1);
        if (half == 0) rbuf[i * BM + row] = __builtin_amdgcn_rsqf(t * (1.0f / DM) + RMS_EPS);
    }
    __syncthreads();
}
struct SliceOrder {
    int first, nN, c;
    __device__ __forceinline__ bool next(int i, Unit& u) const { const int idx = c - first; u.pm = MP / BM; u.pn = idx; u.idx = 0; return i == 0 && idx >= 0 && idx < nN; }
    __device__ __forceinline__ void a_ready(const Unit&) const {}
    __device__ __forceinline__ void done(const Unit&) const {}
};
__device__ __forceinline__ void ld16_coh(const f32x4* p, f32x4 (&t)[16]) {
    const f32x4 *p0 = p, *p1 = p + 256, *p2 = p + 512, *p3 = p + 768;
    asm volatile(
        "global_load_dwordx4 %0, %16, off sc1\n\tglobal_load_dwordx4 %1, %16, off offset:1024 sc1\n\tglobal_load_dwordx4 %2, %16, off offset:2048 sc1\n\tglobal_load_dwordx4 %3, %16, off offset:3072 sc1\n\t"
        "global_load_dwordx4 %4, %17, off sc1\n\tglobal_load_dwordx4 %5, %17, off offset:1024 sc1\n\tglobal_load_dwordx4 %6, %17, off offset:2048 sc1\n\tglobal_load_dwordx4 %7, %17, off offset:3072 sc1\n\t"
        "global_load_dwordx4 %8, %18, off sc1\n\tglobal_load_dwordx4 %9, %18, off offset:1024 sc1\n\tglobal_load_dwordx4 %10, %18, off offset:2048 sc1\n\tglobal_load_dwordx4 %11, %18, off offset:3072 sc1\n\t"
        "global_load_dwordx4 %12, %19, off sc1\n\tglobal_load_dwordx4 %13, %19, off offset:1024 sc1\n\tglobal_load_dwordx4 %14, %19, off offset:2048 sc1\n\tglobal_load_dwordx4 %15, %19, off offset:3072 sc1\n\t"
        "s_waitcnt vmcnt(0)"
        : "=&v"(t[0]), "=&v"(t[1]), "=&v"(t[2]), "=&v"(t[3]), "=&v"(t[4]), "=&v"(t[5]), "=&v"(t[6]), "=&v"(t[7]),
          "=&v"(t[8]), "=&v"(t[9]), "=&v"(t[10]), "=&v"(t[11]), "=&v"(t[12]), "=&v"(t[13]), "=&v"(t[14]), "=&v"(t[15])
        : "v"(p0), "v"(p1), "v"(p2), "v"(p3) : "memory");
}
template <class E> struct SplitEpi {
    static constexpr bool PERM = E::PERM, AFTER_DRAIN = false;
    E e; float* part; unsigned* cnt; int slice, nsl;
    __device__ __forceinline__ void operator()(f32x4 (&acc)[2][2][4][2], const Unit& u, int wr, int wc, int fr, int fq) const {
        const int wid = wr * 4 + wc, lane = fq * 16 + fr;
        f32x4* base = (f32x4*)part + (size_t)(u.pn * 8 + wid) * 32 * 64 + lane;
        const size_t sstride = (size_t)16 * 8 * 32 * 64;
        f32x4* dst = base + (size_t)slice * sstride;
#pragma unroll
        for (int q = 0; q < 32; ++q) asm volatile("global_store_dwordx4 %0, %1, off sc1\n\ts_nop 2" :: "v"(dst + q * 64), "v"(acc[q >> 4][(q >> 3) & 1][(q >> 1) & 3][q & 1]) : "memory");
        asm volatile("s_waitcnt vmcnt(0)" ::: "memory");
        unsigned old = 0u;
        if (lane == 0) old = __hip_atomic_fetch_add(cnt + u.pn * 8 + wid, 1u, __ATOMIC_RELAXED, __HIP_MEMORY_SCOPE_AGENT);
        old = (unsigned)__builtin_amdgcn_readfirstlane((int)old);
        if (old + 1u == (unsigned)nsl) {
            __builtin_amdgcn_fence(__ATOMIC_ACQUIRE, "agent");
#pragma unroll
            for (int q = 0; q < 32; ++q) acc[q >> 4][(q >> 3) & 1][(q >> 1) & 3][q & 1] = (f32x4){0.f, 0.f, 0.f, 0.f};
#pragma unroll 1
            for (int sl = 0; sl < nsl; ++sl) {
                const f32x4* src = base + (size_t)sl * sstride;
#pragma unroll
                for (int hb = 0; hb < 2; ++hb) {
                    f32x4 t[16]; ld16_coh(src + hb * 16 * 64, t);
#pragma unroll
                    for (int i = 0; i < 16; ++i) { const int q = hb * 16 + i; acc[q >> 4][(q >> 3) & 1][(q >> 1) & 3][q & 1] += t[i]; }
                }
            }
            e(acc, u, wr, wc, fr, fq);
        }
    }
};
template <class Epi, class Sched, bool ALIGN_EPI = false, bool SP2 = false>
__device__ __forceinline__ void gemm_phase(PG8_LAS unsigned char* lds, const Gemm g, const Sched& S, const Epi& E) {
    int tid_o = threadIdx.x; asm volatile("" : "+v"(tid_o));
    const int tid = tid_o, wid = __builtin_amdgcn_readfirstlane(tid >> 6), lane = tid & 63, wr = wid >> 2, wc = wid & 3, fr = lane & 15, fq = lane >> 4;
    const int K = g.K, nt = g.Kloop / BK;
    unsigned voffA[2], voffB[2];
#pragma unroll
    for (int i = 0; i < 2; ++i) { int R, C; stage_rc(tid * 16 + i * 8192, R, C); const int Rb = Epi::PERM ? ((R & ~31) + perm32(R & 31)) : R;
        voffA[i] = (unsigned)(R * K + C) * 2u; voffB[i] = (unsigned)(Rb * K + C) * 2u; }
    const size_t kstep = (size_t)(BK * 2);
    const size_t hstep = (size_t)HALF * K * 2;
    const size_t tstep = 2 * hstep;
    const unsigned ldsw = (unsigned)wid * 1024u;
    const int aoff = lds_byte(wr * 64 + fr, fq * 8), boff = lds_byte(wc * 32 + fr, fq * 8);
#define PG8_SA(b, h) (((b) * 2 + (h)) * HTB)
#define PG8_SB(b, h) ((4 + (b) * 2 + (h)) * HTB)
#define PG8_STAGE(bufoff, gbase, voff) do { _Pragma("unroll") for (int _i = 0; _i < 2; ++_i) \
        __builtin_amdgcn_global_load_lds((const unsigned*)((const char*)(gbase) + (voff)[_i]), (PG8_LAS unsigned*)(lds + (bufoff) + ldsw + _i * 8192), 16, 0, 0); } while (0)
#define PG8_LDA(dst, b, h) do { _Pragma("unroll") for (int m = 0; m < 4; ++m) _Pragma("unroll") for (int k = 0; k < 2; ++k) dst[m][k] = *(const PG8_LAS bf16x8*)(lds + PG8_SA(b, h) + aoff + m * 2048 + k * 1024); } while (0)
#define PG8_LDB(dst, b, h) do { _Pragma("unroll") for (int n = 0; n < 2; ++n) _Pragma("unroll") for (int k = 0; k < 2; ++k) dst[n][k] = *(const PG8_LAS bf16x8*)(lds + PG8_SB(b, h) + boff + n * 2048 + k * 1024); } while (0)
#define PG8_MMA(ai, bj, At, Bt) do { __builtin_amdgcn_s_setprio(1); _Pragma("unroll") for (int m = 0; m < 4; ++m) _Pragma("unroll") for (int n = 0; n < 2; ++n) _Pragma("unroll") for (int k = 0; k < 2; ++k) \
        acc[ai][bj][m][n] = __builtin_amdgcn_mfma_f32_16x16x32_bf16(Bt[n][k], At[m][k], acc[ai][bj][m][n], 0, 0, 0); __builtin_amdgcn_s_setprio(0); } while (0)
#define PG8_WAIT_V(n) asm volatile("s_waitcnt vmcnt(" #n ")" ::: "memory")
#define PG8_WAIT_L(n) asm volatile("s_waitcnt lgkmcnt(" #n ")" ::: "memory")
#define PG8_BAR __builtin_amdgcn_s_barrier()
#define PG8_SCHED __builtin_amdgcn_sched_barrier(0)
    Unit cur, nxt; int ui = 0;
    if (!S.next(0, cur)) return;
    f32x4 acc[2][2][4][2];
#pragma unroll
    for (int a = 0; a < 2; ++a)
#pragma unroll
        for (int b = 0; b < 2; ++b)
#pragma unroll
            for (int m = 0; m < 4; ++m)
#pragma unroll
                for (int n = 0; n < 2; ++n) acc[a][b][m][n] = (f32x4){0.f, 0.f, 0.f, 0.f};
    bf16x8 At[4][2], B0[2][2], B1[2][2];
    const char* cA = (const char*)g.A + (size_t)cur.pm * tstep; const char* cB = (const char*)g.Bt + (size_t)cur.pn * tstep;
    S.a_ready(cur);
    if constexpr (SP2) {
        PG8_STAGE(PG8_SB(0, 0), cB, voffB); PG8_STAGE(PG8_SB(0, 1), cB + hstep, voffB); PG8_STAGE(PG8_SA(0, 0), cA, voffA); PG8_STAGE(PG8_SA(0, 1), cA + hstep, voffA);
        if (wr == 1) PG8_BAR;
        PG8_WAIT_V(2); PG8_BAR;
        PG8_STAGE(PG8_SB(1, 0), cB + kstep, voffB); PG8_STAGE(PG8_SA(1, 0), cA + kstep, voffA); PG8_STAGE(PG8_SB(1, 1), cB + hstep + kstep, voffB);
        PG8_WAIT_V(6); PG8_BAR;
    } else {
        PG8_STAGE(PG8_SB(0, 0), cB, voffB); PG8_STAGE(PG8_SA(0, 0), cA, voffA); PG8_STAGE(PG8_SB(0, 1), cB + hstep, voffB); PG8_STAGE(PG8_SA(0, 1), cA + hstep, voffA);
        if (wr == 1) PG8_BAR;
        PG8_WAIT_V(4); PG8_BAR;
        PG8_STAGE(PG8_SB(1, 0), cB + kstep, voffB); PG8_STAGE(PG8_SA(1, 0), cA + kstep, voffA); PG8_STAGE(PG8_SB(1, 1), cB + hstep + kstep, voffB);
        PG8_WAIT_V(6); PG8_BAR;
    }
    for (;;) {
        const bool has_next = S.next(ui + 1, nxt);
        const char* nA = has_next ? (const char*)g.A + (size_t)nxt.pm * tstep : cA; const char* nB = has_next ? (const char*)g.Bt + (size_t)nxt.pn * tstep : cB;
        for (int t = 0; t < nt; t += 2) {
            const bool last = (t == nt - 2);
            const char* a1 = cA + (size_t)(t + 1) * kstep;
            const char* a2 = last ? nA : cA + (size_t)(t + 2) * kstep; const char* b2 = last ? nB : cB + (size_t)(t + 2) * kstep;
            const char* a3 = a2 + kstep; const char* b3 = b2 + kstep;
            if (last && has_next) S.a_ready(nxt);
            if constexpr (SP2) {
            PG8_LDB(B0, 0, 0); PG8_LDB(B1, 0, 1); PG8_SCHED; PG8_LDA(At, 0, 0); PG8_STAGE(PG8_SA(1, 1), a1 + hstep, voffA);
            PG8_WAIT_V(8); PG8_WAIT_L(0); PG8_BAR; PG8_MMA(0, 0, At, B0); PG8_MMA(0, 1, At, B1); PG8_BAR; PG8_SCHED;
            PG8_LDA(At, 0, 1); PG8_STAGE(PG8_SB(0, 0), b2, voffB); PG8_STAGE(PG8_SB(0, 1), b2 + hstep, voffB); PG8_STAGE(PG8_SA(0, 0), a2, voffA);
            PG8_WAIT_V(8); PG8_WAIT_L(0); PG8_BAR; PG8_MMA(1, 0, At, B0); PG8_MMA(1, 1, At, B1); PG8_BAR; PG8_SCHED;
            PG8_LDB(B0, 1, 0); PG8_LDB(B1, 1, 1); PG8_SCHED; PG8_LDA(At, 1, 0); PG8_STAGE(PG8_SA(0, 1), a2 + hstep, voffA);
            PG8_WAIT_V(8); PG8_WAIT_L(0); PG8_BAR; PG8_MMA(0, 0, At, B0); PG8_MMA(0, 1, At, B1); PG8_BAR; PG8_SCHED;
            PG8_LDA(At, 1, 1); PG8_STAGE(PG8_SB(1, 0), b3, voffB); PG8_STAGE(PG8_SB(1, 1), b3 + hstep, voffB); PG8_STAGE(PG8_SA(1, 0), a3, voffA);
            PG8_WAIT_V(8); PG8_WAIT_L(0); PG8_BAR; PG8_MMA(1, 0, At, B0); PG8_MMA(1, 1, At, B1); PG8_BAR; PG8_SCHED;
            } else {
            PG8_LDB(B0, 0, 0); PG8_SCHED; PG8_LDA(At, 0, 0); PG8_STAGE(PG8_SA(1, 1), a1 + hstep, voffA);
            PG8_WAIT_L(8); PG8_BAR; PG8_WAIT_L(0); PG8_MMA(0, 0, At, B0); PG8_BAR; PG8_SCHED;
            PG8_LDB(B1, 0, 1); PG8_STAGE(PG8_SB(0, 0), b2, voffB);
            PG8_BAR; PG8_WAIT_L(0); PG8_MMA(0, 1, At, B1); PG8_BAR;
            PG8_LDA(At, 0, 1); PG8_STAGE(PG8_SA(0, 0), a2, voffA);
            PG8_BAR; PG8_WAIT_L(0); PG8_MMA(1, 0, At, B0); PG8_BAR; PG8_SCHED;
            PG8_STAGE(PG8_SB(0, 1), b2 + hstep, voffB);
            PG8_WAIT_V(6); PG8_BAR; PG8_MMA(1, 1, At, B1); PG8_BAR;
            PG8_LDB(B0, 1, 0); PG8_SCHED; PG8_LDA(At, 1, 0); PG8_STAGE(PG8_SA(0, 1), a2 + hstep, voffA);
            PG8_WAIT_L(8); PG8_BAR; PG8_WAIT_L(0); PG8_MMA(0, 0, At, B0); PG8_BAR; PG8_SCHED;
            PG8_LDB(B1, 1, 1); PG8_STAGE(PG8_SB(1, 0), b3, voffB);
            PG8_BAR; PG8_WAIT_L(0); PG8_MMA(0, 1, At, B1); PG8_BAR;
            PG8_LDA(At, 1, 1); PG8_STAGE(PG8_SA(1, 0), a3, voffA);
            PG8_BAR; PG8_WAIT_L(0); PG8_MMA(1, 0, At, B0); PG8_BAR; PG8_SCHED;
            PG8_STAGE(PG8_SB(1, 1), b3 + hstep, voffB);
            PG8_WAIT_V(6); PG8_BAR; PG8_MMA(1, 1, At, B1); PG8_BAR;
            }
        }
        if constexpr (ALIGN_EPI) { if (wr == 0) PG8_BAR; }
        if constexpr (!Epi::AFTER_DRAIN) { E(acc, cur, wr, wc, fr, fq); S.done(cur); }
        if (!has_next) break;
#pragma unroll
        for (int a = 0; a < 2; ++a)
#pragma unroll
            for (int b = 0; b < 2; ++b)
#pragma unroll
                for (int m = 0; m < 4; ++m)
#pragma unroll
                    for (int n = 0; n < 2; ++n) acc[a][b][m][n] = (f32x4){0.f, 0.f, 0.f, 0.f};
        cur = nxt; cA = nA; cB = nB; ++ui;
        if constexpr (ALIGN_EPI) { if (wr == 1) PG8_BAR; }
    }
    PG8_WAIT_V(0);
    if constexpr (!ALIGN_EPI) { if (wr == 0) PG8_BAR; }
    PG8_BAR;
    if constexpr (Epi::AFTER_DRAIN) { E.fused(acc, cur, wr, wc, fr, fq, lds, wid, lane); S.done(cur); }
#undef PG8_SA
#undef PG8_SB
#undef PG8_STAGE
#undef PG8_LDA
#undef PG8_LDB
#undef PG8_MMA
#undef PG8_WAIT_V
#undef PG8_WAIT_L
#undef PG8_BAR
#undef PG8_SCHED
}
}
#define LAS __attribute__((address_space(3)))
#define XB_TMO      128
#define XB_XCNT(j)  (256  + 64 * (j))
#define XB_XSUB(j)  (1280 + 64 * (j))
#define XB_XGEN(j)  (2304 + 64 * (j))
#define XB_TOP      3328
#define XB_TOPGEN   3392
#define XCD_BAR_WORDS 3456
#define XB_SPIN_CAP (1u << 18)

__device__ __forceinline__ unsigned xb_ld(unsigned* p)              { return __hip_atomic_load(p, __ATOMIC_RELAXED, __HIP_MEMORY_SCOPE_AGENT); }
__device__ __forceinline__ unsigned xb_add(unsigned* p, unsigned v) { return __hip_atomic_fetch_add(p, v, __ATOMIC_RELAXED, __HIP_MEMORY_SCOPE_AGENT); }
__device__ __forceinline__ unsigned xb_xcc_id() { return (unsigned)__builtin_amdgcn_s_getreg((3 << 11) | 20) & 0xFu; }
#define XB_SPIN(cond, bar) do { unsigned _sp = 0; while (cond) { __builtin_amdgcn_s_sleep(1); \
    if ((++_sp & 255u) == 0u) { if (xb_ld(&(bar)[XB_TMO])) break; if (_sp > XB_SPIN_CAP) { atomicAdd(&(bar)[XB_TMO], 1u); break; } } } } while (0)

struct XcdBarrier {
    unsigned* bar; unsigned x;
    volatile LAS unsigned* st;
};

__device__ __forceinline__ XcdBarrier xcd_barrier_post(unsigned* bar, volatile LAS unsigned* st) {
    XcdBarrier b; b.bar = bar; b.x = xb_xcc_id(); b.st = st;
    if (threadIdx.x == 0) (void)xb_add(&bar[XB_XCNT(b.x)], 1u);
    return b;
}
__device__ __forceinline__ void xcd_barrier_complete(unsigned* bar, unsigned x, unsigned& nloc, unsigned& nx) {
    const unsigned G = gridDim.x * gridDim.y * gridDim.z;
    unsigned sum, cnt, mine, sp = 0u;
    for (;;) {
        sum = 0u; cnt = 0u; mine = 0u;
#pragma unroll
        for (unsigned j = 0; j < 16; ++j) { const unsigned c = xb_ld(&bar[XB_XCNT(j)]); sum += c; cnt += (c > 0u) ? 1u : 0u; mine = (j == x) ? c : mine; }
        if (sum == G) break;
        __builtin_amdgcn_s_sleep(1);
        if ((++sp & 255u) == 0u) { if (xb_ld(&bar[XB_TMO])) break; if (sp > XB_SPIN_CAP) { atomicAdd(&bar[XB_TMO], 1u); break; } }
    }
    nloc = mine > 0u ? mine : 1u; nx = cnt > 0u ? cnt : 1u;
}

__device__ __forceinline__ void xcd_barrier(const XcdBarrier& b) {
    asm volatile("s_waitcnt vmcnt(0)" ::: "memory");
    __syncthreads();
    if (threadIdx.x == 0) {
        unsigned* bar = b.bar;
        __builtin_amdgcn_s_waitcnt(0);
        unsigned nloc = b.st[0], nx = b.st[1];
        if (nloc == 0u) { xcd_barrier_complete(bar, b.x, nloc, nx); b.st[0] = nloc; b.st[1] = nx; }
        const unsigned old = xb_add(&bar[XB_XSUB(b.x)], 1u);
        const unsigned gen = old / nloc;
        if (old + 1u == (gen + 1u) * nloc) {
            __builtin_amdgcn_fence(__ATOMIC_RELEASE, "agent");
            asm volatile("s_waitcnt vmcnt(0)" ::: "memory");
            const unsigned og = xb_add(&bar[XB_TOP], 1u);
            const unsigned tg = og / nx;
            if (og + 1u == (tg + 1u) * nx) xb_add(&bar[XB_TOPGEN], 1u);
            else XB_SPIN(xb_ld(&bar[XB_TOPGEN]) == tg, bar);
            __builtin_amdgcn_fence(__ATOMIC_ACQUIRE, "agent");
            xb_add(&bar[XB_XGEN(b.x)], 1u);
            asm volatile("s_waitcnt vmcnt(0)" ::: "memory");
        } else {
            XB_SPIN(xb_ld(&bar[XB_XGEN(b.x)]) == gen, bar);
            __builtin_amdgcn_fence(__ATOMIC_ACQUIRE, "agent");
            asm volatile("s_waitcnt vmcnt(0)" ::: "memory");
        }
    }
    __syncthreads();
}

using pg8::bf16_t; using pg8::bf16x8; using pg8::f32x4; using pg8::u32x4;
using pg8::DM; using pg8::MP; using pg8::MS; using pg8::MT; using pg8::NIN; using pg8::DFF; using pg8::LDP; using pg8::SEQ; using pg8::DSEQ;
using pg8::NBATCH; using pg8::DBATCH; using pg8::DEPTH;
#define LAS __attribute__((address_space(3)))
typedef unsigned u32x2 __attribute__((ext_vector_type(2)));
typedef float f32x2 __attribute__((ext_vector_type(2)));

constexpr int NTHR = 512;
constexpr int LDS_BYTES = 147456;
constexpr size_t O_YP = 0, O_YS = (size_t)MP * DM, O_RETP = O_YS + (size_t)MS * DM, O_CONVP = O_RETP + (size_t)DEPTH * NBATCH * 4 * 16384,
                 O_RETS = O_CONVP + (size_t)DEPTH * NBATCH * 2 * 512, O_CONVS = O_RETS + (size_t)DEPTH * DBATCH * 4 * 16384;
constexpr size_t MiB = 1u << 20;
constexpr size_t WS_WIN = 0, WS_WOUT = 14 * MiB, WS_WUP = 18 * MiB, WS_WDN = 34 * MiB;
constexpr size_t WS_COS = 50 * MiB, WS_SIN = 51 * MiB, WS_SSP = 52 * MiB, WS_SSEG = 55 * MiB;
constexpr size_t WS_CTL = 54 * MiB + 512 * 1024;
constexpr int CTL_WORDS = 8192, CW_CNT = 4096;
constexpr size_t WS_PART = 400 * MiB;
constexpr size_t WS_XB = 71 * MiB;
constexpr size_t WS_PROJ = 136 * MiB;
constexpr size_t WS_MIX = WS_PROJ + (size_t)MT * LDP * 2;
constexpr size_t WS_H = WS_PROJ;
constexpr size_t WS_END = WS_MIX + (size_t)MT * DM * 2;
static_assert(WS_END <= WS_PART && WS_PART + 64 * MiB <= 512 * MiB && WS_XB + (size_t)MT * DM * 2 <= WS_PROJ && WS_END <= 512 * MiB && WS_H + (size_t)MT * DFF * 2 <= WS_END, "ws map");

__device__ __forceinline__ float bf2f(unsigned b) { return __uint_as_float(b << 16); }
__device__ __forceinline__ unsigned pk2(float lo, float hi) { return pg8::cvt_pk_bf16(lo, hi); }
__device__ __forceinline__ float ex2(float x) { return __builtin_amdgcn_exp2f(x); }
__device__ __forceinline__ f32x4 mma(const bf16x8 x, const bf16x8 y, const f32x4 c) { return __builtin_amdgcn_mfma_f32_16x16x32_bf16(x, y, c, 0, 0, 0); }
__device__ __forceinline__ bf16x8 frag(LAS unsigned char* base, int row, int stride, int kg, int kb) { return *(const LAS bf16x8*)(base + row * stride + 16 * kg + 64 * kb); }

constexpr int R_Q = 0, R_K = 17408, R_KT = 34816, R_VT = 53248, R_SP = 71680, R_RT = 80896, R_ST = 115712;
constexpr int SQ = 272, ST = 144;
#define LDS_BAR() do { asm volatile("s_waitcnt lgkmcnt(0)" ::: "memory"); __builtin_amdgcn_s_barrier(); asm volatile("" ::: "memory"); } while (0)
__device__ __forceinline__ void ret_item(LAS unsigned char* lds, const bf16_t* proj, bf16_t* mix, int row0, int nchunks, int CL, int h, float lg2, bool full,
                                         int rinit, const float* rsrc, int nprefix, float* rdst, const float* gnw) {
    int tid_o = threadIdx.x; asm volatile("" : "+v"(tid_o));
    const int tid = tid_o, w = __builtin_amdgcn_readfirstlane(tid >> 6), lane = tid & 63, j = lane & 15, ig = lane >> 4;
    f32x4 R[8];
#pragma unroll
    for (int dt = 0; dt < 8; ++dt) R[dt] = (f32x4){0.f, 0.f, 0.f, 0.f};
    if (rinit == 2) {
#pragma unroll
        for (int dt = 0; dt < 8; ++dt)
#pragma unroll
            for (int t = 0; t < 4; ++t) R[dt][t] = rsrc[(16 * dt + 4 * ig + t) * 128 + 16 * w + j];
    } else if (rinit == 1) {
#pragma unroll 1
        for (int s = 0; s < nprefix; ++s) {
            const float sc = ex2(lg2 * 512.f * (float)(nprefix - 1 - s));
            const float* rp = rsrc + (size_t)s * 16384 + 16 * w + j;
#pragma unroll
            for (int dt = 0; dt < 8; ++dt)
#pragma unroll
                for (int t = 0; t < 4; ++t) R[dt][t] += rp[(16 * dt + 4 * ig + t) * 128] * sc;
        }
    }
    if (full) {
#pragma unroll
        for (int dt = 0; dt < 8; ++dt) { u32x2 p; p.x = pk2(R[dt][0], R[dt][1]); p.y = pk2(R[dt][2], R[dt][3]); *(LAS u32x2*)(lds + R_RT + (16 * w + j) * SQ + (16 * dt + 4 * ig) * 2) = p; }
    }
    const float cdec = ex2(lg2 * (float)CL);
    const float kdec = ex2(lg2 * (float)(CL - 1 - lane));
    u32x4 qreg[2], kreg[2], vreg[2];
    const u32x4 zero4 = (u32x4){0u, 0u, 0u, 0u};
#define RET_LOAD(c) do { _Pragma("unroll") for (int it = 0; it < 2; ++it) { \
        const int qm = (tid + NTHR * it) >> 4, qd = (tid + NTHR * it) & 15, kd = w + 8 * it; \
        const bf16_t* rb = proj + (size_t)(row0 + (c) * 64) * LDP + h * 128; \
        qreg[it] = (full && qm < CL) ? *(const u32x4*)(rb + (size_t)qm * LDP + 8 * qd) : zero4; \
        kreg[it] = (lane < CL) ? *(const u32x4*)(rb + (size_t)lane * LDP + 512 + 8 * kd) : zero4; \
        vreg[it] = (lane < CL) ? *(const u32x4*)(rb + (size_t)lane * LDP + 1024 + 8 * kd) : zero4; } } while (0)
    RET_LOAD(0);
    for (int c = 0; c < nchunks; ++c) {
#pragma unroll
        for (int it = 0; it < 2; ++it) {
            const int qm = (tid + NTHR * it) >> 4, qd = (tid + NTHR * it) & 15, kd = w + 8 * it;
            if (full) { *(LAS u32x4*)(lds + R_Q + qm * SQ + 16 * qd) = qreg[it]; *(LAS u32x4*)(lds + R_K + lane * SQ + 16 * kd) = kreg[it]; }
#pragma unroll
            for (int e = 0; e < 4; ++e) {
                const unsigned kw = kreg[it][e], vw = vreg[it][e];
                const unsigned kp = pk2(bf2f(kw & 0xffffu) * kdec, bf2f(kw >> 16) * kdec);
                *(LAS unsigned short*)(lds + R_KT + (8 * kd + 2 * e) * ST + 2 * lane) = (unsigned short)(kp & 0xffffu);
                *(LAS unsigned short*)(lds + R_KT + (8 * kd + 2 * e + 1) * ST + 2 * lane) = (unsigned short)(kp >> 16);
                *(LAS unsigned short*)(lds + R_VT + (8 * kd + 2 * e) * ST + 2 * lane) = (unsigned short)(vw & 0xffffu);
                *(LAS unsigned short*)(lds + R_VT + (8 * kd + 2 * e + 1) * ST + 2 * lane) = (unsigned short)(vw >> 16);
            }
        }
        if (c + 1 < nchunks) RET_LOAD(c + 1);
        u32x2 sgr[4];
        if (full) {
#pragma unroll
            for (int nt = 0; nt < 4; ++nt) {
                const int n = 16 * nt + j;
                sgr[nt] = n < CL ? *(const u32x2*)(proj + (size_t)(row0 + c * 64 + n) * LDP + 1536 + h * 128 + 16 * w + 4 * ig) : (u32x2){0u, 0u};
            }
        }
        LDS_BAR();
        f32x4 o[4];
        if (full) {
            const int mt = w & 3;
#pragma unroll
            for (int q2 = 0; q2 < 2; ++q2) {
                const int nt = 2 * (w >> 2) + q2;
                f32x4 s = (f32x4){0.f, 0.f, 0.f, 0.f};
#pragma unroll
                for (int kb = 0; kb < 4; ++kb) s = mma(frag(lds + R_K, 16 * mt + j, SQ, ig, kb), frag(lds + R_Q, 16 * nt + j, SQ, ig, kb), s);
                const int n = 16 * nt + j, m0 = 16 * mt + 4 * ig;
#pragma unroll
                for (int t = 0; t < 4; ++t) { const int df = n - (m0 + t); s[t] = df >= 0 ? s[t] * ex2(lg2 * (float)df) : 0.f; }
                u32x2 p; p.x = pk2(s[0], s[1]); p.y = pk2(s[2], s[3]);
                *(LAS u32x2*)(lds + R_SP + n * ST + m0 * 2) = p;
            }
            LDS_BAR();
            bf16x8 rt[4], vt[2], qf[4][4], sf[4][2];
#pragma unroll
            for (int kb = 0; kb < 4; ++kb) rt[kb] = frag(lds + R_RT, 16 * w + j, SQ, ig, kb);
#pragma unroll
            for (int kb = 0; kb < 2; ++kb) vt[kb] = frag(lds + R_VT, 16 * w + j, ST, ig, kb);
#pragma unroll
            for (int nt = 0; nt < 4; ++nt) {
#pragma unroll
                for (int kb = 0; kb < 4; ++kb) qf[nt][kb] = frag(lds + R_Q, 16 * nt + j, SQ, ig, kb);
#pragma unroll
                for (int kb = 0; kb < 2; ++kb) sf[nt][kb] = frag(lds + R_SP, 16 * nt + j, ST, ig, kb);
            }
            f32x4 a[4], b[4];
#pragma unroll
            for (int nt = 0; nt < 4; ++nt) { a[nt] = (f32x4){0.f, 0.f, 0.f, 0.f}; b[nt] = (f32x4){0.f, 0.f, 0.f, 0.f}; }
#pragma unroll
            for (int kb = 0; kb < 4; ++kb)
#pragma unroll
                for (int nt = 0; nt < 4; ++nt) a[nt] = mma(rt[kb], qf[nt][kb], a[nt]);
#pragma unroll
            for (int kb = 0; kb < 2; ++kb)
#pragma unroll
                for (int nt = 0; nt < 4; ++nt) b[nt] = mma(vt[kb], sf[nt][kb], b[nt]);
#pragma unroll
            for (int nt = 0; nt < 4; ++nt) {
                const float qd = ex2(lg2 * (float)(16 * nt + j + 1));
                o[nt] = b[nt] + a[nt] * qd;
                float s1 = (o[nt][0] + o[nt][1]) + (o[nt][2] + o[nt][3]);
                float s2 = (o[nt][0] * o[nt][0] + o[nt][1] * o[nt][1]) + (o[nt][2] * o[nt][2] + o[nt][3] * o[nt][3]);
                s1 += __shfl_xor(s1, 16); s1 += __shfl_xor(s1, 32); s2 += __shfl_xor(s2, 16); s2 += __shfl_xor(s2, 32);
                if (ig == 0) *(LAS f32x2*)(lds + R_ST + ((16 * nt + j) * 8 + w) * 8) = (f32x2){s1, s2};
            }
        }
        {
            bf16x8 vt[2], kt[8][2];
#pragma unroll
            for (int kb = 0; kb < 2; ++kb) vt[kb] = frag(lds + R_VT, 16 * w + j, ST, ig, kb);
#pragma unroll
            for (int dt = 0; dt < 8; ++dt)
#pragma unroll
                for (int kb = 0; kb < 2; ++kb) kt[dt][kb] = frag(lds + R_KT, 16 * dt + j, ST, ig, kb);
#pragma unroll
            for (int dt = 0; dt < 8; ++dt) R[dt] = R[dt] * cdec;
#pragma unroll
            for (int kb = 0; kb < 2; ++kb)
#pragma unroll
                for (int dt = 0; dt < 8; ++dt) R[dt] = mma(kt[dt][kb], vt[kb], R[dt]);
        }
        if (full && c + 1 < nchunks) {
#pragma unroll
            for (int dt = 0; dt < 8; ++dt) { u32x2 p; p.x = pk2(R[dt][0], R[dt][1]); p.y = pk2(R[dt][2], R[dt][3]); *(LAS u32x2*)(lds + R_RT + (16 * w + j) * SQ + (16 * dt + 4 * ig) * 2) = p; }
        }
        LDS_BAR();
        if (full) {
            const f32x4 gw = *(const f32x4*)(gnw + h * 128 + 16 * w + 4 * ig);
#pragma unroll
            for (int nt = 0; nt < 4; ++nt) {
                const int n = 16 * nt + j;
                if (n < CL) {
                    const LAS f32x4* sp = (const LAS f32x4*)(lds + R_ST + n * 64);
                    const f32x4 p0 = sp[0], p1 = sp[1], p2 = sp[2], p3 = sp[3];
                    const float s1 = (p0[0] + p0[2]) + (p1[0] + p1[2]) + (p2[0] + p2[2]) + (p3[0] + p3[2]);
                    const float s2 = (p0[1] + p0[3]) + (p1[1] + p1[3]) + (p2[1] + p2[3]) + (p3[1] + p3[3]);
                    const float mean = s1 * (1.0f / 128.0f);
                    const float var = fmaxf(s2 * (1.0f / 128.0f) - mean * mean, 0.f);
                    const float rstd = __builtin_amdgcn_rsqf(var + pg8::GN_EPS);
                    const size_t row = (size_t)(row0 + c * 64 + n);
                    const u32x2 sg = sgr[nt];
                    const float g0 = bf2f(sg.x & 0xffffu), g1 = bf2f(sg.x >> 16), g2 = bf2f(sg.y & 0xffffu), g3 = bf2f(sg.y >> 16);
                    u32x2 p;
                    p.x = pk2((o[nt][0] - mean) * rstd * gw[0] * g0, (o[nt][1] - mean) * rstd * gw[1] * g1);
                    p.y = pk2((o[nt][2] - mean) * rstd * gw[2] * g2, (o[nt][3] - mean) * rstd * gw[3] * g3);
                    *(u32x2*)(mix + row * DM + h * 128 + 16 * w + 4 * ig) = p;
                }
            }
        }
    }
#undef RET_LOAD
    if (rdst) {
#pragma unroll
        for (int dt = 0; dt < 8; ++dt)
#pragma unroll
            for (int t = 0; t < 4; ++t) rdst[(16 * dt + 4 * ig + t) * 128 + 16 * w + j] = R[dt][t];
    }
    LDS_BAR();
}
__device__ __forceinline__ float head_lg2(int h) { return h == 0 ? -0.04580368961312479f : h == 1 ? -0.02272007650008353f : h == 2 ? -0.011315313227834146f : -0.005646563141142063f; }

__device__ __forceinline__ void conv_phase(const bf16_t* proj, bf16_t* mix, const float* conv_w  , const float* sconv  , int bx_, int nthr) {
    int tid_o = threadIdx.x; asm volatile("" : "+v"(tid_o));
    const int gtid = bx_ * NTHR + tid_o;
    const int nitems = (MT / 16) * 64;
    for (int it = gtid; it < nitems; it += nthr) {
        const int co = it & 63, rb = it >> 6, r0 = rb * 16, c0 = co * 8;
        float w0[8], w1[8], w2[8], um2[8], um1[8];
#pragma unroll
        for (int e = 0; e < 8; ++e) { w0[e] = conv_w[(c0 + e) * 3 + 0]; w1[e] = conv_w[(c0 + e) * 3 + 1]; w2[e] = conv_w[(c0 + e) * 3 + 2]; }
        const bool seq_start = r0 < MP ? ((r0 & (SEQ - 1)) == 0) : true;
        if (seq_start) {
            if (r0 < MP) {
#pragma unroll
                for (int e = 0; e < 8; ++e) { um2[e] = 0.f; um1[e] = 0.f; }
            } else {
                const float* sb = sconv + (size_t)((r0 - MP) >> 4) * 1024 + c0;
#pragma unroll
                for (int e = 0; e < 8; ++e) { um2[e] = sb[e]; um1[e] = sb[512 + e]; }
            }
        } else {
            const u32x4 a = *(const u32x4*)(proj + (size_t)(r0 - 2) * LDP + 2560 + c0), b = *(const u32x4*)(proj + (size_t)(r0 - 1) * LDP + 2560 + c0);
#pragma unroll
            for (int e = 0; e < 4; ++e) { um2[2 * e] = bf2f(a[e] & 0xffffu); um2[2 * e + 1] = bf2f(a[e] >> 16); um1[2 * e] = bf2f(b[e] & 0xffffu); um1[2 * e + 1] = bf2f(b[e] >> 16); }
        }
#pragma unroll 4
        for (int i = 0; i < 16; ++i) {
            const size_t row = (size_t)(r0 + i);
            const u32x4 uu = *(const u32x4*)(proj + row * LDP + 2560 + c0), bb = *(const u32x4*)(proj + row * LDP + 2048 + c0);
            float res[8];
#pragma unroll
            for (int e = 0; e < 4; ++e) {
                const float u0 = bf2f(uu[e] & 0xffffu), u1 = bf2f(uu[e] >> 16), b0 = bf2f(bb[e] & 0xffffu), b1 = bf2f(bb[e] >> 16);
                res[2 * e] = b0 * (w0[2 * e] * um2[2 * e] + w1[2 * e] * um1[2 * e] + w2[2 * e] * u0);
                res[2 * e + 1] = b1 * (w0[2 * e + 1] * um2[2 * e + 1] + w1[2 * e + 1] * um1[2 * e + 1] + w2[2 * e + 1] * u1);
                um2[2 * e] = um1[2 * e]; um1[2 * e] = u0; um2[2 * e + 1] = um1[2 * e + 1]; um1[2 * e + 1] = u1;
            }
            u32x4 o; o.x = pk2(res[0], res[1]); o.y = pk2(res[2], res[3]); o.z = pk2(res[4], res[5]); o.w = pk2(res[6], res[7]);
            *(u32x4*)(mix + row * DM + 512 + c0) = o;
        }
    }
}

__device__ __forceinline__ void conv_weight(const float* W, int K, int N, bf16_t* Wt, const float* ksc, int mode, int gtid, int nthr) {
    const int nitems = (K / 8) * N;
    for (int it = gtid; it < nitems; it += nthr) {
        const int ko = it / N, np = it - ko * N, k0 = ko * 8;
        int col = np; float cs = 1.f;
        if (mode == 1) {
            const int pn = np >> 8, bj = (np >> 7) & 1, t = np & 127;
            if (pn < 4) { col = (pn < 2 ? 0 : 512) + 128 * (2 * (pn & 1) + (t >> 6)) + 64 * bj + (t & 63); if (pn >= 2) cs = 0.08838834764831845f; }
            else if (pn >= 10) col = (bj ? 3072 : 2560) + 128 * (pn - 10) + t;
        }
        float v[8];
#pragma unroll
        for (int e = 0; e < 8; ++e) v[e] = W[(size_t)(k0 + e) * N + col] * (ksc ? ksc[k0 + e] : 1.f) * cs;
        u32x4 o; o.x = pk2(v[0], v[1]); o.y = pk2(v[2], v[3]); o.z = pk2(v[4], v[5]); o.w = pk2(v[6], v[7]);
        *(u32x4*)(Wt + (size_t)np * K + k0) = o;
    }
}
__device__ __forceinline__ float wave_sum(float v) {
#pragma unroll
    for (int o = 1; o < 64; o <<= 1) v += __shfl_xor(v, o);
    return v;
}

struct Args { const float* in[13]; float* out; unsigned char* ws; };

__global__ void __launch_bounds__(NTHR, 2) hymba_fwd(Args args) {
    extern __shared__ __attribute__((aligned(16))) unsigned char lds_raw[];
    LAS unsigned char* lds = (LAS unsigned char*)lds_raw;
    cg::grid_group grid = cg::this_grid();
    const int tid = threadIdx.x, lane = tid & 63, wave = __builtin_amdgcn_readfirstlane(tid >> 6);
    const int G = gridDim.x, bx = blockIdx.x;
    const int gtid = bx * NTHR + tid, nthr = G * NTHR, gw = bx * 8 + wave, ngw = G * 8;
    unsigned char* ws = args.ws;
    const float* x_prompt = args.in[0]; const float* x_sample = args.in[1]; const float* state_ret = args.in[2]; const float* state_conv = args.in[3];
    const float* ln1_w = args.in[4]; const float* w_in = args.in[5]; const float* conv_w = args.in[6]; const float* ret_norm_w = args.in[7];
    const float* w_out = args.in[8]; const float* ln2_w = args.in[9]; const float* w_up = args.in[10]; const float* w_dn = args.in[11]; const float* ln_f_w = args.in[12];
    float* out = args.out;
    bf16_t* WtIn = (bf16_t*)(ws + WS_WIN); bf16_t* WtOut = (bf16_t*)(ws + WS_WOUT); bf16_t* WtUp = (bf16_t*)(ws + WS_WUP); bf16_t* WtDn = (bf16_t*)(ws + WS_WDN);
    float* ssp = (float*)(ws + WS_SSP); float* sseg = (float*)(ws + WS_SSEG);
    bf16_t* xb = (bf16_t*)(ws + WS_XB); bf16_t* proj = (bf16_t*)(ws + WS_PROJ); bf16_t* mix = (bf16_t*)(ws + WS_MIX); bf16_t* Hb = (bf16_t*)(ws + WS_H);
    unsigned* ctl = (unsigned*)(ws + WS_CTL); float* part = (float*)(ws + WS_PART);
    volatile LAS unsigned* MISC = (volatile LAS unsigned*)(lds + 131072 + 512);
    if (tid < 64) MISC[tid] = 0u;
    if (bx == 0) { for (int i = tid; i < CTL_WORDS; i += NTHR) ctl[i] = 0u; }
    __syncthreads();
    int kslice = 256; asm volatile("" : "+s"(kslice));
    LAS float* rbuf = (LAS float*)(lds + 131072 + 1024);
    float* X = out;

#pragma unroll 1
    for (int l = 0; l < DEPTH; ++l) {
        conv_weight(w_in + (size_t)l * DM * NIN, DM, NIN, WtIn + (size_t)l * NIN * DM, ln1_w + l * DM, 1, gtid, nthr);
        conv_weight(w_out + (size_t)l * DM * DM, DM, DM, WtOut + (size_t)l * DM * DM, nullptr, 0, gtid, nthr);
        conv_weight(w_up + (size_t)l * DM * DFF, DM, DFF, WtUp + (size_t)l * DFF * DM, ln2_w + l * DM, 0, gtid, nthr);
        conv_weight(w_dn + (size_t)l * DFF * DM, DFF, DM, WtDn + (size_t)l * DM * DFF, nullptr, 0, gtid, nthr);
    }
    for (int r = gw; r < MT; r += ngw) {
        const float* xr = r < MP ? x_prompt + (size_t)r * DM : x_sample + (size_t)(r - MP) * DM;
        float s = 0.f;
#pragma unroll
        for (int q = 0; q < 4; ++q) {
            const f32x4 v = *(const f32x4*)(xr + 256 * q + 4 * lane);
            u32x2 p; p.x = pk2(v[0], v[1]); p.y = pk2(v[2], v[3]);
            *(u32x2*)(xb + (size_t)r * DM + 256 * q + 4 * lane) = p;
            s += (v[0] * v[0] + v[1] * v[1]) + (v[2] * v[2] + v[3] * v[3]);
        }
        s = wave_sum(s);
        if (lane < 16) ssp[(size_t)r * 16 + lane] = lane == 0 ? s : 0.f;
    }
    grid.sync();
    XcdBarrier bar = xcd_barrier_post(ctl, MISC + 8);

#pragma unroll 1
    for (int l = 0; l < DEPTH; ++l) {
        {
            const bf16_t* Bw = WtIn + (size_t)l * NIN * DM;
            pg8::EpiIn E{proj, rbuf, out + O_CONVP + (size_t)l * NBATCH * 1024, out + O_CONVS + (size_t)l * DBATCH * 1024};
            { pg8::Gemm g{xb, Bw, MP, NIN, DM, DM}; pg8::StaticOrder S; S.init(MP, NIN, G, bx); pg8::rstd_prepass(rbuf, ssp, S); pg8::gemm_phase<pg8::EpiIn, pg8::StaticOrder, true, true>(lds, g, S, E); }
#pragma unroll 1
            for (int s = 0; s < DM / 256; ++s) {
                pg8::Gemm g{xb + s * 256, Bw + s * 256, MT, NIN, DM, kslice}; pg8::SliceOrder S{s * (NIN / 256), NIN / 256, bx}; pg8::rstd_prepass(rbuf, ssp, S);
                pg8::SplitEpi<pg8::EpiIn> E2{E, part, ctl + CW_CNT + (l * 4 + 0) * 128, s, DM / 256};
                pg8::gemm_phase<pg8::SplitEpi<pg8::EpiIn>, pg8::SliceOrder, false, true>(lds, g, S, E2);
            }
        }
        xcd_barrier(bar);
        for (int k2 = 0; ; ++k2) {
            int it;
            if (G == 256) { if (k2 == 0) it = bx; else if (k2 == 1 && bx >= 224) it = bx + 32; else break; }
            else { it = bx + k2 * G; if (it >= 288) break; }
            if (it < 224) {
                const int b = it / 28, rem = it - b * 28, h = rem / 7, sg = rem - h * 7;
                ret_item(lds, proj, mix, b * SEQ + sg * 512, 8, 64, h, head_lg2(h), false, 0, nullptr, 0, sseg + (size_t)((b * 4 + h) * 8 + sg) * 16384, nullptr);
            } else {
                const int si = it - 224, b = si >> 2, h = si & 3;
                ret_item(lds, proj, mix, MP + b * DSEQ, 1, DSEQ, h, head_lg2(h), true, 2, state_ret + (size_t)((l * DBATCH + b) * 4 + h) * 16384, 0,
                         out + O_RETS + (size_t)((l * DBATCH + b) * 4 + h) * 16384, ret_norm_w + l * 512);
            }
        }
        conv_phase(proj, mix, conv_w + (size_t)l * 512 * 3, state_conv + (size_t)l * DBATCH * 1024, bx, nthr);
        xcd_barrier(bar);
        for (int it = bx; it < 256; it += G) {
            const int b = it >> 5, h = (it >> 3) & 3, sg = it & 7;
            ret_item(lds, proj, mix, b * SEQ + sg * 512, 8, 64, h, head_lg2(h), true, sg > 0 ? 1 : 0, sseg + (size_t)((b * 4 + h) * 8) * 16384, sg,
                     sg == 7 ? out + O_RETP + (size_t)((l * NBATCH + b) * 4 + h) * 16384 : nullptr, ret_norm_w + l * 512);
        }
        xcd_barrier(bar);
        {
            const bf16_t* Bw = WtOut + (size_t)l * DM * DM;
            pg8::EpiRes E{l == 0 ? x_prompt : X, l == 0 ? x_sample : X + (size_t)MP * DM, X, xb, ssp};
            { pg8::Gemm g{mix, Bw, MP, DM, DM, DM}; pg8::StaticOrder S; S.init(MP, DM, G, bx); pg8::gemm_phase<pg8::EpiRes, pg8::StaticOrder, true, true>(lds, g, S, E); }
#pragma unroll 1
            for (int s = 0; s < DM / 256; ++s) {
                pg8::Gemm g{mix + s * 256, Bw + s * 256, MT, DM, DM, kslice}; pg8::SliceOrder S{s * (DM / 256), DM / 256, bx};
                pg8::SplitEpi<pg8::EpiRes> E2{E, part, ctl + CW_CNT + (l * 4 + 1) * 128, s, DM / 256};
                pg8::gemm_phase<pg8::SplitEpi<pg8::EpiRes>, pg8::SliceOrder, false, true>(lds, g, S, E2);
            }
        }
        xcd_barrier(bar);
        {
            const bf16_t* Bw = WtUp + (size_t)l * DFF * DM;
            pg8::EpiUp E{Hb, rbuf};
            { pg8::Gemm g{xb, Bw, MP, DFF, DM, DM}; pg8::StaticOrder S; S.init(MP, DFF, G, bx); pg8::rstd_prepass(rbuf, ssp, S); pg8::gemm_phase<pg8::EpiUp, pg8::StaticOrder, true, true>(lds, g, S, E); }
#pragma unroll 1
            for (int s = 0; s < DM / 256; ++s) {
                pg8::Gemm g{xb + s * 256, Bw + s * 256, MT, DFF, DM, kslice}; pg8::SliceOrder S{s * (DFF / 256), DFF / 256, bx}; pg8::rstd_prepass(rbuf, ssp, S);
                pg8::SplitEpi<pg8::EpiUp> E2{E, part, ctl + CW_CNT + (l * 4 + 2) * 128, s, DM / 256};
                pg8::gemm_phase<pg8::SplitEpi<pg8::EpiUp>, pg8::SliceOrder, false, true>(lds, g, S, E2);
            }
        }
        xcd_barrier(bar);
        {
            const bf16_t* Bw = WtDn + (size_t)l * DM * DFF;
            pg8::EpiRes E{X, X + (size_t)MP * DM, X, xb, ssp};
            { pg8::Gemm g{Hb, Bw, MP, DM, DFF, DFF}; pg8::StaticOrder S; S.init(MP, DM, G, bx); pg8::gemm_phase<pg8::EpiRes, pg8::StaticOrder, true, true>(lds, g, S, E); }
#pragma unroll 1
            for (int s = 0; s < 4; ++s) {
                pg8::Gemm g{Hb + s * 1024, Bw + s * 1024, MT, DM, DFF, 4 * kslice}; pg8::SliceOrder S{s * (DM / 256), DM / 256, bx};
                pg8::SplitEpi<pg8::EpiRes> E2{E, part, ctl + CW_CNT + (l * 4 + 3) * 128, s, 4};
                pg8::gemm_phase<pg8::SplitEpi<pg8::EpiRes>, pg8::SliceOrder, false, true>(lds, g, S, E2);
            }
        }
        xcd_barrier(bar);
    }
    int tid2 = threadIdx.x; asm volatile("" : "+v"(tid2));
    const int lane2 = tid2 & 63, gw2 = bx * 8 + __builtin_amdgcn_readfirstlane(tid2 >> 6);
    for (int r = gw2; r < MT; r += ngw) {
        const float rs = pg8::row_rstd(ssp, r);
        float* xr = X + (size_t)r * DM;
#pragma unroll
        for (int q = 0; q < 4; ++q) {
            const f32x4 v = *(const f32x4*)(xr + 256 * q + 4 * lane2), wv = *(const f32x4*)(ln_f_w + 256 * q + 4 * lane2);
            *(f32x4*)(xr + 256 * q + 4 * lane2) = v * rs * wv;
        }
    }
}

extern "C" void kernel_launch(void* const* d_in, const int* in_sizes, int n_in, void* d_out, int out_size, void* d_ws, size_t ws_size, hipStream_t stream) {
    static int grid = 0;
    if (grid == 0) {
        int dev = 0, cus = 0, per_cu = 0;
        if (n_in != 13 || ws_size < WS_END) { fprintf(stderr, "kernel_launch: unexpected n_in %d / ws_size %zu (need %zu)\n", n_in, ws_size, (size_t)WS_END); grid = -1; return; }
        hipGetDevice(&dev);
        hipDeviceGetAttribute(&cus, hipDeviceAttributeMultiprocessorCount, dev);
        hipFuncSetAttribute((const void*)hymba_fwd, hipFuncAttributeMaxDynamicSharedMemorySize, LDS_BYTES);
        hipOccupancyMaxActiveBlocksPerMultiprocessor(&per_cu, (const void*)hymba_fwd, NTHR, LDS_BYTES);
        if (per_cu < 1) { fprintf(stderr, "kernel_launch: occupancy query says %d blocks/CU\n", per_cu); per_cu = 1; }
        (void)hipGetLastError();
        grid = cus;
    }
    if (grid < 0) return;
    Args a{};
    for (int i = 0; i < 13; ++i) a.in[i] = (const float*)d_in[i];
    a.out = (float*)d_out; a.ws = (unsigned char*)d_ws;
    void* kargs[] = {&a};
    hipError_t e = hipLaunchCooperativeKernel((const void*)hymba_fwd, dim3(grid), dim3(NTHR), kargs, LDS_BYTES, stream);
    if (e != hipSuccess) fprintf(stderr, "cooperative launch failed: %s (grid %d)\n", hipGetErrorString(e), grid);
}
```

```cpp
#include <hip/hip_runtime.h>
#include <hip/hip_cooperative_groups.h>
#include <cstdio>
#include <cstdint>
namespace cg = cooperative_groups;
namespace pg8 {
#define PG8_LAS __attribute__((address_space(3)))
typedef unsigned short bf16_t;
typedef short bf16x8 __attribute__((ext_vector_type(8)));
typedef float f32x4 __attribute__((ext_vector_type(4)));
typedef unsigned u32x4 __attribute__((ext_vector_type(4)));
constexpr int BM = 256, BK = 64, HALF = 128, HTB = HALF * BK * 2  , STAGE_BYTES = 8 * HTB, NXCD = 8, WGM = 8;

__host__ __device__ __forceinline__ int lds_byte(int r, int c) { const int st = (r >> 4) * 2 + (c >> 5), rr = r & 15, cc = c & 31, ob = rr * 64 + cc * 2; return st * 1024 + (ob ^ (((ob >> 9) & 1) << 5)); }
__host__ __device__ __forceinline__ void stage_rc(int b, int& R, int& C) { const int st = b / 1024, sb = b % 1024, swz = sb ^ (((sb >> 9) & 1) << 5); R = (st >> 1) * 16 + swz / 64; C = (st & 1) * 32 + (swz % 64) / 2; }
__host__ __device__ __forceinline__ int perm32(int rho) { const int n = rho >> 4, i = rho & 15; return 8 * (i >> 2) + 4 * n + (i & 3); }

struct Unit { int pm, pn, idx; };
struct Gemm { const bf16_t* A; const bf16_t* Bt; int M, N, K, Kloop; };

struct StaticOrder {
    int nM, nN, nwg, G, c;
    __host__ __device__ __forceinline__ void init(int M, int N, int G_, int c_) { nM = M / BM; nN = N / BM; nwg = nM * nN; G = G_; c = c_; }
    __host__ __device__ __forceinline__ void map(int L, int& pm, int& pn) const {
        int wgid = L; { const int q = nwg / NXCD, r = nwg % NXCD, xcd = wgid % NXCD, off = wgid / NXCD; wgid = (xcd < r ? xcd * (q + 1) : r * (q + 1) + (xcd - r) * q) + off; }
        const int nig = WGM * nN, gid = wgid / nig, fm = gid * WGM, gsz = (nM - fm) < WGM ? (nM - fm) : WGM;
        pm = fm + ((wgid % nig) % gsz); pn = (wgid % nig) / gsz;
    }
    __host__ __device__ __forceinline__ bool next(int i, Unit& u) const {
        const long L = (long)i * G + c; if (L >= nwg) return false;
        int wgid = (int)L; { const int q = nwg / NXCD, r = nwg % NXCD, xcd = wgid % NXCD, off = wgid / NXCD; wgid = (xcd < r ? xcd * (q + 1) : r * (q + 1) + (xcd - r) * q) + off; }
        const int nig = WGM * nN, gid = wgid / nig, fm = gid * WGM, gsz = (nM - fm) < WGM ? (nM - fm) : WGM;
        u.pm = fm + ((wgid % nig) % gsz); u.pn = (wgid % nig) / gsz; u.idx = i; return true;
    }
    __device__ __forceinline__ void a_ready(const Unit&) const {}
    __device__ __forceinline__ void done(const Unit&) const {}
};

__device__ __forceinline__ unsigned cvt_pk_bf16(float lo, float hi) { unsigned r; asm volatile("v_cvt_pk_bf16_f32 %0, %1, %2" : "=v"(r) : "v"(lo), "v"(hi)); return r; }
typedef float f32x2 __attribute__((ext_vector_type(2)));

constexpr int DM = 1024, NBATCH = 8, SEQ = 4096, DEPTH = 2, DBATCH = 16, DSEQ = 16, PAST = 2048;
constexpr int MP = NBATCH * SEQ, MS = DBATCH * DSEQ, MT = MP + MS;
constexpr int NIN = 3584, DFF = 4096, LDP = 3072;
constexpr float RMS_EPS = 1e-6f, GN_EPS = 1e-5f;

__device__ __forceinline__ void store8bf(bf16_t* p, const f32x4 a, const f32x4 b) {
    u32x4 w; w.x = cvt_pk_bf16(a[0], a[1]); w.y = cvt_pk_bf16(a[2], a[3]); w.z = cvt_pk_bf16(b[0], b[1]); w.w = cvt_pk_bf16(b[2], b[3]);
    *(u32x4*)p = w;
}
__device__ __forceinline__ float row_rstd(const float* ssp, int r) {
    const f32x4* sp = (const f32x4*)(ssp + (size_t)r * 16);
    const f32x4 s0 = sp[0], s1 = sp[1], s2 = sp[2], s3 = sp[3];
    const f32x4 s = (s0 + s1) + (s2 + s3);
    const float tot = (s[0] + s[1]) + (s[2] + s[3]);
    return __builtin_amdgcn_rsqf(tot * (1.0f / DM) + RMS_EPS);
}
__device__ __forceinline__ float silu_f(float x) { return x * __builtin_amdgcn_rcpf(1.0f + __builtin_amdgcn_exp2f(-1.4426950408889634f * x)); }

struct EpiIn {
    static constexpr bool PERM = true, AFTER_DRAIN = false;
    bf16_t* proj; const PG8_LAS float* rbuf; float* nconv_p; float* nconv_s;
    __device__ __forceinline__ void operator()(f32x4 (&acc)[2][2][4][2], const Unit& u, int wr, int wc, int fr, int fq, unsigned gmask = 0xffu) const {
        const int pn = u.pn, tcol = wc * 32 + 8 * fq;
        const PG8_LAS float* rb = rbuf + u.idx * BM + wr * 64 + fr;
        if (pn < 4) {
            const int i0 = 32 * (wc & 1) + 8 * fq;
            float ir[8];
#pragma unroll
            for (int e = 0; e < 8; ++e) ir[e] = __builtin_amdgcn_exp2f(-(float)(i0 + e) * (13.287712379549449f / 64.0f)) * 0.15915494309189535f;
            const int dcol = (pn < 2 ? 0 : 512) + 128 * (2 * (pn & 1) + (wc >> 1)) + i0;
#pragma unroll
            for (int ai = 0; ai < 2; ++ai)
#pragma unroll
                for (int m = 0; m < 4; ++m) {
                    if (!((gmask >> (ai * 4 + m)) & 1u)) continue;
                    const int r = u.pm * BM + ai * HALF + wr * 64 + m * 16 + fr;
                    const float rs = rb[ai * HALF + m * 16];
                    float fp = (float)(r < MP ? (r & (SEQ - 1)) : PAST + (r & (DSEQ - 1)));
                    asm volatile("" : "+v"(fp) :: "memory");
                    f32x4 o1[2], o2[2];
#pragma unroll
                    for (int n = 0; n < 2; ++n)
#pragma unroll
                        for (int e = 0; e < 4; ++e) {
                            const float rev = fp * ir[4 * n + e], f = __builtin_amdgcn_fractf(rev);
                            const float c = __builtin_amdgcn_cosf(f), s = __builtin_amdgcn_sinf(f);
                            const float x1 = acc[ai][0][m][n][e] * rs, x2 = acc[ai][1][m][n][e] * rs;
                            o1[n][e] = x1 * c - x2 * s; o2[n][e] = x1 * s + x2 * c;
                        }
                    bf16_t* prow = proj + (size_t)r * LDP + dcol;
                    store8bf(prow, o1[0], o1[1]); store8bf(prow + 64, o2[0], o2[1]);
                }
        } else {
#pragma unroll
            for (int ai = 0; ai < 2; ++ai)
#pragma unroll
                for (int m = 0; m < 4; ++m) {
                    if (!((gmask >> (ai * 4 + m)) & 1u)) continue;
                    const int r = u.pm * BM + ai * HALF + wr * 64 + m * 16 + fr;
                    const float rs = rb[ai * HALF + m * 16];
                    const f32x4 a0 = acc[ai][0][m][0] * rs, a1 = acc[ai][0][m][1] * rs, b0 = acc[ai][1][m][0] * rs, b1 = acc[ai][1][m][1] * rs;
                    bf16_t* prow = proj + (size_t)r * LDP;
                    if (pn < 10) {
                        f32x4 x0 = a0, x1 = a1, y0 = b0, y1 = b1;
                        if (pn == 6 || pn == 7) {
#pragma unroll
                            for (int e = 0; e < 4; ++e) { x0[e] = silu_f(x0[e]); x1[e] = silu_f(x1[e]); y0[e] = silu_f(y0[e]); y1[e] = silu_f(y1[e]); }
                        }
                        const int dcol = 256 * pn + tcol;
                        store8bf(prow + dcol, x0, x1); store8bf(prow + dcol + 128, y0, y1);
                    } else {
                        const f32x4 u0 = a0 * b0, u1 = a1 * b1;
                        const int cc = 128 * (pn - 10) + tcol;
                        store8bf(prow + 2560 + cc, u0, u1);
                        if (r < MP) { const int t = r & (SEQ - 1); if (t >= SEQ - 2) { float* d = nconv_p + (size_t)((r >> 12) * 2 + (t - (SEQ - 2))) * 512 + cc; *(f32x4*)d = u0; *(f32x4*)(d + 4) = u1; } }
                        else { const int t = r & (DSEQ - 1); if (t >= DSEQ - 2) { float* d = nconv_s + (size_t)(((r - MP) >> 4) * 2 + (t - (DSEQ - 2))) * 512 + cc; *(f32x4*)d = u0; *(f32x4*)(d + 4) = u1; } }
                    }
                }
        }
    }
};
struct EpiRes {
    static constexpr bool PERM = false, AFTER_DRAIN = false;
    const float* xs_main; const float* xs_tail; float* X; bf16_t* xb; float* ssp;
    __device__ __forceinline__ void operator()(f32x4 (&acc)[2][2][4][2], const Unit& u, int wr, int wc, int fr, int fq, unsigned gmask = 0xffu) const {
        typedef unsigned u32x2v __attribute__((ext_vector_type(2)));
        const int cb = u.pn * BM + wc * 32 + 4 * fq;
#pragma unroll
        for (int g = 0; g < 4; ++g) {
            if (!((gmask >> (2 * g)) & 3u)) continue;
            const int ai = g >> 1, mb = (g & 1) * 2;
            const int r0 = u.pm * BM + ai * HALF + wr * 64 + mb * 16 + fr;
            const float* xs = (r0 < MP ? xs_main + (size_t)r0 * DM : xs_tail + (size_t)(r0 - MP) * DM) + cb;
            f32x4 xv[2][2][2];
#pragma unroll
            for (int m = 0; m < 2; ++m)
#pragma unroll
                for (int bj = 0; bj < 2; ++bj)
#pragma unroll
                    for (int n = 0; n < 2; ++n) xv[m][bj][n] = *(const f32x4*)(xs + (size_t)m * 16 * DM + bj * HALF + n * 16);
#pragma unroll
            for (int m = 0; m < 2; ++m) {
                if (!((gmask >> (2 * g + m)) & 1u)) continue;
                const int r = r0 + m * 16;
                float ss = 0.f;
#pragma unroll
                for (int bj = 0; bj < 2; ++bj)
#pragma unroll
                    for (int n = 0; n < 2; ++n) {
                        const int c = cb + bj * HALF + n * 16;
                        const f32x4 v = xv[m][bj][n] + acc[ai][bj][mb + m][n];
                        *(f32x4*)(X + (size_t)r * DM + c) = v;
                        u32x2v w; w.x = cvt_pk_bf16(v[0], v[1]); w.y = cvt_pk_bf16(v[2], v[3]);
                        *(u32x2v*)(xb + (size_t)r * DM + c) = w;
                        ss += (v[0] * v[0] + v[1] * v[1]) + (v[2] * v[2] + v[3] * v[3]);
                    }
                ss += __shfl_xor(ss, 16); ss += __shfl_xor(ss, 32);
                if (fq == 0) ssp[(size_t)r * 16 + 4 * u.pn + wc] = ss;
            }
            asm volatile("" ::: "memory");
        }
    }
};
struct EpiUp {
    static constexpr bool PERM = true, AFTER_DRAIN = false;
    bf16_t* H; const PG8_LAS float* rbuf;
    __device__ __forceinline__ void operator()(f32x4 (&acc)[2][2][4][2], const Unit& u, int wr, int wc, int fr, int fq, unsigned gmask = 0xffu) const {
        const PG8_LAS float* rb = rbuf + u.idx * BM + wr * 64 + fr;
#pragma unroll
        for (int ai = 0; ai < 2; ++ai)
#pragma unroll
            for (int m = 0; m < 4; ++m) {
                if (!((gmask >> (ai * 4 + m)) & 1u)) continue;
                const int r = u.pm * BM + ai * HALF + wr * 64 + m * 16 + fr;
                const float rs = rb[ai * HALF + m * 16];
                bf16_t* hrow = H + (size_t)r * DFF + u.pn * BM + wc * 32 + 8 * fq;
#pragma unroll
                for (int bj = 0; bj < 2; ++bj) {
                    f32x4 v0 = acc[ai][bj][m][0] * rs, v1 = acc[ai][bj][m][1] * rs;
#pragma unroll
                    for (int e = 0; e < 4; ++e) { const float p = fmaxf(v0[e], 0.f), q = fmaxf(v1[e], 0.f); v0[e] = p * p; v1[e] = q * q; }
                    store8bf(hrow + bj * HALF, v0, v1);
                }
            }
    }
};
template <class Sched> __device__ __forceinline__ void rstd_prepass(PG8_LAS float* rbuf, const float* ssp, const Sched& S) {
    int tid = threadIdx.x; asm volatile("" : "+v"(tid));
    const int row = tid >> 1, half = tid & 1;
    Unit u;
    for (int i = 0; S.next(i, u); ++i) {
        const f32x4* sp = (const f32x4*)(ssp + (size_t)(u.pm * BM + row) * 16 + half * 8);
        const f32x4 a = sp[0], b = sp[1];
        float t = ((a[0] + a[1]) + (a[2] + a[3])) + ((b[0] + b[1]) + (b[2] + b[3]));
        t += __shfl_xor(t, 1);
        if (half == 0) rbuf[i * BM + row] = __builtin_amdgcn_rsqf(t * (1.0f / DM) + RMS_EPS);
    }
    __syncthreads();
}
struct SliceOrder {
    int first, nN, c;
    __device__ __forceinline__ bool next(int i, Unit& u) const { const int idx = c - first; u.pm = MP / BM; u.pn = idx; u.idx = 0; return i == 0 && idx >= 0 && idx < nN; }
    __device__ __forceinline__ void a_ready(const Unit&) const {}
    __device__ __forceinline__ void done(const Unit&) const {}
};
template <class E, int NSL> struct SplitEpi {
    static constexpr bool PERM = E::PERM, AFTER_DRAIN = false;
    E e; float* part; unsigned* cnt; unsigned* tmo; int slice;
    __device__ __forceinline__ void operator()(f32x4 (&acc)[2][2][4][2], const Unit& u, int wr, int wc, int fr, int fq) const {
        constexpr int NG = 8 / NSL;
        const int wid = wr * 4 + wc, lane = fq * 16 + fr;
        f32x4* base = (f32x4*)part + (size_t)(u.pn * 8 + wid) * 32 * 64 + lane;
        const size_t sstride = (size_t)16 * 8 * 32 * 64;
        f32x4* dst = base + (size_t)slice * sstride;
#pragma unroll
        for (int q = 0; q < 32; ++q) asm volatile("global_store_dwordx4 %0, %1, off sc1\n\ts_nop 2" :: "v"(dst + q * 64), "v"(acc[q >> 4][(q >> 3) & 1][(q >> 1) & 3][q & 1]) : "memory");
        asm volatile("s_waitcnt vmcnt(0)" ::: "memory");
        unsigned* cw = cnt + u.pn * 8 + wid;
        if (lane == 0) __hip_atomic_fetch_add(cw, 1u, __ATOMIC_RELAXED, __HIP_MEMORY_SCOPE_AGENT);
        { unsigned sp = 0u;
          while ((unsigned)__builtin_amdgcn_readfirstlane((int)__hip_atomic_load(cw, __ATOMIC_RELAXED, __HIP_MEMORY_SCOPE_AGENT)) < (unsigned)NSL) {
              __builtin_amdgcn_s_sleep(1);
              if (++sp > (1u << 20)) { if (lane == 0) __hip_atomic_store(tmo, 1u, __ATOMIC_RELAXED, __HIP_MEMORY_SCOPE_AGENT); break; }
          } }
        __builtin_amdgcn_fence(__ATOMIC_ACQUIRE, "agent");
#pragma unroll
        for (int s = 0; s < NSL; ++s) {
            if (slice != s) continue;
            f32x4 sum[NG][4];
#pragma unroll
            for (int gi = 0; gi < NG; ++gi)
#pragma unroll
                for (int p = 0; p < 4; ++p) sum[gi][p] = (f32x4){0.f, 0.f, 0.f, 0.f};
#pragma unroll
            for (int sb = 0; sb < NSL; sb += 4) {
                f32x4 t[4][NG][4];
#pragma unroll
                for (int sl = sb; sl < sb + 4; ++sl)
#pragma unroll
                    for (int gi = 0; gi < NG; ++gi)
#pragma unroll
                        for (int p = 0; p < 4; ++p) {
                            const int g = s * NG + gi, ai = g >> 2, m = g & 3, bj = p >> 1, n = p & 1, q = ((ai * 2 + bj) * 4 + m) * 2 + n;
                            if (sl != s) t[sl - sb][gi][p] = base[(size_t)sl * sstride + q * 64];
                        }
#pragma unroll
                for (int sl = sb; sl < sb + 4; ++sl)
#pragma unroll
                    for (int gi = 0; gi < NG; ++gi)
#pragma unroll
                        for (int p = 0; p < 4; ++p) {
                            const int g = s * NG + gi, ai = g >> 2, m = g & 3, bj = p >> 1, n = p & 1;
                            sum[gi][p] += (sl == s) ? acc[ai][bj][m][n] : t[sl - sb][gi][p];
                        }
                asm volatile("" ::: "memory");
            }
#pragma unroll
            for (int gi = 0; gi < NG; ++gi)
#pragma unroll
                for (int p = 0; p < 4; ++p) { const int g = s * NG + gi; acc[g >> 2][p >> 1][g & 3][p & 1] = sum[gi][p]; }
            e(acc, u, wr, wc, fr, fq, ((1u << NG) - 1u) << (s * NG));
        }
    }
};
template <class Epi, class Sched, bool ALIGN_EPI = false, bool SP2 = false>
__device__ __forceinline__ void gemm_phase(PG8_LAS unsigned char* lds, const Gemm g, const Sched& S, const Epi& E) {
    int tid_o = threadIdx.x; asm volatile("" : "+v"(tid_o));
    const int tid = tid_o, wid = __builtin_amdgcn_readfirstlane(tid >> 6), lane = tid & 63, wr = wid >> 2, wc = wid & 3, fr = lane & 15, fq = lane >> 4;
    const int K = g.K, nt = g.Kloop / BK;
    unsigned voffA[2], voffB[2];
#pragma unroll
    for (int i = 0; i < 2; ++i) { int R, C; stage_rc(tid * 16 + i * 8192, R, C); const int Rb = Epi::PERM ? ((R & ~31) + perm32(R & 31)) : R;
        voffA[i] = (unsigned)(R * K + C) * 2u; voffB[i] = (unsigned)(Rb * K + C) * 2u; }
    const size_t kstep = (size_t)(BK * 2);
    const size_t hstep = (size_t)HALF * K * 2;
    const size_t tstep = 2 * hstep;
    const unsigned ldsw = (unsigned)wid * 1024u;
    const int aoff = lds_byte(wr * 64 + fr, fq * 8), boff = lds_byte(wc * 32 + fr, fq * 8);
#define PG8_SA(b, h) (((b) * 2 + (h)) * HTB)
#define PG8_SB(b, h) ((4 + (b) * 2 + (h)) * HTB)
#define PG8_STAGE(bufoff, gbase, voff) do { _Pragma("unroll") for (int _i = 0; _i < 2; ++_i) \
        __builtin_amdgcn_global_load_lds((const unsigned*)((const char*)(gbase) + (voff)[_i]), (PG8_LAS unsigned*)(lds + (bufoff) + ldsw + _i * 8192), 16, 0, 0); } while (0)
#define PG8_LDA(dst, b, h) do { _Pragma("unroll") for (int m = 0; m < 4; ++m) _Pragma("unroll") for (int k = 0; k < 2; ++k) dst[m][k] = *(const PG8_LAS bf16x8*)(lds + PG8_SA(b, h) + aoff + m * 2048 + k * 1024); } while (0)
#define PG8_LDB(dst, b, h) do { _Pragma("unroll") for (int n = 0; n < 2; ++n) _Pragma("unroll") for (int k = 0; k < 2; ++k) dst[n][k] = *(const PG8_LAS bf16x8*)(lds + PG8_SB(b, h) + boff + n * 2048 + k * 1024); } while (0)
#define PG8_MMA(ai, bj, At, Bt) do { __builtin_amdgcn_s_setprio(1); _Pragma("unroll") for (int m = 0; m < 4; ++m) _Pragma("unroll") for (int n = 0; n < 2; ++n) _Pragma("unroll") for (int k = 0; k < 2; ++k) \
        acc[ai][bj][m][n] = __builtin_amdgcn_mfma_f32_16x16x32_bf16(Bt[n][k], At[m][k], acc[ai][bj][m][n], 0, 0, 0); __builtin_amdgcn_s_setprio(0); } while (0)
#define PG8_WAIT_V(n) asm volatile("s_waitcnt vmcnt(" #n ")" ::: "memory")
#define PG8_WAIT_L(n) asm volatile("s_waitcnt lgkmcnt(" #n ")" ::: "memory")
#define PG8_BAR __builtin_amdgcn_s_barrier()
#define PG8_SCHED __builtin_amdgcn_sched_barrier(0)
    Unit cur, nxt; int ui = 0;
    if (!S.next(0, cur)) return;
    f32x4 acc[2][2][4][2];
#pragma unroll
    for (int a = 0; a < 2; ++a)
#pragma unroll
        for (int b = 0; b < 2; ++b)
#pragma unroll
            for (int m = 0; m < 4; ++m)
#pragma unroll
                for (int n = 0; n < 2; ++n) acc[a][b][m][n] = (f32x4){0.f, 0.f, 0.f, 0.f};
    bf16x8 At[4][2], B0[2][2], B1[2][2];
    const char* cA = (const char*)g.A + (size_t)cur.pm * tstep; const char* cB = (const char*)g.Bt + (size_t)cur.pn * tstep;
    S.a_ready(cur);
    if constexpr (SP2) {
        PG8_STAGE(PG8_SB(0, 0), cB, voffB); PG8_STAGE(PG8_SB(0, 1), cB + hstep, voffB); PG8_STAGE(PG8_SA(0, 0), cA, voffA); PG8_STAGE(PG8_SA(0, 1), cA + hstep, voffA);
        if (wr == 1) PG8_BAR;
        PG8_WAIT_V(2); PG8_BAR;
        PG8_STAGE(PG8_SB(1, 0), cB + kstep, voffB); PG8_STAGE(PG8_SA(1, 0), cA + kstep, voffA); PG8_STAGE(PG8_SB(1, 1), cB + hstep + kstep, voffB);
        PG8_WAIT_V(6); PG8_BAR;
    } else {
        PG8_STAGE(PG8_SB(0, 0), cB, voffB); PG8_STAGE(PG8_SA(0, 0), cA, voffA); PG8_STAGE(PG8_SB(0, 1), cB + hstep, voffB); PG8_STAGE(PG8_SA(0, 1), cA + hstep, voffA);
        if (wr == 1) PG8_BAR;
        PG8_WAIT_V(4); PG8_BAR;
        PG8_STAGE(PG8_SB(1, 0), cB + kstep, voffB); PG8_STAGE(PG8_SA(1, 0), cA + kstep, voffA); PG8_STAGE(PG8_SB(1, 1), cB + hstep + kstep, voffB);
        PG8_WAIT_V(6); PG8_BAR;
    }
    for (;;) {
        const bool has_next = S.next(ui + 1, nxt);
        const char* nA = has_next ? (const char*)g.A + (size_t)nxt.pm * tstep : cA; const char* nB = has_next ? (const char*)g.Bt + (size_t)nxt.pn * tstep : cB;
        for (int t = 0; t < nt; t += 2) {
            const bool last = (t == nt - 2);
            const char* a1 = cA + (size_t)(t + 1) * kstep;
            const char* a2 = last ? nA : cA + (size_t)(t + 2) * kstep; const char* b2 = last ? nB : cB + (size_t)(t + 2) * kstep;
            const char* a3 = a2 + kstep; const char* b3 = b2 + kstep;
            if (last && has_next) S.a_ready(nxt);
            if constexpr (SP2) {
            PG8_LDB(B0, 0, 0); PG8_LDB(B1, 0, 1); PG8_SCHED; PG8_LDA(At, 0, 0); PG8_STAGE(PG8_SA(1, 1), a1 + hstep, voffA);
            PG8_WAIT_V(8); PG8_WAIT_L(0); PG8_BAR; PG8_MMA(0, 0, At, B0); PG8_MMA(0, 1, At, B1); PG8_BAR; PG8_SCHED;
            PG8_LDA(At, 0, 1); PG8_STAGE(PG8_SB(0, 0), b2, voffB); PG8_STAGE(PG8_SB(0, 1), b2 + hstep, voffB); PG8_STAGE(PG8_SA(0, 0), a2, voffA);
            PG8_WAIT_V(8); PG8_WAIT_L(0); PG8_BAR; PG8_MMA(1, 0, At, B0); PG8_MMA(1, 1, At, B1); PG8_BAR; PG8_SCHED;
            PG8_LDB(B0, 1, 0); PG8_LDB(B1, 1, 1); PG8_SCHED; PG8_LDA(At, 1, 0); PG8_STAGE(PG8_SA(0, 1), a2 + hstep, voffA);
            PG8_WAIT_V(8); PG8_WAIT_L(0); PG8_BAR; PG8_MMA(0, 0, At, B0); PG8_MMA(0, 1, At, B1); PG8_BAR; PG8_SCHED;
            PG8_LDA(At, 1, 1); PG8_STAGE(PG8_SB(1, 0), b3, voffB); PG8_STAGE(PG8_SB(1, 1), b3 + hstep, voffB); PG8_STAGE(PG8_SA(1, 0), a3, voffA);
            PG8_WAIT_V(8); PG8_WAIT_L(0); PG8_BAR; PG8_MMA(1, 0, At, B0); PG8_MMA(1, 1, At, B1); PG8_BAR; PG8_SCHED;
            } else {
            PG8_LDB(B0, 0, 0); PG8_SCHED; PG8_LDA(At, 0, 0); PG8_STAGE(PG8_SA(1, 1), a1 + hstep, voffA);
            PG8_WAIT_L(8); PG8_BAR; PG8_WAIT_L(0); PG8_MMA(0, 0, At, B0); PG8_BAR; PG8_SCHED;
            PG8_LDB(B1, 0, 1); PG8_STAGE(PG8_SB(0, 0), b2, voffB);
            PG8_BAR; PG8_WAIT_L(0); PG8_MMA(0, 1, At, B1); PG8_BAR;
            PG8_LDA(At, 0, 1); PG8_STAGE(PG8_SA(0, 0), a2, voffA);
            PG8_BAR; PG8_WAIT_L(0); PG8_MMA(1, 0, At, B0); PG8_BAR; PG8_SCHED;
            PG8_STAGE(PG8_SB(0, 1), b2 + hstep, voffB);
            PG8_WAIT_V(6); PG8_BAR; PG8_MMA(1, 1, At, B1); PG8_BAR;
            PG8_LDB(B0, 1, 0); PG8_SCHED; PG8_LDA(At, 1, 0); PG8_STAGE(PG8_SA(0, 1), a2 + hstep, voffA);
            PG8_WAIT_L(8); PG8_BAR; PG8_WAIT_L(0); PG8_MMA(0, 0, At, B0); PG8_BAR; PG8_SCHED;
            PG8_LDB(B1, 1, 1); PG8_STAGE(PG8_SB(1, 0), b3, voffB);
            PG8_BAR; PG8_WAIT_L(0); PG8_MMA(0, 1, At, B1); PG8_BAR;
            PG8_LDA(At, 1, 1); PG8_STAGE(PG8_SA(1, 0), a3, voffA);
            PG8_BAR; PG8_WAIT_L(0); PG8_MMA(1, 0, At, B0); PG8_BAR; PG8_SCHED;
            PG8_STAGE(PG8_SB(1, 1), b3 + hstep, voffB);
            PG8_WAIT_V(6); PG8_BAR; PG8_MMA(1, 1, At, B1); PG8_BAR;
            }
        }
        if constexpr (ALIGN_EPI) { if (wr == 0) PG8_BAR; }
        if constexpr (!Epi::AFTER_DRAIN) { E(acc, cur, wr, wc, fr, fq); S.done(cur); }
        if (!has_next) break;
#pragma unroll
        for (int a = 0; a < 2; ++a)
#pragma unroll
            for (int b = 0; b < 2; ++b)
#pragma unroll
                for (int m = 0; m < 4; ++m)
#pragma unroll
                    for (int n = 0; n < 2; ++n) acc[a][b][m][n] = (f32x4){0.f, 0.f, 0.f, 0.f};
        cur = nxt; cA = nA; cB = nB; ++ui;
        if constexpr (ALIGN_EPI) { if (wr == 1) PG8_BAR; }
    }
    PG8_WAIT_V(0);
    if constexpr (!ALIGN_EPI) { if (wr == 0) PG8_BAR; }
    PG8_BAR;
    if constexpr (Epi::AFTER_DRAIN) { E.fused(acc, cur, wr, wc, fr, fq, lds, wid, lane); S.done(cur); }
#undef PG8_SA
#undef PG8_SB
#undef PG8_STAGE
#undef PG8_LDA
#undef PG8_LDB
#undef PG8_MMA
#undef PG8_WAIT_V
#undef PG8_WAIT_L
#undef PG8_BAR
#undef PG8_SCHED
}
}
#define LAS __attribute__((address_space(3)))
#define XB_TMO      128
#define XB_XCNT(j)  (256  + 64 * (j))
#define XB_XSUB(j)  (1280 + 64 * (j))
#define XB_XGEN(j)  (2304 + 64 * (j))
#define XB_TOP      3328
#define XB_TOPGEN   3392
#define XCD_BAR_WORDS 3456
#define XB_SPIN_CAP (1u << 18)

__device__ __forceinline__ unsigned xb_ld(unsigned* p)              { return __hip_atomic_load(p, __ATOMIC_RELAXED, __HIP_MEMORY_SCOPE_AGENT); }
__device__ __forceinline__ unsigned xb_add(unsigned* p, unsigned v) { return __hip_atomic_fetch_add(p, v, __ATOMIC_RELAXED, __HIP_MEMORY_SCOPE_AGENT); }
__device__ __forceinline__ unsigned xb_xcc_id() { return (unsigned)__builtin_amdgcn_s_getreg((3 << 11) | 20) & 0xFu; }
#define XB_SPIN(cond, bar) do { unsigned _sp = 0; while (cond) { __builtin_amdgcn_s_sleep(1); \
    if ((++_sp & 255u) == 0u) { if (xb_ld(&(bar)[XB_TMO])) break; if (_sp > XB_SPIN_CAP) { atomicAdd(&(bar)[XB_TMO], 1u); break; } } } } while (0)

struct XcdBarrier {
    unsigned* bar; unsigned x;
    volatile LAS unsigned* st;
};

__device__ __forceinline__ XcdBarrier xcd_barrier_post(unsigned* bar, volatile LAS unsigned* st) {
    XcdBarrier b; b.bar = bar; b.x = xb_xcc_id(); b.st = st;
    if (threadIdx.x == 0) (void)xb_add(&bar[XB_XCNT(b.x)], 1u);
    return b;
}
__device__ __forceinline__ void xcd_barrier_complete(unsigned* bar, unsigned x, unsigned& nloc, unsigned& nx) {
    const unsigned G = gridDim.x * gridDim.y * gridDim.z;
    unsigned sum, cnt, mine, sp = 0u;
    for (;;) {
        sum = 0u; cnt = 0u; mine = 0u;
#pragma unroll
        for (unsigned j = 0; j < 16; ++j) { const unsigned c = xb_ld(&bar[XB_XCNT(j)]); sum += c; cnt += (c > 0u) ? 1u : 0u; mine = (j == x) ? c : mine; }
        if (sum == G) break;
        __builtin_amdgcn_s_sleep(1);
        if ((++sp & 255u) == 0u) { if (xb_ld(&bar[XB_TMO])) break; if (sp > XB_SPIN_CAP) { atomicAdd(&bar[XB_TMO], 1u); break; } }
    }
    nloc = mine > 0u ? mine : 1u; nx = cnt > 0u ? cnt : 1u;
}

__device__ __forceinline__ void xcd_barrier(const XcdBarrier& b) {
    asm volatile("s_waitcnt vmcnt(0)" ::: "memory");
    __syncthreads();
    if (threadIdx.x == 0) {
        unsigned* bar = b.bar;
        __builtin_amdgcn_s_waitcnt(0);
        unsigned nloc = b.st[0], nx = b.st[1];
        if (nloc == 0u) { xcd_barrier_complete(bar, b.x, nloc, nx); b.st[0] = nloc; b.st[1] = nx; }
        const unsigned old = xb_add(&bar[XB_XSUB(b.x)], 1u);
        const unsigned gen = old / nloc;
        if (old + 1u == (gen + 1u) * nloc) {
            __builtin_amdgcn_fence(__ATOMIC_RELEASE, "agent");
            asm volatile("s_waitcnt vmcnt(0)" ::: "memory");
            const unsigned og = xb_add(&bar[XB_TOP], 1u);
            const unsigned tg = og / nx;
            if (og + 1u == (tg + 1u) * nx) xb_add(&bar[XB_TOPGEN], 1u);
            else XB_SPIN(xb_ld(&bar[XB_TOPGEN]) == tg, bar);
            __builtin_amdgcn_fence(__ATOMIC_ACQUIRE, "agent");
            xb_add(&bar[XB_XGEN(b.x)], 1u);
            asm volatile("s_waitcnt vmcnt(0)" ::: "memory");
        } else {
            XB_SPIN(xb_ld(&bar[XB_XGEN(b.x)]) == gen, bar);
            __builtin_amdgcn_fence(__ATOMIC_ACQUIRE, "agent");
            asm volatile("s_waitcnt vmcnt(0)" ::: "memory");
        }
    }
    __syncthreads();
}

using pg8::bf16_t; using pg8::bf16x8; using pg8::f32x4; using pg8::u32x4;
using pg8::DM; using pg8::MP; using pg8::MS; using pg8::MT; using pg8::NIN; using pg8::DFF; using pg8::LDP; using pg8::SEQ; using pg8::DSEQ;
using pg8::NBATCH; using pg8::DBATCH; using pg8::DEPTH;
#define LAS __attribute__((address_space(3)))
typedef unsigned u32x2 __attribute__((ext_vector_type(2)));
typedef float f32x2 __attribute__((ext_vector_type(2)));

constexpr int NTHR = 512;
constexpr int LDS_BYTES = 147456;
constexpr size_t O_YP = 0, O_YS = (size_t)MP * DM, O_RETP = O_YS + (size_t)MS * DM, O_CONVP = O_RETP + (size_t)DEPTH * NBATCH * 4 * 16384,
                 O_RETS = O_CONVP + (size_t)DEPTH * NBATCH * 2 * 512, O_CONVS = O_RETS + (size_t)DEPTH * DBATCH * 4 * 16384;
constexpr size_t MiB = 1u << 20;
constexpr size_t WS_WIN = 0, WS_WOUT = 14 * MiB, WS_WUP = 18 * MiB, WS_WDN = 34 * MiB;
constexpr size_t WS_COS = 50 * MiB, WS_SIN = 51 * MiB, WS_SSP = 52 * MiB, WS_SSEG = 55 * MiB;
constexpr size_t WS_CTL = 54 * MiB + 512 * 1024;
constexpr int CTL_WORDS = 8192, CW_CNT = 4096;
constexpr size_t WS_PART = 400 * MiB;
constexpr size_t WS_XB = 71 * MiB;
constexpr size_t WS_PROJ = 136 * MiB;
constexpr size_t WS_MIX = WS_PROJ + (size_t)MT * LDP * 2;
constexpr size_t WS_H = WS_PROJ;
constexpr size_t WS_END = WS_MIX + (size_t)MT * DM * 2;
static_assert(WS_END <= WS_PART && WS_PART + 64 * MiB <= 512 * MiB && WS_XB + (size_t)MT * DM * 2 <= WS_PROJ && WS_END <= 512 * MiB && WS_H + (size_t)MT * DFF * 2 <= WS_END, "ws map");

__device__ __forceinline__ float bf2f(unsigned b) { return __uint_as_float(b << 16); }
__device__ __forceinline__ unsigned pk2(float lo, float hi) { return pg8::cvt_pk_bf16(lo, hi); }
__device__ __forceinline__ float ex2(float x) { return __builtin_amdgcn_exp2f(x); }
__device__ __forceinline__ f32x4 mma(const bf16x8 x, const bf16x8 y, const f32x4 c) { return __builtin_amdgcn_mfma_f32_16x16x32_bf16(x, y, c, 0, 0, 0); }
__device__ __forceinline__ bf16x8 frag(LAS unsigned char* base, int row, int stride, int kg, int kb) { return *(const LAS bf16x8*)(base + row * stride + 16 * kg + 64 * kb); }

constexpr int R_Q = 0, R_K = 17408, R_KT = 34816, R_VT = 53248, R_SP = 71680, R_RT = 80896, R_ST = 115712;
constexpr int SQ = 272, ST = 144;
#define LDS_BAR() do { asm volatile("s_waitcnt lgkmcnt(0)" ::: "memory"); __builtin_amdgcn_s_barrier(); asm volatile("" ::: "memory"); } while (0)
__device__ __forceinline__ void ret_item(LAS unsigned char* lds, const bf16_t* proj, bf16_t* mix, int row0, int nchunks, int CL, int h, float lg2, bool full,
                                         int rinit, const float* rsrc, int nprefix, float* rdst, const float* gnw) {
    int tid_o = threadIdx.x; asm volatile("" : "+v"(tid_o));
    const int tid = tid_o, w = __builtin_amdgcn_readfirstlane(tid >> 6), lane = tid & 63, j = lane & 15, ig = lane >> 4;
    f32x4 R[8];
#pragma unroll
    for (int dt = 0; dt < 8; ++dt) R[dt] = (f32x4){0.f, 0.f, 0.f, 0.f};
    if (rinit == 2) {
#pragma unroll
        for (int dt = 0; dt < 8; ++dt)
#pragma unroll
            for (int t = 0; t < 4; ++t) R[dt][t] = rsrc[(16 * dt + 4 * ig + t) * 128 + 16 * w + j];
    } else if (rinit == 1) {
#pragma unroll 1
        for (int s = 0; s < nprefix; ++s) {
            const float sc = ex2(lg2 * 512.f * (float)(nprefix - 1 - s));
            const float* rp = rsrc + (size_t)s * 16384 + 16 * w + j;
#pragma unroll
            for (int dt = 0; dt < 8; ++dt)
#pragma unroll
                for (int t = 0; t < 4; ++t) R[dt][t] += rp[(16 * dt + 4 * ig + t) * 128] * sc;
        }
    }
    if (full) {
#pragma unroll
        for (int dt = 0; dt < 8; ++dt) { u32x2 p; p.x = pk2(R[dt][0], R[dt][1]); p.y = pk2(R[dt][2], R[dt][3]); *(LAS u32x2*)(lds + R_RT + (16 * w + j) * SQ + (16 * dt + 4 * ig) * 2) = p; }
    }
    const float cdec = ex2(lg2 * (float)CL);
    const float kdec = ex2(lg2 * (float)(CL - 1 - lane));
    u32x4 qreg[2], kreg[2], vreg[2];
    const u32x4 zero4 = (u32x4){0u, 0u, 0u, 0u};
#define RET_LOAD(c) do { _Pragma("unroll") for (int it = 0; it < 2; ++it) { \
        const int qm = (tid + NTHR * it) >> 4, qd = (tid + NTHR * it) & 15, kd = w + 8 * it; \
        const bf16_t* rb = proj + (size_t)(row0 + (c) * 64) * LDP + h * 128; \
        qreg[it] = (full && qm < CL) ? *(const u32x4*)(rb + (size_t)qm * LDP + 8 * qd) : zero4; \
        kreg[it] = (lane < CL) ? *(const u32x4*)(rb + (size_t)lane * LDP + 512 + 8 * kd) : zero4; \
        vreg[it] = (lane < CL) ? *(const u32x4*)(rb + (size_t)lane * LDP + 1024 + 8 * kd) : zero4; } } while (0)
    RET_LOAD(0);
    for (int c = 0; c < nchunks; ++c) {
#pragma unroll
        for (int it = 0; it < 2; ++it) {
            const int qm = (tid + NTHR * it) >> 4, qd = (tid + NTHR * it) & 15, kd = w + 8 * it;
            if (full) { *(LAS u32x4*)(lds + R_Q + qm * SQ + 16 * qd) = qreg[it]; *(LAS u32x4*)(lds + R_K + lane * SQ + 16 * kd) = kreg[it]; }
#pragma unroll
            for (int e = 0; e < 4; ++e) {
                const unsigned kw = kreg[it][e], vw = vreg[it][e];
                const unsigned kp = pk2(bf2f(kw & 0xffffu) * kdec, bf2f(kw >> 16) * kdec);
                *(LAS unsigned short*)(lds + R_KT + (8 * kd + 2 * e) * ST + 2 * lane) = (unsigned short)(kp & 0xffffu);
                *(LAS unsigned short*)(lds + R_KT + (8 * kd + 2 * e + 1) * ST + 2 * lane) = (unsigned short)(kp >> 16);
                *(LAS unsigned short*)(lds + R_VT + (8 * kd + 2 * e) * ST + 2 * lane) = (unsigned short)(vw & 0xffffu);
                *(LAS unsigned short*)(lds + R_VT + (8 * kd + 2 * e + 1) * ST + 2 * lane) = (unsigned short)(vw >> 16);
            }
        }
        if (c + 1 < nchunks) RET_LOAD(c + 1);
        u32x2 sgr[4];
        if (full) {
#pragma unroll
            for (int nt = 0; nt < 4; ++nt) {
                const int n = 16 * nt + j;
                sgr[nt] = n < CL ? *(const u32x2*)(proj + (size_t)(row0 + c * 64 + n) * LDP + 1536 + h * 128 + 16 * w + 4 * ig) : (u32x2){0u, 0u};
            }
        }
        LDS_BAR();
        f32x4 o[4];
        if (full) {
            const int mt = w & 3;
#pragma unroll
            for (int q2 = 0; q2 < 2; ++q2) {
                const int nt = 2 * (w >> 2) + q2;
                f32x4 s = (f32x4){0.f, 0.f, 0.f, 0.f};
#pragma unroll
                for (int kb = 0; kb < 4; ++kb) s = mma(frag(lds + R_K, 16 * mt + j, SQ, ig, kb), frag(lds + R_Q, 16 * nt + j, SQ, ig, kb), s);
                const int n = 16 * nt + j, m0 = 16 * mt + 4 * ig;
#pragma unroll
                for (int t = 0; t < 4; ++t) { const int df = n - (m0 + t); s[t] = df >= 0 ? s[t] * ex2(lg2 * (float)df) : 0.f; }
                u32x2 p; p.x = pk2(s[0], s[1]); p.y = pk2(s[2], s[3]);
                *(LAS u32x2*)(lds + R_SP + n * ST + m0 * 2) = p;
            }
            LDS_BAR();
            bf16x8 rt[4], vt[2], qf[4][4], sf[4][2];
#pragma unroll
            for (int kb = 0; kb < 4; ++kb) rt[kb] = frag(lds + R_RT, 16 * w + j, SQ, ig, kb);
#pragma unroll
            for (int kb = 0; kb < 2; ++kb) vt[kb] = frag(lds + R_VT, 16 * w + j, ST, ig, kb);
#pragma unroll
            for (int nt = 0; nt < 4; ++nt) {
#pragma unroll
                for (int kb = 0; kb < 4; ++kb) qf[nt][kb] = frag(lds + R_Q, 16 * nt + j, SQ, ig, kb);
#pragma unroll
                for (int kb = 0; kb < 2; ++kb) sf[nt][kb] = frag(lds + R_SP, 16 * nt + j, ST, ig, kb);
            }
            f32x4 a[4], b[4];
#pragma unroll
            for (int nt = 0; nt < 4; ++nt) { a[nt] = (f32x4){0.f, 0.f, 0.f, 0.f}; b[nt] = (f32x4){0.f, 0.f, 0.f, 0.f}; }
#pragma unroll
            for (int kb = 0; kb < 4; ++kb)
#pragma unroll
                for (int nt = 0; nt < 4; ++nt) a[nt] = mma(rt[kb], qf[nt][kb], a[nt]);
#pragma unroll
            for (int kb = 0; kb < 2; ++kb)
#pragma unroll
                for (int nt = 0; nt < 4; ++nt) b[nt] = mma(vt[kb], sf[nt][kb], b[nt]);
#pragma unroll
            for (int nt = 0; nt < 4; ++nt) {
                const float qd = ex2(lg2 * (float)(16 * nt + j + 1));
                o[nt] = b[nt] + a[nt] * qd;
                float s1 = (o[nt][0] + o[nt][1]) + (o[nt][2] + o[nt][3]);
                float s2 = (o[nt][0] * o[nt][0] + o[nt][1] * o[nt][1]) + (o[nt][2] * o[nt][2] + o[nt][3] * o[nt][3]);
                s1 += __shfl_xor(s1, 16); s1 += __shfl_xor(s1, 32); s2 += __shfl_xor(s2, 16); s2 += __shfl_xor(s2, 32);
                if (ig == 0) *(LAS f32x2*)(lds + R_ST + ((16 * nt + j) * 8 + w) * 8) = (f32x2){s1, s2};
            }
        }
        {
            bf16x8 vt[2], kt[8][2];
#pragma unroll
            for (int kb = 0; kb < 2; ++kb) vt[kb] = frag(lds + R_VT, 16 * w + j, ST, ig, kb);
#pragma unroll
            for (int dt = 0; dt < 8; ++dt)
#pragma unroll
                for (int kb = 0; kb < 2; ++kb) kt[dt][kb] = frag(lds + R_KT, 16 * dt + j, ST, ig, kb);
#pragma unroll
            for (int dt = 0; dt < 8; ++dt) R[dt] = R[dt] * cdec;
#pragma unroll
            for (int kb = 0; kb < 2; ++kb)
#pragma unroll
                for (int dt = 0; dt < 8; ++dt) R[dt] = mma(kt[dt][kb], vt[kb], R[dt]);
        }
        if (full && c + 1 < nchunks) {
#pragma unroll
            for (int dt = 0; dt < 8; ++dt) { u32x2 p; p.x = pk2(R[dt][0], R[dt][1]); p.y = pk2(R[dt][2], R[dt][3]); *(LAS u32x2*)(lds + R_RT + (16 * w + j) * SQ + (16 * dt + 4 * ig) * 2) = p; }
        }
        LDS_BAR();
        if (full) {
            const f32x4 gw = *(const f32x4*)(gnw + h * 128 + 16 * w + 4 * ig);
#pragma unroll
            for (int nt = 0; nt < 4; ++nt) {
                const int n = 16 * nt + j;
                if (n < CL) {
                    const LAS f32x4* sp = (const LAS f32x4*)(lds + R_ST + n * 64);
                    const f32x4 p0 = sp[0], p1 = sp[1], p2 = sp[2], p3 = sp[3];
                    const float s1 = (p0[0] + p0[2]) + (p1[0] + p1[2]) + (p2[0] + p2[2]) + (p3[0] + p3[2]);
                    const float s2 = (p0[1] + p0[3]) + (p1[1] + p1[3]) + (p2[1] + p2[3]) + (p3[1] + p3[3]);
                    const float mean = s1 * (1.0f / 128.0f);
                    const float var = fmaxf(s2 * (1.0f / 128.0f) - mean * mean, 0.f);
                    const float rstd = __builtin_amdgcn_rsqf(var + pg8::GN_EPS);
                    const size_t row = (size_t)(row0 + c * 64 + n);
                    const u32x2 sg = sgr[nt];
                    const float g0 = bf2f(sg.x & 0xffffu), g1 = bf2f(sg.x >> 16), g2 = bf2f(sg.y & 0xffffu), g3 = bf2f(sg.y >> 16);
                    u32x2 p;
                    p.x = pk2((o[nt][0] - mean) * rstd * gw[0] * g0, (o[nt][1] - mean) * rstd * gw[1] * g1);
                    p.y = pk2((o[nt][2] - mean) * rstd * gw[2] * g2, (o[nt][3] - mean) * rstd * gw[3] * g3);
                    *(u32x2*)(mix + row * DM + h * 128 + 16 * w + 4 * ig) = p;
                }
            }
        }
    }
#undef RET_LOAD
    if (rdst) {
#pragma unroll
        for (int dt = 0; dt < 8; ++dt)
#pragma unroll
            for (int t = 0; t < 4; ++t) rdst[(16 * dt + 4 * ig + t) * 128 + 16 * w + j] = R[dt][t];
    }
    LDS_BAR();
}
__device__ __forceinline__ float head_lg2(int h) { return h == 0 ? -0.04580368961312479f : h == 1 ? -0.02272007650008353f : h == 2 ? -0.011315313227834146f : -0.005646563141142063f; }

__device__ __forceinline__ void conv_phase(const bf16_t* proj, bf16_t* mix, const float* conv_w  , const float* sconv  , int bx_, int nthr) {
    int tid_o = threadIdx.x; asm volatile("" : "+v"(tid_o));
    const int gtid = bx_ * NTHR + tid_o;
    const int nitems = (MT / 16) * 64;
    for (int it = gtid; it < nitems; it += nthr) {
        const int co = it & 63, rb = it >> 6, r0 = rb * 16, c0 = co * 8;
        float w0[8], w1[8], w2[8], um2[8], um1[8];
#pragma unroll
        for (int e = 0; e < 8; ++e) { w0[e] = conv_w[(c0 + e) * 3 + 0]; w1[e] = conv_w[(c0 + e) * 3 + 1]; w2[e] = conv_w[(c0 + e) * 3 + 2]; }
        const bool seq_start = r0 < MP ? ((r0 & (SEQ - 1)) == 0) : true;
        if (seq_start) {
            if (r0 < MP) {
#pragma unroll
                for (int e = 0; e < 8; ++e) { um2[e] = 0.f; um1[e] = 0.f; }
            } else {
                const float* sb = sconv + (size_t)((r0 - MP) >> 4) * 1024 + c0;
#pragma unroll
                for (int e = 0; e < 8; ++e) { um2[e] = sb[e]; um1[e] = sb[512 + e]; }
            }
        } else {
            const u32x4 a = *(const u32x4*)(proj + (size_t)(r0 - 2) * LDP + 2560 + c0), b = *(const u32x4*)(proj + (size_t)(r0 - 1) * LDP + 2560 + c0);
#pragma unroll
            for (int e = 0; e < 4; ++e) { um2[2 * e] = bf2f(a[e] & 0xffffu); um2[2 * e + 1] = bf2f(a[e] >> 16); um1[2 * e] = bf2f(b[e] & 0xffffu); um1[2 * e + 1] = bf2f(b[e] >> 16); }
        }
#pragma unroll 4
        for (int i = 0; i < 16; ++i) {
            const size_t row = (size_t)(r0 + i);
            const u32x4 uu = *(const u32x4*)(proj + row * LDP + 2560 + c0), bb = *(const u32x4*)(proj + row * LDP + 2048 + c0);
            float res[8];
#pragma unroll
            for (int e = 0; e < 4; ++e) {
                const float u0 = bf2f(uu[e] & 0xffffu), u1 = bf2f(uu[e] >> 16), b0 = bf2f(bb[e] & 0xffffu), b1 = bf2f(bb[e] >> 16);
                res[2 * e] = b0 * (w0[2 * e] * um2[2 * e] + w1[2 * e] * um1[2 * e] + w2[2 * e] * u0);
                res[2 * e + 1] = b1 * (w0[2 * e + 1] * um2[2 * e + 1] + w1[2 * e + 1] * um1[2 * e + 1] + w2[2 * e + 1] * u1);
                um2[2 * e] = um1[2 * e]; um1[2 * e] = u0; um2[2 * e + 1] = um1[2 * e + 1]; um1[2 * e + 1] = u1;
            }
            u32x4 o; o.x = pk2(res[0], res[1]); o.y = pk2(res[2], res[3]); o.z = pk2(res[4], res[5]); o.w = pk2(res[6], res[7]);
            *(u32x4*)(mix + row * DM + 512 + c0) = o;
        }
    }
}

__device__ __forceinline__ void conv_weight(const float* W, int K, int N, bf16_t* Wt, const float* ksc, int mode, int gtid, int nthr) {
    const int nitems = (K / 8) * N;
    for (int it = gtid; it < nitems; it += nthr) {
        const int ko = it / N, np = it - ko * N, k0 = ko * 8;
        int col = np; float cs = 1.f;
        if (mode == 1) {
            const int pn = np >> 8, bj = (np >> 7) & 1, t = np & 127;
            if (pn < 4) { col = (pn < 2 ? 0 : 512) + 128 * (2 * (pn & 1) + (t >> 6)) + 64 * bj + (t & 63); if (pn >= 2) cs = 0.08838834764831845f; }
            else if (pn >= 10) col = (bj ? 3072 : 2560) + 128 * (pn - 10) + t;
        }
        float v[8];
#pragma unroll
        for (int e = 0; e < 8; ++e) v[e] = W[(size_t)(k0 + e) * N + col] * (ksc ? ksc[k0 + e] : 1.f) * cs;
        u32x4 o; o.x = pk2(v[0], v[1]); o.y = pk2(v[2], v[3]); o.z = pk2(v[4], v[5]); o.w = pk2(v[6], v[7]);
        *(u32x4*)(Wt + (size_t)np * K + k0) = o;
    }
}
__device__ __forceinline__ float wave_sum(float v) {
#pragma unroll
    for (int o = 1; o < 64; o <<= 1) v += __shfl_xor(v, o);
    return v;
}

struct Args { const float* in[13]; float* out; unsigned char* ws; };

__global__ void __launch_bounds__(NTHR, 2) hymba_fwd(Args args) {
    extern __shared__ __attribute__((aligned(16))) unsigned char lds_raw[];
    LAS unsigned char* lds = (LAS unsigned char*)lds_raw;
    cg::grid_group grid = cg::this_grid();
    const int tid = threadIdx.x, lane = tid & 63, wave = __builtin_amdgcn_readfirstlane(tid >> 6);
    const int G = gridDim.x, bx = blockIdx.x;
    const int gtid = bx * NTHR + tid, nthr = G * NTHR, gw = bx * 8 + wave, ngw = G * 8;
    unsigned char* ws = args.ws;
    const float* x_prompt = args.in[0]; const float* x_sample = args.in[1]; const float* state_ret = args.in[2]; const float* state_conv = args.in[3];
    const float* ln1_w = args.in[4]; const float* w_in = args.in[5]; const float* conv_w = args.in[6]; const float* ret_norm_w = args.in[7];
    const float* w_out = args.in[8]; const float* ln2_w = args.in[9]; const float* w_up = args.in[10]; const float* w_dn = args.in[11]; const float* ln_f_w = args.in[12];
    float* out = args.out;
    bf16_t* WtIn = (bf16_t*)(ws + WS_WIN); bf16_t* WtOut = (bf16_t*)(ws + WS_WOUT); bf16_t* WtUp = (bf16_t*)(ws + WS_WUP); bf16_t* WtDn = (bf16_t*)(ws + WS_WDN);
    float* ssp = (float*)(ws + WS_SSP); float* sseg = (float*)(ws + WS_SSEG);
    bf16_t* xb = (bf16_t*)(ws + WS_XB); bf16_t* proj = (bf16_t*)(ws + WS_PROJ); bf16_t* mix = (bf16_t*)(ws + WS_MIX); bf16_t* Hb = (bf16_t*)(ws + WS_H);
    unsigned* ctl = (unsigned*)(ws + WS_CTL); float* part = (float*)(ws + WS_PART);
    volatile LAS unsigned* MISC = (volatile LAS unsigned*)(lds + 131072 + 512);
    if (tid < 64) MISC[tid] = 0u;
    if (bx == 0) { for (int i = tid; i < CTL_WORDS; i += NTHR) ctl[i] = 0u; }
    __syncthreads();
    int kslice = 256; asm volatile("" : "+s"(kslice));
    LAS float* rbuf = (LAS float*)(lds + 131072 + 1024);
    float* X = out;

#pragma unroll 1
    for (int l = 0; l < DEPTH; ++l) {
        conv_weight(w_in + (size_t)l * DM * NIN, DM, NIN, WtIn + (size_t)l * NIN * DM, ln1_w + l * DM, 1, gtid, nthr);
        conv_weight(w_out + (size_t)l * DM * DM, DM, DM, WtOut + (size_t)l * DM * DM, nullptr, 0, gtid, nthr);
        conv_weight(w_up + (size_t)l * DM * DFF, DM, DFF, WtUp + (size_t)l * DFF * DM, ln2_w + l * DM, 0, gtid, nthr);
        conv_weight(w_dn + (size_t)l * DFF * DM, DFF, DM, WtDn + (size_t)l * DM * DFF, nullptr, 0, gtid, nthr);
    }
    for (int r = gw; r < MT; r += ngw) {
        const float* xr = r < MP ? x_prompt + (size_t)r * DM : x_sample + (size_t)(r - MP) * DM;
        float s = 0.f;
#pragma unroll
        for (int q = 0; q < 4; ++q) {
            const f32x4 v = *(const f32x4*)(xr + 256 * q + 4 * lane);
            u32x2 p; p.x = pk2(v[0], v[1]); p.y = pk2(v[2], v[3]);
            *(u32x2*)(xb + (size_t)r * DM + 256 * q + 4 * lane) = p;
            s += (v[0] * v[0] + v[1] * v[1]) + (v[2] * v[2] + v[3] * v[3]);
        }
        s = wave_sum(s);
        if (lane < 16) ssp[(size_t)r * 16 + lane] = lane == 0 ? s : 0.f;
    }
    grid.sync();
    XcdBarrier bar = xcd_barrier_post(ctl, MISC + 8);

#pragma unroll 1
    for (int l = 0; l < DEPTH; ++l) {
        {
            const bf16_t* Bw = WtIn + (size_t)l * NIN * DM;
            pg8::EpiIn E{proj, rbuf, out + O_CONVP + (size_t)l * NBATCH * 1024, out + O_CONVS + (size_t)l * DBATCH * 1024};
            { pg8::Gemm g{xb, Bw, MP, NIN, DM, DM}; pg8::StaticOrder S; S.init(MP, NIN, G, bx); pg8::rstd_prepass(rbuf, ssp, S); pg8::gemm_phase<pg8::EpiIn, pg8::StaticOrder, true, true>(lds, g, S, E); }
#pragma unroll 1
            for (int s = 0; s < DM / 256; ++s) {
                pg8::Gemm g{xb + s * 256, Bw + s * 256, MT, NIN, DM, kslice}; pg8::SliceOrder S{s * (NIN / 256), NIN / 256, bx}; pg8::rstd_prepass(rbuf, ssp, S);
                pg8::SplitEpi<pg8::EpiIn, 4> E2{E, part, ctl + CW_CNT + (l * 4 + 0) * 128, ctl + 16, s};
                pg8::gemm_phase<pg8::SplitEpi<pg8::EpiIn, 4>, pg8::SliceOrder, false, true>(lds, g, S, E2);
            }
        }
        xcd_barrier(bar);
        for (int k2 = 0; ; ++k2) {
            int it;
            if (G == 256) { if (k2 == 0) it = bx; else if (k2 == 1 && bx >= 224) it = bx + 32; else break; }
            else { it = bx + k2 * G; if (it >= 288) break; }
            if (it < 224) {
                const int b = it / 28, rem = it - b * 28, h = rem / 7, sg = rem - h * 7;
                ret_item(lds, proj, mix, b * SEQ + sg * 512, 8, 64, h, head_lg2(h), false, 0, nullptr, 0, sseg + (size_t)((b * 4 + h) * 8 + sg) * 16384, nullptr);
            } else {
                const int si = it - 224, b = si >> 2, h = si & 3;
                ret_item(lds, proj, mix, MP + b * DSEQ, 1, DSEQ, h, head_lg2(h), true, 2, state_ret + (size_t)((l * DBATCH + b) * 4 + h) * 16384, 0,
                         out + O_RETS + (size_t)((l * DBATCH + b) * 4 + h) * 16384, ret_norm_w + l * 512);
            }
        }
        conv_phase(proj, mix, conv_w + (size_t)l * 512 * 3, state_conv + (size_t)l * DBATCH * 1024, bx, nthr);
        xcd_barrier(bar);
        for (int it = bx; it < 256; it += G) {
            const int b = it >> 5, h = (it >> 3) & 3, sg = it & 7;
            ret_item(lds, proj, mix, b * SEQ + sg * 512, 8, 64, h, head_lg2(h), true, sg > 0 ? 1 : 0, sseg + (size_t)((b * 4 + h) * 8) * 16384, sg,
                     sg == 7 ? out + O_RETP + (size_t)((l * NBATCH + b) * 4 + h) * 16384 : nullptr, ret_norm_w + l * 512);
        }
        xcd_barrier(bar);
        {
            const bf16_t* Bw = WtOut + (size_t)l * DM * DM;
            pg8::EpiRes E{l == 0 ? x_prompt : X, l == 0 ? x_sample : X + (size_t)MP * DM, X, xb, ssp};
            { pg8::Gemm g{mix, Bw, MP, DM, DM, DM}; pg8::StaticOrder S; S.init(MP, DM, G, bx); pg8::gemm_phase<pg8::EpiRes, pg8::StaticOrder, true, true>(lds, g, S, E); }
#pragma unroll 1
            for (int s = 0; s < DM / 256; ++s) {
                pg8::Gemm g{mix + s * 256, Bw + s * 256, MT, DM, DM, kslice}; pg8::SliceOrder S{s * (DM / 256), DM / 256, bx};
                pg8::SplitEpi<pg8::EpiRes, 4> E2{E, part, ctl + CW_CNT + (l * 4 + 1) * 128, ctl + 16, s};
                pg8::gemm_phase<pg8::SplitEpi<pg8::EpiRes, 4>, pg8::SliceOrder, false, true>(lds, g, S, E2);
            }
        }
        xcd_barrier(bar);
        {
            const bf16_t* Bw = WtUp + (size_t)l * DFF * DM;
            pg8::EpiUp E{Hb, rbuf};
            { pg8::Gemm g{xb, Bw, MP, DFF, DM, DM}; pg8::StaticOrder S; S.init(MP, DFF, G, bx); pg8::rstd_prepass(rbuf, ssp, S); pg8::gemm_phase<pg8::EpiUp, pg8::StaticOrder, true, true>(lds, g, S, E); }
#pragma unroll 1
            for (int s = 0; s < DM / 256; ++s) {
                pg8::Gemm g{xb + s * 256, Bw + s * 256, MT, DFF, DM, kslice}; pg8::SliceOrder S{s * (DFF / 256), DFF / 256, bx}; pg8::rstd_prepass(rbuf, ssp, S);
                pg8::SplitEpi<pg8::EpiUp, 4> E2{E, part, ctl + CW_CNT + (l * 4 + 2) * 128, ctl + 16, s};
                pg8::gemm_phase<pg8::SplitEpi<pg8::EpiUp, 4>, pg8::SliceOrder, false, true>(lds, g, S, E2);
            }
        }
        xcd_barrier(bar);
        {
            const bf16_t* Bw = WtDn + (size_t)l * DM * DFF;
            pg8::EpiRes E{X, X + (size_t)MP * DM, X, xb, ssp};
            { pg8::Gemm g{Hb, Bw, MP, DM, DFF, DFF}; pg8::StaticOrder S; S.init(MP, DM, G, bx); pg8::gemm_phase<pg8::EpiRes, pg8::StaticOrder, true, true>(lds, g, S, E); }
#pragma unroll 1
            for (int s = 0; s < 8; ++s) {
                pg8::Gemm g{Hb + s * 512, Bw + s * 512, MT, DM, DFF, 2 * kslice}; pg8::SliceOrder S{s * (DM / 256), DM / 256, bx};
                pg8::SplitEpi<pg8::EpiRes, 8> E2{E, part, ctl + CW_CNT + (l * 4 + 3) * 128, ctl + 16, s};
                pg8::gemm_phase<pg8::SplitEpi<pg8::EpiRes, 8>, pg8::SliceOrder, false, true>(lds, g, S, E2);
            }
        }
        xcd_barrier(bar);
    }
    int tid2 = threadIdx.x; asm volatile("" : "+v"(tid2));
    const int lane2 = tid2 & 63, gw2 = bx * 8 + __builtin_amdgcn_readfirstlane(tid2 >> 6);
    for (int r = gw2; r < MT; r += ngw) {
        const float rs = pg8::row_rstd(ssp, r);
        float* xr = X + (size_t)r * DM;
#pragma unroll
        for (int q = 0; q < 4; ++q) {
            const f32x4 v = *(const f32x4*)(xr + 256 * q + 4 * lane2), wv = *(const f32x4*)(ln_f_w + 256 * q + 4 * lane2);
            *(f32x4*)(xr + 256 * q + 4 * lane2) = v * rs * wv;
        }
    }
}

extern "C" void kernel_launch(void* const* d_in, const int* in_sizes, int n_in, void* d_out, int out_size, void* d_ws, size_t ws_size, hipStream_t stream) {
    static int grid = 0;
    if (grid == 0) {
        int dev = 0, cus = 0, per_cu = 0;
        if (n_in != 13 || ws_size < WS_END) { fprintf(stderr, "kernel_launch: unexpected n_in %d / ws_size %zu (need %zu)\n", n_in, ws_size, (size_t)WS_END); grid = -1; return; }
        hipGetDevice(&dev);
        hipDeviceGetAttribute(&cus, hipDeviceAttributeMultiprocessorCount, dev);
        hipFuncSetAttribute((const void*)hymba_fwd, hipFuncAttributeMaxDynamicSharedMemorySize, LDS_BYTES);
        hipOccupancyMaxActiveBlocksPerMultiprocessor(&per_cu, (const void*)hymba_fwd, NTHR, LDS_BYTES);
        if (per_cu < 1) { fprintf(stderr, "kernel_launch: occupancy query says %d blocks/CU\n", per_cu); per_cu = 1; }
        (void)hipGetLastError();
        grid = cus;
    }
    if (grid < 0) return;
    Args a{};
    for (int i = 0; i < 13; ++i) a.in[i] = (const float*)d_in[i];
    a.out = (float*)d_out; a.ws = (unsigned char*)d_ws;
    void* kargs[] = {&a};
    hipError_t e = hipLaunchCooperativeKernel((const void*)hymba_fwd, dim3(grid), dim3(NTHR), kargs, LDS_BYTES, stream);
    if (e != hipSuccess) fprintf(stderr, "cooperative launch failed: %s (grid %d)\n", hipGetErrorString(e), grid);
}
```

```cpp
#include <hip/hip_runtime.h>
#include <hip/hip_cooperative_groups.h>
#include <cstdio>
#include <cstdint>
namespace cg = cooperative_groups;
namespace pg8 {
#define PG8_LAS __attribute__((address_space(3)))
typedef unsigned short bf16_t;
typedef short bf16x8 __attribute__((ext_vector_type(8)));
typedef float f32x4 __attribute__((ext_vector_type(4)));
typedef unsigned u32x4 __attribute__((ext_vector_type(4)));
constexpr int BM = 256, BK = 64, HALF = 128, HTB = HALF * BK * 2  , STAGE_BYTES = 8 * HTB, NXCD = 8, WGM = 8;

__host__ __device__ __forceinline__ int lds_byte(int r, int c) { const int st = (r >> 4) * 2 + (c >> 5), rr = r & 15, cc = c & 31, ob = rr * 64 + cc * 2; return st * 1024 + (ob ^ (((ob >> 9) & 1) << 5)); }
__host__ __device__ __forceinline__ void stage_rc(int b, int& R, int& C) { const int st = b / 1024, sb = b % 1024, swz = sb ^ (((sb >> 9) & 1) << 5); R = (st >> 1) * 16 + swz / 64; C = (st & 1) * 32 + (swz % 64) / 2; }
__host__ __device__ __forceinline__ int perm32(int rho) { const int n = rho >> 4, i = rho & 15; return 8 * (i >> 2) + 4 * n + (i & 3); }

struct Unit { int pm, pn, idx; };
struct Gemm { const bf16_t* A; const bf16_t* Bt; int M, N, K, Kloop; };

struct StaticOrder {
    int nM, nN, nwg, G, c;
    __host__ __device__ __forceinline__ void init(int M, int N, int G_, int c_) { nM = M / BM; nN = N / BM; nwg = nM * nN; G = G_; c = c_; }
    __host__ __device__ __forceinline__ void map(int L, int& pm, int& pn) const {
        int wgid = L; { const int q = nwg / NXCD, r = nwg % NXCD, xcd = wgid % NXCD, off = wgid / NXCD; wgid = (xcd < r ? xcd * (q + 1) : r * (q + 1) + (xcd - r) * q) + off; }
        const int nig = WGM * nN, gid = wgid / nig, fm = gid * WGM, gsz = (nM - fm) < WGM ? (nM - fm) : WGM;
        pm = fm + ((wgid % nig) % gsz); pn = (wgid % nig) / gsz;
    }
    __host__ __device__ __forceinline__ bool next(int i, Unit& u) const {
        const long L = (long)i * G + c; if (L >= nwg) return false;
        int wgid = (int)L; { const int q = nwg / NXCD, r = nwg % NXCD, xcd = wgid % NXCD, off = wgid / NXCD; wgid = (xcd < r ? xcd * (q + 1) : r * (q + 1) + (xcd - r) * q) + off; }
        const int nig = WGM * nN, gid = wgid / nig, fm = gid * WGM, gsz = (nM - fm) < WGM ? (nM - fm) : WGM;
        u.pm = fm + ((wgid % nig) % gsz); u.pn = (wgid % nig) / gsz; u.idx = i; return true;
    }
    __device__ __forceinline__ void a_ready(const Unit&) const {}
    __device__ __forceinline__ void done(const Unit&) const {}
};

__device__ __forceinline__ unsigned cvt_pk_bf16(float lo, float hi) { unsigned r; asm volatile("v_cvt_pk_bf16_f32 %0, %1, %2" : "=v"(r) : "v"(lo), "v"(hi)); return r; }
typedef float f32x2 __attribute__((ext_vector_type(2)));

constexpr int DM = 1024, NBATCH = 8, SEQ = 4096, DEPTH = 2, DBATCH = 16, DSEQ = 16, PAST = 2048;
constexpr int MP = NBATCH * SEQ, MS = DBATCH * DSEQ, MT = MP + MS;
constexpr int NIN = 3584, DFF = 4096, LDP = 3072;
constexpr float RMS_EPS = 1e-6f, GN_EPS = 1e-5f;

__device__ __forceinline__ void store8bf(bf16_t* p, const f32x4 a, const f32x4 b) {
    u32x4 w; w.x = cvt_pk_bf16(a[0], a[1]); w.y = cvt_pk_bf16(a[2], a[3]); w.z = cvt_pk_bf16(b[0], b[1]); w.w = cvt_pk_bf16(b[2], b[3]);
    *(u32x4*)p = w;
}
__device__ __forceinline__ float row_rstd(const float* ssp, int r) {
    const f32x4* sp = (const f32x4*)(ssp + (size_t)r * 16);
    const f32x4 s0 = sp[0], s1 = sp[1], s2 = sp[2], s3 = sp[3];
    const f32x4 s = (s0 + s1) + (s2 + s3);
    const float tot = (s[0] + s[1]) + (s[2] + s[3]);
    return __builtin_amdgcn_rsqf(tot * (1.0f / DM) + RMS_EPS);
}
__device__ __forceinline__ float silu_f(float x) { return x * __builtin_amdgcn_rcpf(1.0f + __builtin_amdgcn_exp2f(-1.4426950408889634f * x)); }

struct EpiIn {
    static constexpr bool PERM = true, AFTER_DRAIN = false;
    bf16_t* proj; const PG8_LAS float* rbuf; float* nconv_p; float* nconv_s;
    __device__ __forceinline__ void operator()(f32x4 (&acc)[2][2][4][2], const Unit& u, int wr, int wc, int fr, int fq, unsigned gmask = 0xffu) const {
        const int pn = u.pn, tcol = wc * 32 + 8 * fq;
        const PG8_LAS float* rb = rbuf + u.idx * BM + wr * 64 + fr;
        if (pn < 4) {
            const int i0 = 32 * (wc & 1) + 8 * fq;
            float ir[8];
#pragma unroll
            for (int e = 0; e < 8; ++e) ir[e] = __builtin_amdgcn_exp2f(-(float)(i0 + e) * (13.287712379549449f / 64.0f)) * 0.15915494309189535f;
            const int dcol = (pn < 2 ? 0 : 512) + 128 * (2 * (pn & 1) + (wc >> 1)) + i0;
#pragma unroll
            for (int ai = 0; ai < 2; ++ai)
#pragma unroll
                for (int m = 0; m < 4; ++m) {
                    if (!((gmask >> (ai * 4 + m)) & 1u)) continue;
                    const int r = u.pm * BM + ai * HALF + wr * 64 + m * 16 + fr;
                    const float rs = rb[ai * HALF + m * 16];
                    float fp = (float)(r < MP ? (r & (SEQ - 1)) : PAST + (r & (DSEQ - 1)));
                    asm volatile("" : "+v"(fp) :: "memory");
                    f32x4 o1[2], o2[2];
#pragma unroll
                    for (int n = 0; n < 2; ++n)
#pragma unroll
                        for (int e = 0; e < 4; ++e) {
                            const float rev = fp * ir[4 * n + e], f = __builtin_amdgcn_fractf(rev);
                            const float c = __builtin_amdgcn_cosf(f), s = __builtin_amdgcn_sinf(f);
                            const float x1 = acc[ai][0][m][n][e] * rs, x2 = acc[ai][1][m][n][e] * rs;
                            o1[n][e] = x1 * c - x2 * s; o2[n][e] = x1 * s + x2 * c;
                        }
                    bf16_t* prow = proj + (size_t)r * LDP + dcol;
                    store8bf(prow, o1[0], o1[1]); store8bf(prow + 64, o2[0], o2[1]);
                }
        } else {
#pragma unroll
            for (int ai = 0; ai < 2; ++ai)
#pragma unroll
                for (int m = 0; m < 4; ++m) {
                    if (!((gmask >> (ai * 4 + m)) & 1u)) continue;
                    const int r = u.pm * BM + ai * HALF + wr * 64 + m * 16 + fr;
                    const float rs = rb[ai * HALF + m * 16];
                    const f32x4 a0 = acc[ai][0][m][0] * rs, a1 = acc[ai][0][m][1] * rs, b0 = acc[ai][1][m][0] * rs, b1 = acc[ai][1][m][1] * rs;
                    bf16_t* prow = proj + (size_t)r * LDP;
                    if (pn < 10) {
                        f32x4 x0 = a0, x1 = a1, y0 = b0, y1 = b1;
                        if (pn == 6 || pn == 7) {
#pragma unroll
                            for (int e = 0; e < 4; ++e) { x0[e] = silu_f(x0[e]); x1[e] = silu_f(x1[e]); y0[e] = silu_f(y0[e]); y1[e] = silu_f(y1[e]); }
                        }
                        const int dcol = 256 * pn + tcol;
                        store8bf(prow + dcol, x0, x1); store8bf(prow + dcol + 128, y0, y1);
                    } else {
                        const f32x4 u0 = a0 * b0, u1 = a1 * b1;
                        const int cc = 128 * (pn - 10) + tcol;
                        store8bf(prow + 2560 + cc, u0, u1);
                        if (r < MP) { const int t = r & (SEQ - 1); if (t >= SEQ - 2) { float* d = nconv_p + (size_t)((r >> 12) * 2 + (t - (SEQ - 2))) * 512 + cc; *(f32x4*)d = u0; *(f32x4*)(d + 4) = u1; } }
                        else { const int t = r & (DSEQ - 1); if (t >= DSEQ - 2) { float* d = nconv_s + (size_t)(((r - MP) >> 4) * 2 + (t - (DSEQ - 2))) * 512 + cc; *(f32x4*)d = u0; *(f32x4*)(d + 4) = u1; } }
                    }
                }
        }
    }
};
struct EpiRes {
    static constexpr bool PERM = false, AFTER_DRAIN = false;
    const float* xs_main; const float* xs_tail; float* X; bf16_t* xb; float* ssp;
    __device__ __forceinline__ void operator()(f32x4 (&acc)[2][2][4][2], const Unit& u, int wr, int wc, int fr, int fq, unsigned gmask = 0xffu) const {
        typedef unsigned u32x2v __attribute__((ext_vector_type(2)));
        const int cb = u.pn * BM + wc * 32 + 4 * fq;
#pragma unroll
        for (int g = 0; g < 4; ++g) {
            if (!((gmask >> (2 * g)) & 3u)) continue;
            const int ai = g >> 1, mb = (g & 1) * 2;
            const int r0 = u.pm * BM + ai * HALF + wr * 64 + mb * 16 + fr;
            const float* xs = (r0 < MP ? xs_main + (size_t)r0 * DM : xs_tail + (size_t)(r0 - MP) * DM) + cb;
            f32x4 xv[2][2][2];
#pragma unroll
            for (int m = 0; m < 2; ++m)
#pragma unroll
                for (int bj = 0; bj < 2; ++bj)
#pragma unroll
                    for (int n = 0; n < 2; ++n) xv[m][bj][n] = *(const f32x4*)(xs + (size_t)m * 16 * DM + bj * HALF + n * 16);
#pragma unroll
            for (int m = 0; m < 2; ++m) {
                if (!((gmask >> (2 * g + m)) & 1u)) continue;
                const int r = r0 + m * 16;
                float ss = 0.f;
#pragma unroll
                for (int bj = 0; bj < 2; ++bj)
#pragma unroll
                    for (int n = 0; n < 2; ++n) {
                        const int c = cb + bj * HALF + n * 16;
                        const f32x4 v = xv[m][bj][n] + acc[ai][bj][mb + m][n];
                        *(f32x4*)(X + (size_t)r * DM + c) = v;
                        u32x2v w; w.x = cvt_pk_bf16(v[0], v[1]); w.y = cvt_pk_bf16(v[2], v[3]);
                        *(u32x2v*)(xb + (size_t)r * DM + c) = w;
                        ss += (v[0] * v[0] + v[1] * v[1]) + (v[2] * v[2] + v[3] * v[3]);
                    }
                ss += __shfl_xor(ss, 16); ss += __shfl_xor(ss, 32);
                if (fq == 0) ssp[(size_t)r * 16 + 4 * u.pn + wc] = ss;
            }
            asm volatile("" ::: "memory");
        }
    }
};
struct EpiUp {
    static constexpr bool PERM = true, AFTER_DRAIN = false;
    bf16_t* H; const PG8_LAS float* rbuf;
    __device__ __forceinline__ void operator()(f32x4 (&acc)[2][2][4][2], const Unit& u, int wr, int wc, int fr, int fq, unsigned gmask = 0xffu) const {
        const PG8_LAS float* rb = rbuf + u.idx * BM + wr * 64 + fr;
#pragma unroll
        for (int ai = 0; ai < 2; ++ai)
#pragma unroll
            for (int m = 0; m < 4; ++m) {
                if (!((gmask >> (ai * 4 + m)) & 1u)) continue;
                const int r = u.pm * BM + ai * HALF + wr * 64 + m * 16 + fr;
                const float rs = rb[ai * HALF + m * 16];
                bf16_t* hrow = H + (size_t)r * DFF + u.pn * BM + wc * 32 + 8 * fq;
#pragma unroll
                for (int bj = 0; bj < 2; ++bj) {
                    f32x4 v0 = acc[ai][bj][m][0] * rs, v1 = acc[ai][bj][m][1] * rs;
#pragma unroll
                    for (int e = 0; e < 4; ++e) { const float p = fmaxf(v0[e], 0.f), q = fmaxf(v1[e], 0.f); v0[e] = p * p; v1[e] = q * q; }
                    store8bf(hrow + bj * HALF, v0, v1);
                }
            }
    }
};
template <class Sched> __device__ __forceinline__ void rstd_prepass(PG8_LAS float* rbuf, const float* ssp, const Sched& S) {
    int tid = threadIdx.x; asm volatile("" : "+v"(tid));
    const int row = tid >> 1, half = tid & 1;
    Unit u;
    for (int i = 0; S.next(i, u); ++i) {
        const f32x4* sp = (const f32x4*)(ssp + (size_t)(u.pm * BM + row) * 16 + half * 8);
        const f32x4 a = sp[0], b = sp[1];
        float t = ((a[0] + a[1]) + (a[2] + a[3])) + ((b[0] + b[1]) + (b[2] + b[3]));
        t += __shfl_xor(t, 1);
        if (half == 0) rbuf[i * BM + row] = __builtin_amdgcn_rsqf(t * (1.0f / DM) + RMS_EPS);
    }
    __syncthreads();
}
struct SliceOrder {
    int first, nN, c;
    __device__ __forceinline__ bool next(int i, Unit& u) const { const int idx = c - first; u.pm = MP / BM; u.pn = idx; u.idx = 0; return i == 0 && idx >= 0 && idx < nN; }
    __device__ __forceinline__ void a_ready(const Unit&) const {}
    __device__ __forceinline__ void done(const Unit&) const {}
};
template <class E, int NSL> struct SplitEpi {
    static constexpr bool PERM = E::PERM, AFTER_DRAIN = false;
    E e; float* part; unsigned* cnt; unsigned* tmo; int slice;
    __device__ __forceinline__ void operator()(f32x4 (&acc)[2][2][4][2], const Unit& u, int wr, int wc, int fr, int fq) const {
        constexpr int NG = 8 / NSL;
        const int wid = wr * 4 + wc, lane = fq * 16 + fr;
        f32x4* base = (f32x4*)part + (size_t)(u.pn * 8 + wid) * 32 * 64 + lane;
        const size_t sstride = (size_t)16 * 8 * 32 * 64;
        f32x4* dst = base + (size_t)slice * sstride;
#pragma unroll
        for (int q = 0; q < 32; ++q) asm volatile("global_store_dwordx4 %0, %1, off sc1\n\ts_nop 2" :: "v"(dst + q * 64), "v"(acc[q >> 4][(q >> 3) & 1][(q >> 1) & 3][q & 1]) : "memory");
        asm volatile("s_waitcnt vmcnt(0)" ::: "memory");
        unsigned* cw = cnt + u.pn * 8 + wid;
        if (lane == 0) __hip_atomic_fetch_add(cw, 1u, __ATOMIC_RELAXED, __HIP_MEMORY_SCOPE_AGENT);
        { unsigned sp = 0u;
          while ((unsigned)__builtin_amdgcn_readfirstlane((int)__hip_atomic_load(cw, __ATOMIC_RELAXED, __HIP_MEMORY_SCOPE_AGENT)) < (unsigned)NSL) {
              __builtin_amdgcn_s_sleep(1);
              if (++sp > (1u << 20)) { if (lane == 0) __hip_atomic_store(tmo, 1u, __ATOMIC_RELAXED, __HIP_MEMORY_SCOPE_AGENT); break; }
          } }
        __builtin_amdgcn_fence(__ATOMIC_ACQUIRE, "agent");
#pragma unroll
        for (int s = 0; s < NSL; ++s) {
            if (slice != s) continue;
            f32x4 sum[NG][4];
#pragma unroll
            for (int gi = 0; gi < NG; ++gi)
#pragma unroll
                for (int p = 0; p < 4; ++p) sum[gi][p] = (f32x4){0.f, 0.f, 0.f, 0.f};
#pragma unroll
            for (int sb = 0; sb < NSL; sb += 4) {
                f32x4 t[4][NG][4];
#pragma unroll
                for (int sl = sb; sl < sb + 4; ++sl)
#pragma unroll
                    for (int gi = 0; gi < NG; ++gi)
#pragma unroll
                        for (int p = 0; p < 4; ++p) {
                            const int g = s * NG + gi, ai = g >> 2, m = g & 3, bj = p >> 1, n = p & 1, q = ((ai * 2 + bj) * 4 + m) * 2 + n;
                            if (sl != s) t[sl - sb][gi][p] = base[(size_t)sl * sstride + q * 64];
                        }
#pragma unroll
                for (int sl = sb; sl < sb + 4; ++sl)
#pragma unroll
                    for (int gi = 0; gi < NG; ++gi)
#pragma unroll
                        for (int p = 0; p < 4; ++p) {
                            const int g = s * NG + gi, ai = g >> 2, m = g & 3, bj = p >> 1, n = p & 1;
                            sum[gi][p] += (sl == s) ? acc[ai][bj][m][n] : t[sl - sb][gi][p];
                        }
                asm volatile("" ::: "memory");
            }
#pragma unroll
            for (int gi = 0; gi < NG; ++gi)
#pragma unroll
                for (int p = 0; p < 4; ++p) { const int g = s * NG + gi; acc[g >> 2][p >> 1][g & 3][p & 1] = sum[gi][p]; }
            e(acc, u, wr, wc, fr, fq, ((1u << NG) - 1u) << (s * NG));
        }
    }
};
template <class Epi, class Sched, bool ALIGN_EPI = false, bool SP2 = false>
__device__ __forceinline__ void gemm_phase(PG8_LAS unsigned char* lds, const Gemm g, const Sched& S, const Epi& E) {
    int tid_o = threadIdx.x; asm volatile("" : "+v"(tid_o));
    const int tid = tid_o, wid = __builtin_amdgcn_readfirstlane(tid >> 6), lane = tid & 63, wr = wid >> 2, wc = wid & 3, fr = lane & 15, fq = lane >> 4;
    const int K = g.K, nt = g.Kloop / BK;
    unsigned voffA[2], voffB[2];
#pragma unroll
    for (int i = 0; i < 2; ++i) { int R, C; stage_rc(tid * 16 + i * 8192, R, C); const int Rb = Epi::PERM ? ((R & ~31) + perm32(R & 31)) : R;
        voffA[i] = (unsigned)(R * K + C) * 2u; voffB[i] = (unsigned)(Rb * K + C) * 2u; }
    const size_t kstep = (size_t)(BK * 2);
    const size_t hstep = (size_t)HALF * K * 2;
    const size_t tstep = 2 * hstep;
    const unsigned ldsw = (unsigned)wid * 1024u;
    const int aoff = lds_byte(wr * 64 + fr, fq * 8), boff = lds_byte(wc * 32 + fr, fq * 8);
#define PG8_SA(b, h) (((b) * 2 + (h)) * HTB)
#define PG8_SB(b, h) ((4 + (b) * 2 + (h)) * HTB)
#define PG8_STAGE(bufoff, gbase, voff) do { _Pragma("unroll") for (int _i = 0; _i < 2; ++_i) \
        __builtin_amdgcn_global_load_lds((const unsigned*)((const char*)(gbase) + (voff)[_i]), (PG8_LAS unsigned*)(lds + (bufoff) + ldsw + _i * 8192), 16, 0, 0); } while (0)
#define PG8_LDA(dst, b, h) do { _Pragma("unroll") for (int m = 0; m < 4; ++m) _Pragma("unroll") for (int k = 0; k < 2; ++k) dst[m][k] = *(const PG8_LAS bf16x8*)(lds + PG8_SA(b, h) + aoff + m * 2048 + k * 1024); } while (0)
#define PG8_LDB(dst, b, h) do { _Pragma("unroll") for (int n = 0; n < 2; ++n) _Pragma("unroll") for (int k = 0; k < 2; ++k) dst[n][k] = *(const PG8_LAS bf16x8*)(lds + PG8_SB(b, h) + boff + n * 2048 + k * 1024); } while (0)
#define PG8_MMA(ai, bj, At, Bt) do { __builtin_amdgcn_s_setprio(1); _Pragma("unroll") for (int m = 0; m < 4; ++m) _Pragma("unroll") for (int n = 0; n < 2; ++n) _Pragma("unroll") for (int k = 0; k < 2; ++k) \
        acc[ai][bj][m][n] = __builtin_amdgcn_mfma_f32_16x16x32_bf16(Bt[n][k], At[m][k], acc[ai][bj][m][n], 0, 0, 0); __builtin_amdgcn_s_setprio(0); } while (0)
#define PG8_WAIT_V(n) asm volatile("s_waitcnt vmcnt(" #n ")" ::: "memory")
#define PG8_WAIT_L(n) asm volatile("s_waitcnt lgkmcnt(" #n ")" ::: "memory")
#define PG8_BAR __builtin_amdgcn_s_barrier()
#define PG8_SCHED __builtin_amdgcn_sched_barrier(0)
    Unit cur, nxt; int ui = 0;
    if (!S.next(0, cur)) return;
    f32x4 acc[2][2][4][2];
#pragma unroll
    for (int a = 0; a < 2; ++a)
#pragma unroll
        for (int b = 0; b < 2; ++b)
#pragma unroll
            for (int m = 0; m < 4; ++m)
#pragma unroll
                for (int n = 0; n < 2; ++n) acc[a][b][m][n] = (f32x4){0.f, 0.f, 0.f, 0.f};
    bf16x8 At[4][2], B0[2][2], B1[2][2];
    const char* cA = (const char*)g.A + (size_t)cur.pm * tstep; const char* cB = (const char*)g.Bt + (size_t)cur.pn * tstep;
    S.a_ready(cur);
    if constexpr (SP2) {
        PG8_STAGE(PG8_SB(0, 0), cB, voffB); PG8_STAGE(PG8_SB(0, 1), cB + hstep, voffB); PG8_STAGE(PG8_SA(0, 0), cA, voffA); PG8_STAGE(PG8_SA(0, 1), cA + hstep, voffA);
        if (wr == 1) PG8_BAR;
        PG8_WAIT_V(2); PG8_BAR;
        PG8_STAGE(PG8_SB(1, 0), cB + kstep, voffB); PG8_STAGE(PG8_SA(1, 0), cA + kstep, voffA); PG8_STAGE(PG8_SB(1, 1), cB + hstep + kstep, voffB);
        PG8_WAIT_V(6); PG8_BAR;
    } else {
        PG8_STAGE(PG8_SB(0, 0), cB, voffB); PG8_STAGE(PG8_SA(0, 0), cA, voffA); PG8_STAGE(PG8_SB(0, 1), cB + hstep, voffB); PG8_STAGE(PG8_SA(0, 1), cA + hstep, voffA);
        if (wr == 1) PG8_BAR;
        PG8_WAIT_V(4); PG8_BAR;
        PG8_STAGE(PG8_SB(1, 0), cB + kstep, voffB); PG8_STAGE(PG8_SA(1, 0), cA + kstep, voffA); PG8_STAGE(PG8_SB(1, 1), cB + hstep + kstep, voffB);
        PG8_WAIT_V(6); PG8_BAR;
    }
    for (;;) {
        const bool has_next = S.next(ui + 1, nxt);
        const char* nA = has_next ? (const char*)g.A + (size_t)nxt.pm * tstep : cA; const char* nB = has_next ? (const char*)g.Bt + (size_t)nxt.pn * tstep : cB;
        for (int t = 0; t < nt; t += 2) {
            const bool last = (t == nt - 2);
            const char* a1 = cA + (size_t)(t + 1) * kstep;
            const char* a2 = last ? nA : cA + (size_t)(t + 2) * kstep; const char* b2 = last ? nB : cB + (size_t)(t + 2) * kstep;
            const char* a3 = a2 + kstep; const char* b3 = b2 + kstep;
            if (last && has_next) S.a_ready(nxt);
            if constexpr (SP2) {
            PG8_LDB(B0, 0, 0); PG8_LDB(B1, 0, 1); PG8_SCHED; PG8_LDA(At, 0, 0); PG8_STAGE(PG8_SA(1, 1), a1 + hstep, voffA);
            PG8_WAIT_V(8); PG8_WAIT_L(0); PG8_BAR; PG8_MMA(0, 0, At, B0); PG8_MMA(0, 1, At, B1); PG8_BAR; PG8_SCHED;
            PG8_LDA(At, 0, 1); PG8_STAGE(PG8_SB(0, 0), b2, voffB); PG8_STAGE(PG8_SB(0, 1), b2 + hstep, voffB); PG8_STAGE(PG8_SA(0, 0), a2, voffA);
            PG8_WAIT_V(8); PG8_WAIT_L(0); PG8_BAR; PG8_MMA(1, 0, At, B0); PG8_MMA(1, 1, At, B1); PG8_BAR; PG8_SCHED;
            PG8_LDB(B0, 1, 0); PG8_LDB(B1, 1, 1); PG8_SCHED; PG8_LDA(At, 1, 0); PG8_STAGE(PG8_SA(0, 1), a2 + hstep, voffA);
            PG8_WAIT_V(8); PG8_WAIT_L(0); PG8_BAR; PG8_MMA(0, 0, At, B0); PG8_MMA(0, 1, At, B1); PG8_BAR; PG8_SCHED;
            PG8_LDA(At, 1, 1); PG8_STAGE(PG8_SB(1, 0), b3, voffB); PG8_STAGE(PG8_SB(1, 1), b3 + hstep, voffB); PG8_STAGE(PG8_SA(1, 0), a3, voffA);
            PG8_WAIT_V(8); PG8_WAIT_L(0); PG8_BAR; PG8_MMA(1, 0, At, B0); PG8_MMA(1, 1, At, B1); PG8_BAR; PG8_SCHED;
            } else {
            PG8_LDB(B0, 0, 0); PG8_SCHED; PG8_LDA(At, 0, 0); PG8_STAGE(PG8_SA(1, 1), a1 + hstep, voffA);
            PG8_WAIT_L(8); PG8_BAR; PG8_WAIT_L(0); PG8_MMA(0, 0, At, B0); PG8_BAR; PG8_SCHED;
            PG8_LDB(B1, 0, 1); PG8_STAGE(PG8_SB(0, 0), b2, voffB);
            PG8_BAR; PG8_WAIT_L(0); PG8_MMA(0, 1, At, B1); PG8_BAR;
            PG8_LDA(At, 0, 1); PG8_STAGE(PG8_SA(0, 0), a2, voffA);
            PG8_BAR; PG8_WAIT_L(0); PG8_MMA(1, 0, At, B0); PG8_BAR; PG8_SCHED;
            PG8_STAGE(PG8_SB(0, 1), b2 + hstep, voffB);
            PG8_WAIT_V(6); PG8_BAR; PG8_MMA(1, 1, At, B1); PG8_BAR;
            PG8_LDB(B0, 1, 0); PG8_SCHED; PG8_LDA(At, 1, 0); PG8_STAGE(PG8_SA(0, 1), a2 + hstep, voffA);
            PG8_WAIT_L(8); PG8_BAR; PG8_WAIT_L(0); PG8_MMA(0, 0, At, B0); PG8_BAR; PG8_SCHED;
            PG8_LDB(B1, 1, 1); PG8_STAGE(PG8_SB(1, 0), b3, voffB);
            PG8_BAR; PG8_WAIT_L(0); PG8_MMA(0, 1, At, B1); PG8_BAR;
            PG8_LDA(At, 1, 1); PG8_STAGE(PG8_SA(1, 0), a3, voffA);
            PG8_BAR; PG8_WAIT_L(0); PG8_MMA(1, 0, At, B0); PG8_BAR; PG8_SCHED;
            PG8_STAGE(PG8_SB(1, 1), b3 + hstep, voffB);
            PG8_WAIT_V(6); PG8_BAR; PG8_MMA(1, 1, At, B1); PG8_BAR;
            }
        }
        if constexpr (ALIGN_EPI) { if (wr == 0) PG8_BAR; }
        if constexpr (!Epi::AFTER_DRAIN) { E(acc, cur, wr, wc, fr, fq); S.done(cur); }
        if (!has_next) break;
#pragma unroll
        for (int a = 0; a < 2; ++a)
#pragma unroll
            for (int b = 0; b < 2; ++b)
#pragma unroll
                for (int m = 0; m < 4; ++m)
#pragma unroll
                    for (int n = 0; n < 2; ++n) acc[a][b][m][n] = (f32x4){0.f, 0.f, 0.f, 0.f};
        cur = nxt; cA = nA; cB = nB; ++ui;
        if constexpr (ALIGN_EPI) { if (wr == 1) PG8_BAR; }
    }
    PG8_WAIT_V(0);
    if constexpr (!ALIGN_EPI) { if (wr == 0) PG8_BAR; }
    PG8_BAR;
    if constexpr (Epi::AFTER_DRAIN) { E.fused(acc, cur, wr, wc, fr, fq, lds, wid, lane); S.done(cur); }
#undef PG8_SA
#undef PG8_SB
#undef PG8_STAGE
#undef PG8_LDA
#undef PG8_LDB
#undef PG8_MMA
#undef PG8_WAIT_V
#undef PG8_WAIT_L
#undef PG8_BAR
#undef PG8_SCHED
}
}
#define LAS __attribute__((address_space(3)))
#define XB_TMO      128
#define XB_XCNT(j)  (256  + 64 * (j))
#define XB_XSUB(j)  (1280 + 64 * (j))
#define XB_XGEN(j)  (2304 + 64 * (j))
#define XB_TOP      3328
#define XB_TOPGEN   3392
#define XCD_BAR_WORDS 3456
#define XB_SPIN_CAP (1u << 18)

__device__ __forceinline__ unsigned xb_ld(unsigned* p)              { return __hip_atomic_load(p, __ATOMIC_RELAXED, __HIP_MEMORY_SCOPE_AGENT); }
__device__ __forceinline__ unsigned xb_add(unsigned* p, unsigned v) { return __hip_atomic_fetch_add(p, v, __ATOMIC_RELAXED, __HIP_MEMORY_SCOPE_AGENT); }
__device__ __forceinline__ unsigned xb_xcc_id() { return (unsigned)__builtin_amdgcn_s_getreg((3 << 11) | 20) & 0xFu; }
#define XB_SPIN(cond, bar) do { unsigned _sp = 0; while (cond) { __builtin_amdgcn_s_sleep(1); \
    if ((++_sp & 255u) == 0u) { if (xb_ld(&(bar)[XB_TMO])) break; if (_sp > XB_SPIN_CAP) { atomicAdd(&(bar)[XB_TMO], 1u); break; } } } } while (0)

struct XcdBarrier {
    unsigned* bar; unsigned x;
    volatile LAS unsigned* st;
};

__device__ __forceinline__ XcdBarrier xcd_barrier_post(unsigned* bar, volatile LAS unsigned* st) {
    XcdBarrier b; b.bar = bar; b.x = xb_xcc_id(); b.st = st;
    if (threadIdx.x == 0) (void)xb_add(&bar[XB_XCNT(b.x)], 1u);
    return b;
}
__device__ __forceinline__ void xcd_barrier_complete(unsigned* bar, unsigned x, unsigned& nloc, unsigned& nx) {
    const unsigned G = gridDim.x * gridDim.y * gridDim.z;
    unsigned sum, cnt, mine, sp = 0u;
    for (;;) {
        sum = 0u; cnt = 0u; mine = 0u;
#pragma unroll
        for (unsigned j = 0; j < 16; ++j) { const unsigned c = xb_ld(&bar[XB_XCNT(j)]); sum += c; cnt += (c > 0u) ? 1u : 0u; mine = (j == x) ? c : mine; }
        if (sum == G) break;
        __builtin_amdgcn_s_sleep(1);
        if ((++sp & 255u) == 0u) { if (xb_ld(&bar[XB_TMO])) break; if (sp > XB_SPIN_CAP) { atomicAdd(&bar[XB_TMO], 1u); break; } }
    }
    nloc = mine > 0u ? mine : 1u; nx = cnt > 0u ? cnt : 1u;
}

__device__ __forceinline__ void xcd_barrier(const XcdBarrier& b) {
    asm volatile("s_waitcnt vmcnt(0)" ::: "memory");
    __syncthreads();
    if (threadIdx.x == 0) {
        unsigned* bar = b.bar;
        __builtin_amdgcn_s_waitcnt(0);
        unsigned nloc = b.st[0], nx = b.st[1];
        if (nloc == 0u) { xcd_barrier_complete(bar, b.x, nloc, nx); b.st[0] = nloc; b.st[1] = nx; }
        const unsigned old = xb_add(&bar[XB_XSUB(b.x)], 1u);
        const unsigned gen = old / nloc;
        if (old + 1u == (gen + 1u) * nloc) {
            __builtin_amdgcn_fence(__ATOMIC_RELEASE, "agent");
            asm volatile("s_waitcnt vmcnt(0)" ::: "memory");
            const unsigned og = xb_add(&bar[XB_TOP], 1u);
            const unsigned tg = og / nx;
            if (og + 1u == (tg + 1u) * nx) xb_add(&bar[XB_TOPGEN], 1u);
            else XB_SPIN(xb_ld(&bar[XB_TOPGEN]) == tg, bar);
            __builtin_amdgcn_fence(__ATOMIC_ACQUIRE, "agent");
            xb_add(&bar[XB_XGEN(b.x)], 1u);
            asm volatile("s_waitcnt vmcnt(0)" ::: "memory");
        } else {
            XB_SPIN(xb_ld(&bar[XB_XGEN(b.x)]) == gen, bar);
            __builtin_amdgcn_fence(__ATOMIC_ACQUIRE, "agent");
            asm volatile("s_waitcnt vmcnt(0)" ::: "memory");
        }
    }
    __syncthreads();
}

using pg8::bf16_t; using pg8::bf16x8; using pg8::f32x4; using pg8::u32x4;
using pg8::DM; using pg8::MP; using pg8::MS; using pg8::MT; using pg8::NIN; using pg8::DFF; using pg8::LDP; using pg8::SEQ; using pg8::DSEQ;
using pg8::NBATCH; using pg8::DBATCH; using pg8::DEPTH;
#define LAS __attribute__((address_space(3)))
typedef unsigned u32x2 __attribute__((ext_vector_type(2)));
typedef float f32x2 __attribute__((ext_vector_type(2)));

constexpr int NTHR = 512;
constexpr int LDS_BYTES = 147456;
constexpr size_t O_YP = 0, O_YS = (size_t)MP * DM, O_RETP = O_YS + (size_t)MS * DM, O_CONVP = O_RETP + (size_t)DEPTH * NBATCH * 4 * 16384,
                 O_RETS = O_CONVP + (size_t)DEPTH * NBATCH * 2 * 512, O_CONVS = O_RETS + (size_t)DEPTH * DBATCH * 4 * 16384;
constexpr size_t MiB = 1u << 20;
constexpr size_t WS_WIN = 0, WS_WOUT = 14 * MiB, WS_WUP = 18 * MiB, WS_WDN = 34 * MiB;
constexpr size_t WS_COS = 50 * MiB, WS_SIN = 51 * MiB, WS_SSP = 52 * MiB, WS_SSEG = 55 * MiB;
constexpr size_t WS_CTL = 54 * MiB + 512 * 1024;
constexpr int CTL_WORDS = 8192, CW_CNT = 4096;
constexpr size_t WS_PART = 400 * MiB;
constexpr size_t WS_XB = 71 * MiB;
constexpr size_t WS_PROJ = 136 * MiB;
constexpr size_t WS_MIX = WS_PROJ + (size_t)MT * LDP * 2;
constexpr size_t WS_H = WS_PROJ;
constexpr size_t WS_END = WS_MIX + (size_t)MT * DM * 2;
static_assert(WS_END <= WS_PART && WS_PART + 64 * MiB <= 512 * MiB && WS_XB + (size_t)MT * DM * 2 <= WS_PROJ && WS_END <= 512 * MiB && WS_H + (size_t)MT * DFF * 2 <= WS_END, "ws map");

__device__ __forceinline__ float bf2f(unsigned b) { return __uint_as_float(b << 16); }
__device__ __forceinline__ unsigned pk2(float lo, float hi) { return pg8::cvt_pk_bf16(lo, hi); }
__device__ __forceinline__ float ex2(float x) { return __builtin_amdgcn_exp2f(x); }
__device__ __forceinline__ f32x4 mma(const bf16x8 x, const bf16x8 y, const f32x4 c) { return __builtin_amdgcn_mfma_f32_16x16x32_bf16(x, y, c, 0, 0, 0); }
__device__ __forceinline__ bf16x8 frag(LAS unsigned char* base, int row, int stride, int kg, int kb) { return *(const LAS bf16x8*)(base + row * stride + 16 * kg + 64 * kb); }

constexpr int R_Q = 0, R_K = 17408, R_KT = 34816, R_VT = 53248, R_SP = 71680, R_RT = 80896, R_ST = 115712;
constexpr int SQ = 272, ST = 144;
#define LDS_BAR() do { asm volatile("s_waitcnt lgkmcnt(0)" ::: "memory"); __builtin_amdgcn_s_barrier(); asm volatile("" ::: "memory"); } while (0)
__device__ __forceinline__ void ret_item(LAS unsigned char* lds, const bf16_t* proj, bf16_t* mix, int row0, int nchunks, int CL, int h, float lg2, bool full,
                                         int rinit, const float* rsrc, int nprefix, float* rdst, const float* gnw) {
    int tid_o = threadIdx.x; asm volatile("" : "+v"(tid_o));
    const int tid = tid_o, w = __builtin_amdgcn_readfirstlane(tid >> 6), lane = tid & 63, j = lane & 15, ig = lane >> 4;
    f32x4 R[8];
#pragma unroll
    for (int dt = 0; dt < 8; ++dt) R[dt] = (f32x4){0.f, 0.f, 0.f, 0.f};
    if (rinit == 2) {
#pragma unroll
        for (int dt = 0; dt < 8; ++dt)
#pragma unroll
            for (int t = 0; t < 4; ++t) R[dt][t] = rsrc[(16 * dt + 4 * ig + t) * 128 + 16 * w + j];
    } else if (rinit == 1) {
#pragma unroll 1
        for (int s = 0; s < nprefix; ++s) {
            const float sc = ex2(lg2 * 512.f * (float)(nprefix - 1 - s));
            const float* rp = rsrc + (size_t)s * 16384 + 16 * w + j;
#pragma unroll
            for (int dt = 0; dt < 8; ++dt)
#pragma unroll
                for (int t = 0; t < 4; ++t) R[dt][t] += rp[(16 * dt + 4 * ig + t) * 128] * sc;
        }
    }
    if (full) {
#pragma unroll
        for (int dt = 0; dt < 8; ++dt) { u32x2 p; p.x = pk2(R[dt][0], R[dt][1]); p.y = pk2(R[dt][2], R[dt][3]); *(LAS u32x2*)(lds + R_RT + (16 * w + j) * SQ + (16 * dt + 4 * ig) * 2) = p; }
    }
    const float cdec = ex2(lg2 * (float)CL);
    const float kdec = ex2(lg2 * (float)(CL - 1 - lane));
    u32x4 qreg[2], kreg[2], vreg[2];
    const u32x4 zero4 = (u32x4){0u, 0u, 0u, 0u};
#define RET_LOAD(c) do { _Pragma("unroll") for (int it = 0; it < 2; ++it) { \
        const int qm = (tid + NTHR * it) >> 4, qd = (tid + NTHR * it) & 15, kd = w + 8 * it; \
        const bf16_t* rb = proj + (size_t)(row0 + (c) * 64) * LDP + h * 128; \
        qreg[it] = (full && qm < CL) ? *(const u32x4*)(rb + (size_t)qm * LDP + 8 * qd) : zero4; \
        kreg[it] = (lane < CL) ? *(const u32x4*)(rb + (size_t)lane * LDP + 512 + 8 * kd) : zero4; \
        vreg[it] = (lane < CL) ? *(const u32x4*)(rb + (size_t)lane * LDP + 1024 + 8 * kd) : zero4; } } while (0)
    RET_LOAD(0);
    for (int c = 0; c < nchunks; ++c) {
#pragma unroll
        for (int it = 0; it < 2; ++it) {
            const int qm = (tid + NTHR * it) >> 4, qd = (tid + NTHR * it) & 15, kd = w + 8 * it;
            if (full) { *(LAS u32x4*)(lds + R_Q + qm * SQ + 16 * qd) = qreg[it]; *(LAS u32x4*)(lds + R_K + lane * SQ + 16 * kd) = kreg[it]; }
#pragma unroll
            for (int e = 0; e < 4; ++e) {
                const unsigned kw = kreg[it][e], vw = vreg[it][e];
                const unsigned kp = pk2(bf2f(kw & 0xffffu) * kdec, bf2f(kw >> 16) * kdec);
                *(LAS unsigned short*)(lds + R_KT + (8 * kd + 2 * e) * ST + 2 * lane) = (unsigned short)(kp & 0xffffu);
                *(LAS unsigned short*)(lds + R_KT + (8 * kd + 2 * e + 1) * ST + 2 * lane) = (unsigned short)(kp >> 16);
                *(LAS unsigned short*)(lds + R_VT + (8 * kd + 2 * e) * ST + 2 * lane) = (unsigned short)(vw & 0xffffu);
                *(LAS unsigned short*)(lds + R_VT + (8 * kd + 2 * e + 1) * ST + 2 * lane) = (unsigned short)(vw >> 16);
            }
        }
        if (c + 1 < nchunks) RET_LOAD(c + 1);
        u32x2 sgr[4];
        if (full) {
#pragma unroll
            for (int nt = 0; nt < 4; ++nt) {
                const int n = 16 * nt + j;
                sgr[nt] = n < CL ? *(const u32x2*)(proj + (size_t)(row0 + c * 64 + n) * LDP + 1536 + h * 128 + 16 * w + 4 * ig) : (u32x2){0u, 0u};
            }
        }
        LDS_BAR();
        f32x4 o[4];
        if (full) {
            const int mt = w & 3;
#pragma unroll
            for (int q2 = 0; q2 < 2; ++q2) {
                const int nt = 2 * (w >> 2) + q2;
                f32x4 s = (f32x4){0.f, 0.f, 0.f, 0.f};
#pragma unroll
                for (int kb = 0; kb < 4; ++kb) s = mma(frag(lds + R_K, 16 * mt + j, SQ, ig, kb), frag(lds + R_Q, 16 * nt + j, SQ, ig, kb), s);
                const int n = 16 * nt + j, m0 = 16 * mt + 4 * ig;
#pragma unroll
                for (int t = 0; t < 4; ++t) { const int df = n - (m0 + t); s[t] = df >= 0 ? s[t] * ex2(lg2 * (float)df) : 0.f; }
                u32x2 p; p.x = pk2(s[0], s[1]); p.y = pk2(s[2], s[3]);
                *(LAS u32x2*)(lds + R_SP + n * ST + m0 * 2) = p;
            }
            LDS_BAR();
            bf16x8 rt[4], vt[2], qf[4][4], sf[4][2];
#pragma unroll
            for (int kb = 0; kb < 4; ++kb) rt[kb] = frag(lds + R_RT, 16 * w + j, SQ, ig, kb);
#pragma unroll
            for (int kb = 0; kb < 2; ++kb) vt[kb] = frag(lds + R_VT, 16 * w + j, ST, ig, kb);
#pragma unroll
            for (int nt = 0; nt < 4; ++nt) {
#pragma unroll
                for (int kb = 0; kb < 4; ++kb) qf[nt][kb] = frag(lds + R_Q, 16 * nt + j, SQ, ig, kb);
#pragma unroll
                for (int kb = 0; kb < 2; ++kb) sf[nt][kb] = frag(lds + R_SP, 16 * nt + j, ST, ig, kb);
            }
            f32x4 a[4], b[4];
#pragma unroll
            for (int nt = 0; nt < 4; ++nt) { a[nt] = (f32x4){0.f, 0.f, 0.f, 0.f}; b[nt] = (f32x4){0.f, 0.f, 0.f, 0.f}; }
#pragma unroll
            for (int kb = 0; kb < 4; ++kb)
#pragma unroll
                for (int nt = 0; nt < 4; ++nt) a[nt] = mma(rt[kb], qf[nt][kb], a[nt]);
#pragma unroll
            for (int kb = 0; kb < 2; ++kb)
#pragma unroll
                for (int nt = 0; nt < 4; ++nt) b[nt] = mma(vt[kb], sf[nt][kb], b[nt]);
#pragma unroll
            for (int nt = 0; nt < 4; ++nt) {
                const float qd = ex2(lg2 * (float)(16 * nt + j + 1));
                o[nt] = b[nt] + a[nt] * qd;
                float s1 = (o[nt][0] + o[nt][1]) + (o[nt][2] + o[nt][3]);
                float s2 = (o[nt][0] * o[nt][0] + o[nt][1] * o[nt][1]) + (o[nt][2] * o[nt][2] + o[nt][3] * o[nt][3]);
                s1 += __shfl_xor(s1, 16); s1 += __shfl_xor(s1, 32); s2 += __shfl_xor(s2, 16); s2 += __shfl_xor(s2, 32);
                if (ig == 0) *(LAS f32x2*)(lds + R_ST + ((16 * nt + j) * 8 + w) * 8) = (f32x2){s1, s2};
            }
        }
        {
            bf16x8 vt[2], kt[8][2];
#pragma unroll
            for (int kb = 0; kb < 2; ++kb) vt[kb] = frag(lds + R_VT, 16 * w + j, ST, ig, kb);
#pragma unroll
            for (int dt = 0; dt < 8; ++dt)
#pragma unroll
                for (int kb = 0; kb < 2; ++kb) kt[dt][kb] = frag(lds + R_KT, 16 * dt + j, ST, ig, kb);
#pragma unroll
            for (int dt = 0; dt < 8; ++dt) R[dt] = R[dt] * cdec;
#pragma unroll
            for (int kb = 0; kb < 2; ++kb)
#pragma unroll
                for (int dt = 0; dt < 8; ++dt) R[dt] = mma(kt[dt][kb], vt[kb], R[dt]);
        }
        if (full && c + 1 < nchunks) {
#pragma unroll
            for (int dt = 0; dt < 8; ++dt) { u32x2 p; p.x = pk2(R[dt][0], R[dt][1]); p.y = pk2(R[dt][2], R[dt][3]); *(LAS u32x2*)(lds + R_RT + (16 * w + j) * SQ + (16 * dt + 4 * ig) * 2) = p; }
        }
        LDS_BAR();
        if (full) {
            const f32x4 gw = *(const f32x4*)(gnw + h * 128 + 16 * w + 4 * ig);
#pragma unroll
            for (int nt = 0; nt < 4; ++nt) {
                const int n = 16 * nt + j;
                if (n < CL) {
                    const LAS f32x4* sp = (const LAS f32x4*)(lds + R_ST + n * 64);
                    const f32x4 p0 = sp[0], p1 = sp[1], p2 = sp[2], p3 = sp[3];
                    const float s1 = (p0[0] + p0[2]) + (p1[0] + p1[2]) + (p2[0] + p2[2]) + (p3[0] + p3[2]);
                    const float s2 = (p0[1] + p0[3]) + (p1[1] + p1[3]) + (p2[1] + p2[3]) + (p3[1] + p3[3]);
                    const float mean = s1 * (1.0f / 128.0f);
                    const float var = fmaxf(s2 * (1.0f / 128.0f) - mean * mean, 0.f);
                    const float rstd = __builtin_amdgcn_rsqf(var + pg8::GN_EPS);
                    const size_t row = (size_t)(row0 + c * 64 + n);
                    const u32x2 sg = sgr[nt];
                    const float g0 = bf2f(sg.x & 0xffffu), g1 = bf2f(sg.x >> 16), g2 = bf2f(sg.y & 0xffffu), g3 = bf2f(sg.y >> 16);
                    u32x2 p;
                    p.x = pk2((o[nt][0] - mean) * rstd * gw[0] * g0, (o[nt][1] - mean) * rstd * gw[1] * g1);
                    p.y = pk2((o[nt][2] - mean) * rstd * gw[2] * g2, (o[nt][3] - mean) * rstd * gw[3] * g3);
                    *(u32x2*)(mix + row * DM + h * 128 + 16 * w + 4 * ig) = p;
                }
            }
        }
    }
#undef RET_LOAD
    if (rdst) {
#pragma unroll
        for (int dt = 0; dt < 8; ++dt)
#pragma unroll
            for (int t = 0; t < 4; ++t) rdst[(16 * dt + 4 * ig + t) * 128 + 16 * w + j] = R[dt][t];
    }
    LDS_BAR();
}
__device__ __forceinline__ float head_lg2(int h) { return h == 0 ? -0.04580368961312479f : h == 1 ? -0.02272007650008353f : h == 2 ? -0.011315313227834146f : -0.005646563141142063f; }

__device__ __forceinline__ void conv_phase(const bf16_t* proj, bf16_t* mix, const float* conv_w  , const float* sconv  , int bx_, int nthr) {
    int tid_o = threadIdx.x; asm volatile("" : "+v"(tid_o));
    const int gtid = bx_ * NTHR + tid_o;
    const int nitems = (MT / 16) * 64;
    for (int it = gtid; it < nitems; it += nthr) {
        const int co = it & 63, rb = it >> 6, r0 = rb * 16, c0 = co * 8;
        float w0[8], w1[8], w2[8], um2[8], um1[8];
#pragma unroll
        for (int e = 0; e < 8; ++e) { w0[e] = conv_w[(c0 + e) * 3 + 0]; w1[e] = conv_w[(c0 + e) * 3 + 1]; w2[e] = conv_w[(c0 + e) * 3 + 2]; }
        const bool seq_start = r0 < MP ? ((r0 & (SEQ - 1)) == 0) : true;
        if (seq_start) {
            if (r0 < MP) {
#pragma unroll
                for (int e = 0; e < 8; ++e) { um2[e] = 0.f; um1[e] = 0.f; }
            } else {
                const float* sb = sconv + (size_t)((r0 - MP) >> 4) * 1024 + c0;
#pragma unroll
                for (int e = 0; e < 8; ++e) { um2[e] = sb[e]; um1[e] = sb[512 + e]; }
            }
        } else {
            const u32x4 a = *(const u32x4*)(proj + (size_t)(r0 - 2) * LDP + 2560 + c0), b = *(const u32x4*)(proj + (size_t)(r0 - 1) * LDP + 2560 + c0);
#pragma unroll
            for (int e = 0; e < 4; ++e) { um2[2 * e] = bf2f(a[e] & 0xffffu); um2[2 * e + 1] = bf2f(a[e] >> 16); um1[2 * e] = bf2f(b[e] & 0xffffu); um1[2 * e + 1] = bf2f(b[e] >> 16); }
        }
#pragma unroll 4
        for (int i = 0; i < 16; ++i) {
            const size_t row = (size_t)(r0 + i);
            const u32x4 uu = *(const u32x4*)(proj + row * LDP + 2560 + c0), bb = *(const u32x4*)(proj + row * LDP + 2048 + c0);
            float res[8];
#pragma unroll
            for (int e = 0; e < 4; ++e) {
                const float u0 = bf2f(uu[e] & 0xffffu), u1 = bf2f(uu[e] >> 16), b0 = bf2f(bb[e] & 0xffffu), b1 = bf2f(bb[e] >> 16);
                res[2 * e] = b0 * (w0[2 * e] * um2[2 * e] + w1[2 * e] * um1[2 * e] + w2[2 * e] * u0);
                res[2 * e + 1] = b1 * (w0[2 * e + 1] * um2[2 * e + 1] + w1[2 * e + 1] * um1[2 * e + 1] + w2[2 * e + 1] * u1);
                um2[2 * e] = um1[2 * e]; um1[2 * e] = u0; um2[2 * e + 1] = um1[2 * e + 1]; um1[2 * e + 1] = u1;
            }
            u32x4 o; o.x = pk2(res[0], res[1]); o.y = pk2(res[2], res[3]); o.z = pk2(res[4], res[5]); o.w = pk2(res[6], res[7]);
            *(u32x4*)(mix + row * DM + 512 + c0) = o;
        }
    }
}

__device__ __forceinline__ void conv_weight(const float* W, int K, int N, bf16_t* Wt, const float* ksc, int mode, int gtid, int nthr, int p0 = 0, int p1 = 1, int np = 1) {
    const int nall = (K / 8) * N, it0 = (int)((long)nall * p0 / np), nitems = (int)((long)nall * p1 / np);
    for (int it = it0 + gtid; it < nitems; it += nthr) {
        const int ko = it / N, np = it - ko * N, k0 = ko * 8;
        int col = np; float cs = 1.f;
        if (mode == 1) {
            const int pn = np >> 8, bj = (np >> 7) & 1, t = np & 127;
            if (pn < 4) { col = (pn < 2 ? 0 : 512) + 128 * (2 * (pn & 1) + (t >> 6)) + 64 * bj + (t & 63); if (pn >= 2) cs = 0.08838834764831845f; }
            else if (pn >= 10) col = (bj ? 3072 : 2560) + 128 * (pn - 10) + t;
        }
        float v[8];
#pragma unroll
        for (int e = 0; e < 8; ++e) v[e] = W[(size_t)(k0 + e) * N + col] * (ksc ? ksc[k0 + e] : 1.f) * cs;
        u32x4 o; o.x = pk2(v[0], v[1]); o.y = pk2(v[2], v[3]); o.z = pk2(v[4], v[5]); o.w = pk2(v[6], v[7]);
        *(u32x4*)(Wt + (size_t)np * K + k0) = o;
    }
}
__device__ __forceinline__ float wave_sum(float v) {
#pragma unroll
    for (int o = 1; o < 64; o <<= 1) v += __shfl_xor(v, o);
    return v;
}

#define BG_IDS(P) int bg_t_ = threadIdx.x; asm volatile("" : "+v"(bg_t_)); const int bg_gtid = (bx - (P)) * NTHR + bg_t_, bg_n = (G - (P)) * NTHR
struct Args { const float* in[13]; float* out; unsigned char* ws; };

__global__ void __launch_bounds__(NTHR, 2) hymba_fwd(Args args) {
    extern __shared__ __attribute__((aligned(16))) unsigned char lds_raw[];
    LAS unsigned char* lds = (LAS unsigned char*)lds_raw;
    cg::grid_group grid = cg::this_grid();
    const int tid = threadIdx.x, lane = tid & 63, wave = __builtin_amdgcn_readfirstlane(tid >> 6);
    const int G = gridDim.x, bx = blockIdx.x;
    const int gtid = bx * NTHR + tid, nthr = G * NTHR, gw = bx * 8 + wave, ngw = G * 8;
    unsigned char* ws = args.ws;
    const float* x_prompt = args.in[0]; const float* x_sample = args.in[1]; const float* state_ret = args.in[2]; const float* state_conv = args.in[3];
    const float* ln1_w = args.in[4]; const float* w_in = args.in[5]; const float* conv_w = args.in[6]; const float* ret_norm_w = args.in[7];
    const float* w_out = args.in[8]; const float* ln2_w = args.in[9]; const float* w_up = args.in[10]; const float* w_dn = args.in[11]; const float* ln_f_w = args.in[12];
    float* out = args.out;
    bf16_t* WtIn = (bf16_t*)(ws + WS_WIN); bf16_t* WtOut = (bf16_t*)(ws + WS_WOUT); bf16_t* WtUp = (bf16_t*)(ws + WS_WUP); bf16_t* WtDn = (bf16_t*)(ws + WS_WDN);
    float* ssp = (float*)(ws + WS_SSP); float* sseg = (float*)(ws + WS_SSEG);
    bf16_t* xb = (bf16_t*)(ws + WS_XB); bf16_t* proj = (bf16_t*)(ws + WS_PROJ); bf16_t* mix = (bf16_t*)(ws + WS_MIX); bf16_t* Hb = (bf16_t*)(ws + WS_H);
    unsigned* ctl = (unsigned*)(ws + WS_CTL); float* part = (float*)(ws + WS_PART);
    volatile LAS unsigned* MISC = (volatile LAS unsigned*)(lds + 131072 + 512);
    if (tid < 64) MISC[tid] = 0u;
    if (bx == 0) { for (int i = tid; i < CTL_WORDS; i += NTHR) ctl[i] = 0u; }
    __syncthreads();
    int kslice = 256; asm volatile("" : "+s"(kslice));
    LAS float* rbuf = (LAS float*)(lds + 131072 + 1024);
    float* X = out;

    conv_weight(w_in, DM, NIN, WtIn, ln1_w, 1, gtid, nthr);
    for (int r = gw; r < MT; r += ngw) {
        const float* xr = r < MP ? x_prompt + (size_t)r * DM : x_sample + (size_t)(r - MP) * DM;
        float s = 0.f;
#pragma unroll
        for (int q = 0; q < 4; ++q) {
            const f32x4 v = *(const f32x4*)(xr + 256 * q + 4 * lane);
            u32x2 p; p.x = pk2(v[0], v[1]); p.y = pk2(v[2], v[3]);
            *(u32x2*)(xb + (size_t)r * DM + 256 * q + 4 * lane) = p;
            s += (v[0] * v[0] + v[1] * v[1]) + (v[2] * v[2] + v[3] * v[3]);
        }
        s = wave_sum(s);
        if (lane < 16) ssp[(size_t)r * 16 + lane] = lane == 0 ? s : 0.f;
    }
    grid.sync();
    XcdBarrier bar = xcd_barrier_post(ctl, MISC + 8);

#pragma unroll 1
    for (int l = 0; l < DEPTH; ++l) {
        {
            const bf16_t* Bw = WtIn + (size_t)l * NIN * DM;
            pg8::EpiIn E{proj, rbuf, out + O_CONVP + (size_t)l * NBATCH * 1024, out + O_CONVS + (size_t)l * DBATCH * 1024};
            { pg8::Gemm g{xb, Bw, MP, NIN, DM, DM}; pg8::StaticOrder S; S.init(MP, NIN, G, bx); pg8::rstd_prepass(rbuf, ssp, S); pg8::gemm_phase<pg8::EpiIn, pg8::StaticOrder, true, true>(lds, g, S, E); }
#pragma unroll 1
            for (int s = 0; s < DM / 256; ++s) {
                pg8::Gemm g{xb + s * 256, Bw + s * 256, MT, NIN, DM, kslice}; pg8::SliceOrder S{s * (NIN / 256), NIN / 256, bx}; pg8::rstd_prepass(rbuf, ssp, S);
                pg8::SplitEpi<pg8::EpiIn, 4> E2{E, part, ctl + CW_CNT + (l * 4 + 0) * 128, ctl + 16, s};
                pg8::gemm_phase<pg8::SplitEpi<pg8::EpiIn, 4>, pg8::SliceOrder, false, true>(lds, g, S, E2);
            }
            if (bx >= 56 && G > 56) { BG_IDS(56);
                conv_weight(w_out + (size_t)l * DM * DM, DM, DM, WtOut + (size_t)l * DM * DM, nullptr, 0, bg_gtid, bg_n);
                conv_weight(w_up + (size_t)l * DM * DFF, DM, DFF, WtUp + (size_t)l * DFF * DM, ln2_w + l * DM, 0, bg_gtid, bg_n, 0, 1, 2); }
        }
        xcd_barrier(bar);
        for (int k2 = 0; ; ++k2) {
            int it;
            if (G == 256) { if (k2 == 0) it = bx; else if (k2 == 1 && bx >= 224) it = bx + 32; else break; }
            else { it = bx + k2 * G; if (it >= 288) break; }
            if (it < 224) {
                const int b = it / 28, rem = it - b * 28, h = rem / 7, sg = rem - h * 7;
                ret_item(lds, proj, mix, b * SEQ + sg * 512, 8, 64, h, head_lg2(h), false, 0, nullptr, 0, sseg + (size_t)((b * 4 + h) * 8 + sg) * 16384, nullptr);
            } else {
                const int si = it - 224, b = si >> 2, h = si & 3;
                ret_item(lds, proj, mix, MP + b * DSEQ, 1, DSEQ, h, head_lg2(h), true, 2, state_ret + (size_t)((l * DBATCH + b) * 4 + h) * 16384, 0,
                         out + O_RETS + (size_t)((l * DBATCH + b) * 4 + h) * 16384, ret_norm_w + l * 512);
            }
        }
        conv_phase(proj, mix, conv_w + (size_t)l * 512 * 3, state_conv + (size_t)l * DBATCH * 1024, bx, nthr);
        xcd_barrier(bar);
        for (int it = bx; it < 256; it += G) {
            const int b = it >> 5, h = (it >> 3) & 3, sg = it & 7;
            ret_item(lds, proj, mix, b * SEQ + sg * 512, 8, 64, h, head_lg2(h), true, sg > 0 ? 1 : 0, sseg + (size_t)((b * 4 + h) * 8) * 16384, sg,
                     sg == 7 ? out + O_RETP + (size_t)((l * NBATCH + b) * 4 + h) * 16384 : nullptr, ret_norm_w + l * 512);
        }
        xcd_barrier(bar);
        {
            const bf16_t* Bw = WtOut + (size_t)l * DM * DM;
            pg8::EpiRes E{l == 0 ? x_prompt : X, l == 0 ? x_sample : X + (size_t)MP * DM, X, xb, ssp};
            { pg8::Gemm g{mix, Bw, MP, DM, DM, DM}; pg8::StaticOrder S; S.init(MP, DM, G, bx); pg8::gemm_phase<pg8::EpiRes, pg8::StaticOrder, true, true>(lds, g, S, E); }
#pragma unroll 1
            for (int s = 0; s < DM / 256; ++s) {
                pg8::Gemm g{mix + s * 256, Bw + s * 256, MT, DM, DM, kslice}; pg8::SliceOrder S{s * (DM / 256), DM / 256, bx};
                pg8::SplitEpi<pg8::EpiRes, 4> E2{E, part, ctl + CW_CNT + (l * 4 + 1) * 128, ctl + 16, s};
                pg8::gemm_phase<pg8::SplitEpi<pg8::EpiRes, 4>, pg8::SliceOrder, false, true>(lds, g, S, E2);
            }
            if (bx >= 16 && G > 16) { BG_IDS(16);
                conv_weight(w_up + (size_t)l * DM * DFF, DM, DFF, WtUp + (size_t)l * DFF * DM, ln2_w + l * DM, 0, bg_gtid, bg_n, 1, 2, 2);
                conv_weight(w_dn + (size_t)l * DFF * DM, DFF, DM, WtDn + (size_t)l * DM * DFF, nullptr, 0, bg_gtid, bg_n, 0, 1, 4); }
        }
        xcd_barrier(bar);
        {
            const bf16_t* Bw = WtUp + (size_t)l * DFF * DM;
            pg8::EpiUp E{Hb, rbuf};
            { pg8::Gemm g{xb, Bw, MP, DFF, DM, DM}; pg8::StaticOrder S; S.init(MP, DFF, G, bx); pg8::rstd_prepass(rbuf, ssp, S); pg8::gemm_phase<pg8::EpiUp, pg8::StaticOrder, true, true>(lds, g, S, E); }
#pragma unroll 1
            for (int s = 0; s < DM / 256; ++s) {
                pg8::Gemm g{xb + s * 256, Bw + s * 256, MT, DFF, DM, kslice}; pg8::SliceOrder S{s * (DFF / 256), DFF / 256, bx}; pg8::rstd_prepass(rbuf, ssp, S);
                pg8::SplitEpi<pg8::EpiUp, 4> E2{E, part, ctl + CW_CNT + (l * 4 + 2) * 128, ctl + 16, s};
                pg8::gemm_phase<pg8::SplitEpi<pg8::EpiUp, 4>, pg8::SliceOrder, false, true>(lds, g, S, E2);
            }
            if (bx >= 64 && G > 64) { BG_IDS(64); conv_weight(w_dn + (size_t)l * DFF * DM, DFF, DM, WtDn + (size_t)l * DM * DFF, nullptr, 0, bg_gtid, bg_n, 1, 4, 4); }
        }
        xcd_barrier(bar);
        {
            const bf16_t* Bw = WtDn + (size_t)l * DM * DFF;
            pg8::EpiRes E{X, X + (size_t)MP * DM, X, xb, ssp};
            { pg8::Gemm g{Hb, Bw, MP, DM, DFF, DFF}; pg8::StaticOrder S; S.init(MP, DM, G, bx); pg8::gemm_phase<pg8::EpiRes, pg8::StaticOrder, true, true>(lds, g, S, E); }
#pragma unroll 1
            for (int s = 0; s < 8; ++s) {
                pg8::Gemm g{Hb + s * 512, Bw + s * 512, MT, DM, DFF, 2 * kslice}; pg8::SliceOrder S{s * (DM / 256), DM / 256, bx};
                pg8::SplitEpi<pg8::EpiRes, 8> E2{E, part, ctl + CW_CNT + (l * 4 + 3) * 128, ctl + 16, s};
                pg8::gemm_phase<pg8::SplitEpi<pg8::EpiRes, 8>, pg8::SliceOrder, false, true>(lds, g, S, E2);
            }
            if (l == 0 && bx >= 32 && G > 32) { BG_IDS(32); conv_weight(w_in + (size_t)DM * NIN, DM, NIN, WtIn + (size_t)NIN * DM, ln1_w + DM, 1, bg_gtid, bg_n); }
        }
        xcd_barrier(bar);
    }
    int tid2 = threadIdx.x; asm volatile("" : "+v"(tid2));
    const int lane2 = tid2 & 63, gw2 = bx * 8 + __builtin_amdgcn_readfirstlane(tid2 >> 6);
    for (int r = gw2; r < MT; r += ngw) {
        const float rs = pg8::row_rstd(ssp, r);
        float* xr = X + (size_t)r * DM;
#pragma unroll
        for (int q = 0; q < 4; ++q) {
            const f32x4 v = *(const f32x4*)(xr + 256 * q + 4 * lane2), wv = *(const f32x4*)(ln_f_w + 256 * q + 4 * lane2);
            *(f32x4*)(xr + 256 * q + 4 * lane2) = v * rs * wv;
        }
    }
}

extern "C" void kernel_launch(void* const* d_in, const int* in_sizes, int n_in, void* d_out, int out_size, void* d_ws, size_t ws_size, hipStream_t stream) {
    static int grid = 0;
    if (grid == 0) {
        int dev = 0, cus = 0, per_cu = 0;
        if (n_in != 13 || ws_size < WS_END) { fprintf(stderr, "kernel_launch: unexpected n_in %d / ws_size %zu (need %zu)\n", n_in, ws_size, (size_t)WS_END); grid = -1; return; }
        hipGetDevice(&dev);
        hipDeviceGetAttribute(&cus, hipDeviceAttributeMultiprocessorCount, dev);
        hipFuncSetAttribute((const void*)hymba_fwd, hipFuncAttributeMaxDynamicSharedMemorySize, LDS_BYTES);
        hipOccupancyMaxActiveBlocksPerMultiprocessor(&per_cu, (const void*)hymba_fwd, NTHR, LDS_BYTES);
        if (per_cu < 1) { fprintf(stderr, "kernel_launch: occupancy query says %d blocks/CU\n", per_cu); per_cu = 1; }
        (void)hipGetLastError();
        grid = cus;
    }
    if (grid < 0) return;
    Args a{};
    for (int i = 0; i < 13; ++i) a.in[i] = (const float*)d_in[i];
    a.out = (float*)d_out; a.ws = (unsigned char*)d_ws;
    void* kargs[] = {&a};
    hipError_t e = hipLaunchCooperativeKernel((const void*)hymba_fwd, dim3(grid), dim3(NTHR), kargs, LDS_BYTES, stream);
    if (e != hipSuccess) fprintf(stderr, "cooperative launch failed: %s (grid %d)\n", hipGetErrorString(e), grid);
}
```

```cpp
#include <hip/hip_runtime.h>
#include <hip/hip_cooperative_groups.h>
#include <cstdio>
#include <cstdint>
namespace cg = cooperative_groups;
namespace pg8 {
#define PG8_LAS __attribute__((address_space(3)))
typedef unsigned short bf16_t;
typedef short bf16x8 __attribute__((ext_vector_type(8)));
typedef float f32x4 __attribute__((ext_vector_type(4)));
typedef unsigned u32x4 __attribute__((ext_vector_type(4)));
constexpr int BM = 256, BK = 64, HALF = 128, HTB = HALF * BK * 2  , STAGE_BYTES = 8 * HTB, NXCD = 8, WGM = 8;

__host__ __device__ __forceinline__ int lds_byte(int r, int c) { const int st = (r >> 4) * 2 + (c >> 5), rr = r & 15, cc = c & 31, ob = rr * 64 + cc * 2; return st * 1024 + (ob ^ (((ob >> 9) & 1) << 5)); }
__host__ __device__ __forceinline__ void stage_rc(int b, int& R, int& C) { const int st = b / 1024, sb = b % 1024, swz = sb ^ (((sb >> 9) & 1) << 5); R = (st >> 1) * 16 + swz / 64; C = (st & 1) * 32 + (swz % 64) / 2; }
__host__ __device__ __forceinline__ int perm32(int rho) { const int n = rho >> 4, i = rho & 15; return 8 * (i >> 2) + 4 * n + (i & 3); }

struct Unit { int pm, pn, idx; };
struct Gemm { const bf16_t* A; const bf16_t* Bt; int M, N, K, Kloop; };

struct StaticOrder {
    int nM, nN, nwg, G, c;
    __host__ __device__ __forceinline__ void init(int M, int N, int G_, int c_) { nM = M / BM; nN = N / BM; nwg = nM * nN; G = G_; c = c_; }
    __host__ __device__ __forceinline__ void map(int L, int& pm, int& pn) const {
        int wgid = L; { const int q = nwg / NXCD, r = nwg % NXCD, xcd = wgid % NXCD, off = wgid / NXCD; wgid = (xcd < r ? xcd * (q + 1) : r * (q + 1) + (xcd - r) * q) + off; }
        const int nig = WGM * nN, gid = wgid / nig, fm = gid * WGM, gsz = (nM - fm) < WGM ? (nM - fm) : WGM;
        pm = fm + ((wgid % nig) % gsz); pn = (wgid % nig) / gsz;
    }
    __host__ __device__ __forceinline__ bool next(int i, Unit& u) const {
        const long L = (long)i * G + c; if (L >= nwg) return false;
        int wgid = (int)L; { const int q = nwg / NXCD, r = nwg % NXCD, xcd = wgid % NXCD, off = wgid / NXCD; wgid = (xcd < r ? xcd * (q + 1) : r * (q + 1) + (xcd - r) * q) + off; }
        const int nig = WGM * nN, gid = wgid / nig, fm = gid * WGM, gsz = (nM - fm) < WGM ? (nM - fm) : WGM;
        u.pm = fm + ((wgid % nig) % gsz); u.pn = (wgid % nig) / gsz; u.idx = i; return true;
    }
    __device__ __forceinline__ void a_ready(const Unit&) const {}
    __device__ __forceinline__ void done(const Unit&) const {}
};

__device__ __forceinline__ unsigned cvt_pk_bf16(float lo, float hi) { unsigned r; asm volatile("v_cvt_pk_bf16_f32 %0, %1, %2" : "=v"(r) : "v"(lo), "v"(hi)); return r; }
typedef float f32x2 __attribute__((ext_vector_type(2)));

constexpr int DM = 1024, NBATCH = 8, SEQ = 4096, DEPTH = 2, DBATCH = 16, DSEQ = 16, PAST = 2048;
constexpr int MP = NBATCH * SEQ, MS = DBATCH * DSEQ, MT = MP + MS;
constexpr int NIN = 3584, DFF = 4096, LDP = 3072;
constexpr float RMS_EPS = 1e-6f, GN_EPS = 1e-5f;

__device__ __forceinline__ void store8bf(bf16_t* p, const f32x4 a, const f32x4 b) {
    u32x4 w; w.x = cvt_pk_bf16(a[0], a[1]); w.y = cvt_pk_bf16(a[2], a[3]); w.z = cvt_pk_bf16(b[0], b[1]); w.w = cvt_pk_bf16(b[2], b[3]);
    *(u32x4*)p = w;
}
__device__ __forceinline__ float row_rstd(const float* ssp, int r) {
    const f32x4* sp = (const f32x4*)(ssp + (size_t)r * 16);
    const f32x4 s0 = sp[0], s1 = sp[1], s2 = sp[2], s3 = sp[3];
    const f32x4 s = (s0 + s1) + (s2 + s3);
    const float tot = (s[0] + s[1]) + (s[2] + s[3]);
    return __builtin_amdgcn_rsqf(tot * (1.0f / DM) + RMS_EPS);
}
__device__ __forceinline__ float silu_f(float x) { return x * __builtin_amdgcn_rcpf(1.0f + __builtin_amdgcn_exp2f(-1.4426950408889634f * x)); }

struct EpiIn {
    static constexpr bool PERM = true, AFTER_DRAIN = false;
    bf16_t* proj; const PG8_LAS float* rbuf; float* nconv_p; float* nconv_s;
    __device__ __forceinline__ void operator()(f32x4 (&acc)[2][2][4][2], const Unit& u, int wr, int wc, int fr, int fq, unsigned gmask = 0xffu) const {
        const int pn = u.pn, tcol = wc * 32 + 8 * fq;
        const PG8_LAS float* rb = rbuf + u.idx * BM + wr * 64 + fr;
        if (pn < 4) {
            const int i0 = 32 * (wc & 1) + 8 * fq;
            float ir[8];
#pragma unroll
            for (int e = 0; e < 8; ++e) ir[e] = __builtin_amdgcn_exp2f(-(float)(i0 + e) * (13.287712379549449f / 64.0f)) * 0.15915494309189535f;
            const int dcol = (pn < 2 ? 0 : 512) + 128 * (2 * (pn & 1) + (wc >> 1)) + i0;
#pragma unroll
            for (int ai = 0; ai < 2; ++ai)
#pragma unroll
                for (int m = 0; m < 4; ++m) {
                    if (!((gmask >> (ai * 4 + m)) & 1u)) continue;
                    const int r = u.pm * BM + ai * HALF + wr * 64 + m * 16 + fr;
                    const float rs = rb[ai * HALF + m * 16];
                    float fp = (float)(r < MP ? (r & (SEQ - 1)) : PAST + (r & (DSEQ - 1)));
                    asm volatile("" : "+v"(fp) :: "memory");
                    f32x4 o1[2], o2[2];
#pragma unroll
                    for (int n = 0; n < 2; ++n)
#pragma unroll
                        for (int e = 0; e < 4; ++e) {
                            const float rev = fp * ir[4 * n + e], f = __builtin_amdgcn_fractf(rev);
                            const float c = __builtin_amdgcn_cosf(f), s = __builtin_amdgcn_sinf(f);
                            const float x1 = acc[ai][0][m][n][e] * rs, x2 = acc[ai][1][m][n][e] * rs;
                            o1[n][e] = x1 * c - x2 * s; o2[n][e] = x1 * s + x2 * c;
                        }
                    bf16_t* prow = proj + (size_t)r * LDP + dcol;
                    store8bf(prow, o1[0], o1[1]); store8bf(prow + 64, o2[0], o2[1]);
                }
        } else {
#pragma unroll
            for (int ai = 0; ai < 2; ++ai)
#pragma unroll
                for (int m = 0; m < 4; ++m) {
                    if (!((gmask >> (ai * 4 + m)) & 1u)) continue;
                    const int r = u.pm * BM + ai * HALF + wr * 64 + m * 16 + fr;
                    const float rs = rb[ai * HALF + m * 16];
                    const f32x4 a0 = acc[ai][0][m][0] * rs, a1 = acc[ai][0][m][1] * rs, b0 = acc[ai][1][m][0] * rs, b1 = acc[ai][1][m][1] * rs;
                    bf16_t* prow = proj + (size_t)r * LDP;
                    if (pn < 10) {
                        f32x4 x0 = a0, x1 = a1, y0 = b0, y1 = b1;
                        if (pn == 6 || pn == 7) {
#pragma unroll
                            for (int e = 0; e < 4; ++e) { x0[e] = silu_f(x0[e]); x1[e] = silu_f(x1[e]); y0[e] = silu_f(y0[e]); y1[e] = silu_f(y1[e]); }
                        }
                        const int dcol = 256 * pn + tcol;
                        store8bf(prow + dcol, x0, x1); store8bf(prow + dcol + 128, y0, y1);
                    } else {
                        const f32x4 u0 = a0 * b0, u1 = a1 * b1;
                        const int cc = 128 * (pn - 10) + tcol;
                        store8bf(prow + 2560 + cc, u0, u1);
                        if (r < MP) { const int t = r & (SEQ - 1); if (t >= SEQ - 2) { float* d = nconv_p + (size_t)((r >> 12) * 2 + (t - (SEQ - 2))) * 512 + cc; *(f32x4*)d = u0; *(f32x4*)(d + 4) = u1; } }
                        else { const int t = r & (DSEQ - 1); if (t >= DSEQ - 2) { float* d = nconv_s + (size_t)(((r - MP) >> 4) * 2 + (t - (DSEQ - 2))) * 512 + cc; *(f32x4*)d = u0; *(f32x4*)(d + 4) = u1; } }
                    }
                }
        }
    }
};
struct EpiRes {
    static constexpr bool PERM = false, AFTER_DRAIN = false;
    const float* xs_main; const float* xs_tail; float* X; bf16_t* xb; float* ssp;
    __device__ __forceinline__ void operator()(f32x4 (&acc)[2][2][4][2], const Unit& u, int wr, int wc, int fr, int fq, unsigned gmask = 0xffu) const {
        typedef unsigned u32x2v __attribute__((ext_vector_type(2)));
        const int cb = u.pn * BM + wc * 32 + 4 * fq;
#pragma unroll
        for (int g = 0; g < 4; ++g) {
            if (!((gmask >> (2 * g)) & 3u)) continue;
            const int ai = g >> 1, mb = (g & 1) * 2;
            const int r0 = u.pm * BM + ai * HALF + wr * 64 + mb * 16 + fr;
            const float* xs = (r0 < MP ? xs_main + (size_t)r0 * DM : xs_tail + (size_t)(r0 - MP) * DM) + cb;
            f32x4 xv[2][2][2];
#pragma unroll
            for (int m = 0; m < 2; ++m)
#pragma unroll
                for (int bj = 0; bj < 2; ++bj)
#pragma unroll
                    for (int n = 0; n < 2; ++n) xv[m][bj][n] = *(const f32x4*)(xs + (size_t)m * 16 * DM + bj * HALF + n * 16);
#pragma unroll
            for (int m = 0; m < 2; ++m) {
                if (!((gmask >> (2 * g + m)) & 1u)) continue;
                const int r = r0 + m * 16;
                float ss = 0.f;
#pragma unroll
                for (int bj = 0; bj < 2; ++bj)
#pragma unroll
                    for (int n = 0; n < 2; ++n) {
                        const int c = cb + bj * HALF + n * 16;
                        const f32x4 v = xv[m][bj][n] + acc[ai][bj][mb + m][n];
                        *(f32x4*)(X + (size_t)r * DM + c) = v;
                        u32x2v w; w.x = cvt_pk_bf16(v[0], v[1]); w.y = cvt_pk_bf16(v[2], v[3]);
                        *(u32x2v*)(xb + (size_t)r * DM + c) = w;
                        ss += (v[0] * v[0] + v[1] * v[1]) + (v[2] * v[2] + v[3] * v[3]);
                    }
                ss += __shfl_xor(ss, 16); ss += __shfl_xor(ss, 32);
                if (fq == 0) ssp[(size_t)r * 16 + 4 * u.pn + wc] = ss;
            }
            asm volatile("" ::: "memory");
        }
    }
};
struct EpiUp {
    static constexpr bool PERM = true, AFTER_DRAIN = false;
    bf16_t* H; const PG8_LAS float* rbuf;
    __device__ __forceinline__ void operator()(f32x4 (&acc)[2][2][4][2], const Unit& u, int wr, int wc, int fr, int fq, unsigned gmask = 0xffu) const {
        const PG8_LAS float* rb = rbuf + u.idx * BM + wr * 64 + fr;
#pragma unroll
        for (int ai = 0; ai < 2; ++ai)
#pragma unroll
            for (int m = 0; m < 4; ++m) {
                if (!((gmask >> (ai * 4 + m)) & 1u)) continue;
                const int r = u.pm * BM + ai * HALF + wr * 64 + m * 16 + fr;
                const float rs = rb[ai * HALF + m * 16];
                bf16_t* hrow = H + (size_t)r * DFF + u.pn * BM + wc * 32 + 8 * fq;
#pragma unroll
                for (int bj = 0; bj < 2; ++bj) {
                    f32x4 v0 = acc[ai][bj][m][0] * rs, v1 = acc[ai][bj][m][1] * rs;
#pragma unroll
                    for (int e = 0; e < 4; ++e) { const float p = fmaxf(v0[e], 0.f), q = fmaxf(v1[e], 0.f); v0[e] = p * p; v1[e] = q * q; }
                    store8bf(hrow + bj * HALF, v0, v1);
                }
            }
    }
};
template <class Sched> __device__ __forceinline__ void rstd_prepass(PG8_LAS float* rbuf, const float* ssp, const Sched& S) {
    int tid = threadIdx.x; asm volatile("" : "+v"(tid));
    const int row = tid >> 1, half = tid & 1;
    Unit u;
    for (int i = 0; S.next(i, u); ++i) {
        const f32x4* sp = (const f32x4*)(ssp + (size_t)(u.pm * BM + row) * 16 + half * 8);
        const f32x4 a = sp[0], b = sp[1];
        float t = ((a[0] + a[1]) + (a[2] + a[3])) + ((b[0] + b[1]) + (b[2] + b[3]));
        t += __shfl_xor(t, 1);
        if (half == 0) rbuf[i * BM + row] = __builtin_amdgcn_rsqf(t * (1.0f / DM) + RMS_EPS);
    }
    __syncthreads();
}
struct SliceOrder {
    int first, nN, c;
    __device__ __forceinline__ bool next(int i, Unit& u) const { const int idx = c - first; u.pm = MP / BM; u.pn = idx; u.idx = 0; return i == 0 && idx >= 0 && idx < nN; }
    __device__ __forceinline__ void a_ready(const Unit&) const {}
    __device__ __forceinline__ void done(const Unit&) const {}
};
template <class E, int NSL> struct SplitEpi {
    static constexpr bool PERM = E::PERM, AFTER_DRAIN = false;
    E e; float* part; unsigned* cnt; unsigned* tmo; int slice;
    __device__ __forceinline__ void operator()(f32x4 (&acc)[2][2][4][2], const Unit& u, int wr, int wc, int fr, int fq) const {
        constexpr int NG = 8 / NSL;
        const int wid = wr * 4 + wc, lane = fq * 16 + fr;
        f32x4* base = (f32x4*)part + (size_t)(u.pn * 8 + wid) * 32 * 64 + lane;
        const size_t sstride = (size_t)16 * 8 * 32 * 64;
        f32x4* dst = base + (size_t)slice * sstride;
#pragma unroll
        for (int q = 0; q < 32; ++q) asm volatile("global_store_dwordx4 %0, %1, off sc1\n\ts_nop 2" :: "v"(dst + q * 64), "v"(acc[q >> 4][(q >> 3) & 1][(q >> 1) & 3][q & 1]) : "memory");
        asm volatile("s_waitcnt vmcnt(0)" ::: "memory");
        unsigned* cw = cnt + u.pn * 8 + wid;
        if (lane == 0) __hip_atomic_fetch_add(cw, 1u, __ATOMIC_RELAXED, __HIP_MEMORY_SCOPE_AGENT);
        { unsigned sp = 0u;
          while ((unsigned)__builtin_amdgcn_readfirstlane((int)__hip_atomic_load(cw, __ATOMIC_RELAXED, __HIP_MEMORY_SCOPE_AGENT)) < (unsigned)NSL) {
              __builtin_amdgcn_s_sleep(1);
              if (++sp > (1u << 20)) { if (lane == 0) __hip_atomic_store(tmo, 1u, __ATOMIC_RELAXED, __HIP_MEMORY_SCOPE_AGENT); break; }
          } }
        __builtin_amdgcn_fence(__ATOMIC_ACQUIRE, "agent");
#pragma unroll
        for (int s = 0; s < NSL; ++s) {
            if (slice != s) continue;
            f32x4 sum[NG][4];
#pragma unroll
            for (int gi = 0; gi < NG; ++gi)
#pragma unroll
                for (int p = 0; p < 4; ++p) sum[gi][p] = (f32x4){0.f, 0.f, 0.f, 0.f};
#pragma unroll
            for (int sb = 0; sb < NSL; sb += 4) {
                f32x4 t[4][NG][4];
#pragma unroll
                for (int sl = sb; sl < sb + 4; ++sl)
#pragma unroll
                    for (int gi = 0; gi < NG; ++gi)
#pragma unroll
                        for (int p = 0; p < 4; ++p) {
                            const int g = s * NG + gi, ai = g >> 2, m = g & 3, bj = p >> 1, n = p & 1, q = ((ai * 2 + bj) * 4 + m) * 2 + n;
                            if (sl != s) t[sl - sb][gi][p] = base[(size_t)sl * sstride + q * 64];
                        }
#pragma unroll
                for (int sl = sb; sl < sb + 4; ++sl)
#pragma unroll
                    for (int gi = 0; gi < NG; ++gi)
#pragma unroll
                        for (int p = 0; p < 4; ++p) {
                            const int g = s * NG + gi, ai = g >> 2, m = g & 3, bj = p >> 1, n = p & 1;
                            sum[gi][p] += (sl == s) ? acc[ai][bj][m][n] : t[sl - sb][gi][p];
                        }
                asm volatile("" ::: "memory");
            }
#pragma unroll
            for (int gi = 0; gi < NG; ++gi)
#pragma unroll
                for (int p = 0; p < 4; ++p) { const int g = s * NG + gi; acc[g >> 2][p >> 1][g & 3][p & 1] = sum[gi][p]; }
            e(acc, u, wr, wc, fr, fq, ((1u << NG) - 1u) << (s * NG));
        }
    }
};
template <class Epi, class Sched, bool ALIGN_EPI = false, bool SP2 = false>
__device__ __forceinline__ void gemm_phase(PG8_LAS unsigned char* lds, const Gemm g, const Sched& S, const Epi& E) {
    int tid_o = threadIdx.x; asm volatile("" : "+v"(tid_o));
    const int tid = tid_o, wid = __builtin_amdgcn_readfirstlane(tid >> 6), lane = tid & 63, wr = wid >> 2, wc = wid & 3, fr = lane & 15, fq = lane >> 4;
    const int K = g.K, nt = g.Kloop / BK;
    unsigned voffA[2], voffB[2];
#pragma unroll
    for (int i = 0; i < 2; ++i) { int R, C; stage_rc(tid * 16 + i * 8192, R, C); const int Rb = Epi::PERM ? ((R & ~31) + perm32(R & 31)) : R;
        voffA[i] = (unsigned)(R * K + C) * 2u; voffB[i] = (unsigned)(Rb * K + C) * 2u; }
    const size_t kstep = (size_t)(BK * 2);
    const size_t hstep = (size_t)HALF * K * 2;
    const size_t tstep = 2 * hstep;
    const unsigned ldsw = (unsigned)wid * 1024u;
    const int aoff = lds_byte(wr * 64 + fr, fq * 8), boff = lds_byte(wc * 32 + fr, fq * 8);
#define PG8_SA(b, h) (((b) * 2 + (h)) * HTB)
#define PG8_SB(b, h) ((4 + (b) * 2 + (h)) * HTB)
#define PG8_STAGE(bufoff, gbase, voff) do { _Pragma("unroll") for (int _i = 0; _i < 2; ++_i) \
        __builtin_amdgcn_global_load_lds((const unsigned*)((const char*)(gbase) + (voff)[_i]), (PG8_LAS unsigned*)(lds + (bufoff) + ldsw + _i * 8192), 16, 0, 0); } while (0)
#define PG8_LDA(dst, b, h) do { _Pragma("unroll") for (int m = 0; m < 4; ++m) _Pragma("unroll") for (int k = 0; k < 2; ++k) dst[m][k] = *(const PG8_LAS bf16x8*)(lds + PG8_SA(b, h) + aoff + m * 2048 + k * 1024); } while (0)
#define PG8_LDB(dst, b, h) do { _Pragma("unroll") for (int n = 0; n < 2; ++n) _Pragma("unroll") for (int k = 0; k < 2; ++k) dst[n][k] = *(const PG8_LAS bf16x8*)(lds + PG8_SB(b, h) + boff + n * 2048 + k * 1024); } while (0)
#define PG8_MMA(ai, bj, At, Bt) do { __builtin_amdgcn_s_setprio(1); _Pragma("unroll") for (int m = 0; m < 4; ++m) _Pragma("unroll") for (int n = 0; n < 2; ++n) _Pragma("unroll") for (int k = 0; k < 2; ++k) \
        acc[ai][bj][m][n] = __builtin_amdgcn_mfma_f32_16x16x32_bf16(Bt[n][k], At[m][k], acc[ai][bj][m][n], 0, 0, 0); __builtin_amdgcn_s_setprio(0); } while (0)
#define PG8_WAIT_V(n) asm volatile("s_waitcnt vmcnt(" #n ")" ::: "memory")
#define PG8_WAIT_L(n) asm volatile("s_waitcnt lgkmcnt(" #n ")" ::: "memory")
#define PG8_BAR __builtin_amdgcn_s_barrier()
#define PG8_SCHED __builtin_amdgcn_sched_barrier(0)
    Unit cur, nxt; int ui = 0;
    if (!S.next(0, cur)) return;
    f32x4 acc[2][2][4][2];
#pragma unroll
    for (int a = 0; a < 2; ++a)
#pragma unroll
        for (int b = 0; b < 2; ++b)
#pragma unroll
            for (int m = 0; m < 4; ++m)
#pragma unroll
                for (int n = 0; n < 2; ++n) acc[a][b][m][n] = (f32x4){0.f, 0.f, 0.f, 0.f};
    bf16x8 At[4][2], B0[2][2], B1[2][2];
    const char* cA = (const char*)g.A + (size_t)cur.pm * tstep; const char* cB = (const char*)g.Bt + (size_t)cur.pn * tstep;
    S.a_ready(cur);
    if constexpr (SP2) {
        PG8_STAGE(PG8_SB(0, 0), cB, voffB); PG8_STAGE(PG8_SB(0, 1), cB + hstep, voffB); PG8_STAGE(PG8_SA(0, 0), cA, voffA); PG8_STAGE(PG8_SA(0, 1), cA + hstep, voffA);
        if (wr == 1) PG8_BAR;
        PG8_WAIT_V(2); PG8_BAR;
        PG8_STAGE(PG8_SB(1, 0), cB + kstep, voffB); PG8_STAGE(PG8_SA(1, 0), cA + kstep, voffA); PG8_STAGE(PG8_SB(1, 1), cB + hstep + kstep, voffB);
        PG8_WAIT_V(6); PG8_BAR;
    } else {
        PG8_STAGE(PG8_SB(0, 0), cB, voffB); PG8_STAGE(PG8_SA(0, 0), cA, voffA); PG8_STAGE(PG8_SB(0, 1), cB + hstep, voffB); PG8_STAGE(PG8_SA(0, 1), cA + hstep, voffA);
        if (wr == 1) PG8_BAR;
        PG8_WAIT_V(4); PG8_BAR;
        PG8_STAGE(PG8_SB(1, 0), cB + kstep, voffB); PG8_STAGE(PG8_SA(1, 0), cA + kstep, voffA); PG8_STAGE(PG8_SB(1, 1), cB + hstep + kstep, voffB);
        PG8_WAIT_V(6); PG8_BAR;
    }
    for (;;) {
        const bool has_next = S.next(ui + 1, nxt);
        const char* nA = has_next ? (const char*)g.A + (size_t)nxt.pm * tstep : cA; const char* nB = has_next ? (const char*)g.Bt + (size_t)nxt.pn * tstep : cB;
        for (int t = 0; t < nt; t += 2) {
            const bool last = (t == nt - 2);
            const char* a1 = cA + (size_t)(t + 1) * kstep;
            const char* a2 = last ? nA : cA + (size_t)(t + 2) * kstep; const char* b2 = last ? nB : cB + (size_t)(t + 2) * kstep;
            const char* a3 = a2 + kstep; const char* b3 = b2 + kstep;
            if (last && has_next) S.a_ready(nxt);
            if constexpr (SP2) {
            PG8_LDB(B0, 0, 0); PG8_LDB(B1, 0, 1); PG8_SCHED; PG8_LDA(At, 0, 0); PG8_STAGE(PG8_SA(1, 1), a1 + hstep, voffA);
            PG8_WAIT_V(8); PG8_WAIT_L(0); PG8_BAR; PG8_MMA(0, 0, At, B0); PG8_MMA(0, 1, At, B1); PG8_BAR; PG8_SCHED;
            PG8_LDA(At, 0, 1); PG8_STAGE(PG8_SB(0, 0), b2, voffB); PG8_STAGE(PG8_SB(0, 1), b2 + hstep, voffB); PG8_STAGE(PG8_SA(0, 0), a2, voffA);
            PG8_WAIT_V(8); PG8_WAIT_L(0); PG8_BAR; PG8_MMA(1, 0, At, B0); PG8_MMA(1, 1, At, B1); PG8_BAR; PG8_SCHED;
            PG8_LDB(B0, 1, 0); PG8_LDB(B1, 1, 1); PG8_SCHED; PG8_LDA(At, 1, 0); PG8_STAGE(PG8_SA(0, 1), a2 + hstep, voffA);
            PG8_WAIT_V(8); PG8_WAIT_L(0); PG8_BAR; PG8_MMA(0, 0, At, B0); PG8_MMA(0, 1, At, B1); PG8_BAR; PG8_SCHED;
            PG8_LDA(At, 1, 1); PG8_STAGE(PG8_SB(1, 0), b3, voffB); PG8_STAGE(PG8_SB(1, 1), b3 + hstep, voffB); PG8_STAGE(PG8_SA(1, 0), a3, voffA);
            PG8_WAIT_V(8); PG8_WAIT_L(0); PG8_BAR; PG8_MMA(1, 0, At, B0); PG8_MMA(1, 1, At, B1); PG8_BAR; PG8_SCHED;
            } else {
            PG8_LDB(B0, 0, 0); PG8_SCHED; PG8_LDA(At, 0, 0); PG8_STAGE(PG8_SA(1, 1), a1 + hstep, voffA);
            PG8_WAIT_L(8); PG8_BAR; PG8_WAIT_L(0); PG8_MMA(0, 0, At, B0); PG8_BAR; PG8_SCHED;
            PG8_LDB(B1, 0, 1); PG8_STAGE(PG8_SB(0, 0), b2, voffB);
            PG8_BAR; PG8_WAIT_L(0); PG8_MMA(0, 1, At, B1); PG8_BAR;
            PG8_LDA(At, 0, 1); PG8_STAGE(PG8_SA(0, 0), a2, voffA);
            PG8_BAR; PG8_WAIT_L(0); PG8_MMA(1, 0, At, B0); PG8_BAR; PG8_SCHED;
            PG8_STAGE(PG8_SB(0, 1), b2 + hstep, voffB);
            PG8_WAIT_V(6); PG8_BAR; PG8_MMA(1, 1, At, B1); PG8_BAR;
            PG8_LDB(B0, 1, 0); PG8_SCHED; PG8_LDA(At, 1, 0); PG8_STAGE(PG8_SA(0, 1), a2 + hstep, voffA);
            PG8_WAIT_L(8); PG8_BAR; PG8_WAIT_L(0); PG8_MMA(0, 0, At, B0); PG8_BAR; PG8_SCHED;
            PG8_LDB(B1, 1, 1); PG8_STAGE(PG8_SB(1, 0), b3, voffB);
            PG8_BAR; PG8_WAIT_L(0); PG8_MMA(0, 1, At, B1); PG8_BAR;
            PG8_LDA(At, 1, 1); PG8_STAGE(PG8_SA(1, 0), a3, voffA);
            PG8_BAR; PG8_WAIT_L(0); PG8_MMA(1, 0, At, B0); PG8_BAR; PG8_SCHED;
            PG8_STAGE(PG8_SB(1, 1), b3 + hstep, voffB);
            PG8_WAIT_V(6); PG8_BAR; PG8_MMA(1, 1, At, B1); PG8_BAR;
            }
        }
        if constexpr (ALIGN_EPI) { if (wr == 0) PG8_BAR; }
        if constexpr (!Epi::AFTER_DRAIN) { E(acc, cur, wr, wc, fr, fq); S.done(cur); }
        if (!has_next) break;
#pragma unroll
        for (int a = 0; a < 2; ++a)
#pragma unroll
            for (int b = 0; b < 2; ++b)
#pragma unroll
                for (int m = 0; m < 4; ++m)
#pragma unroll
                    for (int n = 0; n < 2; ++n) acc[a][b][m][n] = (f32x4){0.f, 0.f, 0.f, 0.f};
        cur = nxt; cA = nA; cB = nB; ++ui;
        if constexpr (ALIGN_EPI) { if (wr == 1) PG8_BAR; }
    }
    PG8_WAIT_V(0);
    if constexpr (!ALIGN_EPI) { if (wr == 0) PG8_BAR; }
    PG8_BAR;
    if constexpr (Epi::AFTER_DRAIN) { E.fused(acc, cur, wr, wc, fr, fq, lds, wid, lane); S.done(cur); }
#undef PG8_SA
#undef PG8_SB
#undef PG8_STAGE
#undef PG8_LDA
#undef PG8_LDB
#undef PG8_MMA
#undef PG8_WAIT_V
#undef PG8_WAIT_L
#undef PG8_BAR
#undef PG8_SCHED
}
}
#define LAS __attribute__((address_space(3)))
#define XB_TMO      128
#define XB_XCNT(j)  (256  + 64 * (j))
#define XB_XSUB(j)  (1280 + 64 * (j))
#define XB_XGEN(j)  (2304 + 64 * (j))
#define XB_TOP      3328
#define XB_TOPGEN   3392
#define XCD_BAR_WORDS 3456
#define XB_SPIN_CAP (1u << 18)

__device__ __forceinline__ unsigned xb_ld(unsigned* p)              { return __hip_atomic_load(p, __ATOMIC_RELAXED, __HIP_MEMORY_SCOPE_AGENT); }
__device__ __forceinline__ unsigned xb_add(unsigned* p, unsigned v) { return __hip_atomic_fetch_add(p, v, __ATOMIC_RELAXED, __HIP_MEMORY_SCOPE_AGENT); }
__device__ __forceinline__ unsigned xb_xcc_id() { return (unsigned)__builtin_amdgcn_s_getreg((3 << 11) | 20) & 0xFu; }
#define XB_SPIN(cond, bar) do { unsigned _sp = 0; while (cond) { __builtin_amdgcn_s_sleep(1); \
    if ((++_sp & 255u) == 0u) { if (xb_ld(&(bar)[XB_TMO])) break; if (_sp > XB_SPIN_CAP) { atomicAdd(&(bar)[XB_TMO], 1u); break; } } } } while (0)

struct XcdBarrier {
    unsigned* bar; unsigned x;
    volatile LAS unsigned* st;
};

__device__ __forceinline__ XcdBarrier xcd_barrier_post(unsigned* bar, volatile LAS unsigned* st) {
    XcdBarrier b; b.bar = bar; b.x = xb_xcc_id(); b.st = st;
    if (threadIdx.x == 0) (void)xb_add(&bar[XB_XCNT(b.x)], 1u);
    return b;
}
__device__ __forceinline__ void xcd_barrier_complete(unsigned* bar, unsigned x, unsigned& nloc, unsigned& nx) {
    const unsigned G = gridDim.x * gridDim.y * gridDim.z;
    unsigned sum, cnt, mine, sp = 0u;
    for (;;) {
        sum = 0u; cnt = 0u; mine = 0u;
#pragma unroll
        for (unsigned j = 0; j < 16; ++j) { const unsigned c = xb_ld(&bar[XB_XCNT(j)]); sum += c; cnt += (c > 0u) ? 1u : 0u; mine = (j == x) ? c : mine; }
        if (sum == G) break;
        __builtin_amdgcn_s_sleep(1);
        if ((++sp & 255u) == 0u) { if (xb_ld(&bar[XB_TMO])) break; if (sp > XB_SPIN_CAP) { atomicAdd(&bar[XB_TMO], 1u); break; } }
    }
    nloc = mine > 0u ? mine : 1u; nx = cnt > 0u ? cnt : 1u;
}

__device__ __forceinline__ void xcd_barrier(const XcdBarrier& b) {
    asm volatile("s_waitcnt vmcnt(0)" ::: "memory");
    __syncthreads();
    if (threadIdx.x == 0) {
        unsigned* bar = b.bar;
        __builtin_amdgcn_s_waitcnt(0);
        unsigned nloc = b.st[0], nx = b.st[1];
        if (nloc == 0u) { xcd_barrier_complete(bar, b.x, nloc, nx); b.st[0] = nloc; b.st[1] = nx; }
        const unsigned old = xb_add(&bar[XB_XSUB(b.x)], 1u);
        const unsigned gen = old / nloc;
        if (old + 1u == (gen + 1u) * nloc) {
            __builtin_amdgcn_fence(__ATOMIC_RELEASE, "agent");
            asm volatile("s_waitcnt vmcnt(0)" ::: "memory");
            const unsigned og = xb_add(&bar[XB_TOP], 1u);
            const unsigned tg = og / nx;
            if (og + 1u == (tg + 1u) * nx) xb_add(&bar[XB_TOPGEN], 1u);
            else XB_SPIN(xb_ld(&bar[XB_TOPGEN]) == tg, bar);
            __builtin_amdgcn_fence(__ATOMIC_ACQUIRE, "agent");
            xb_add(&bar[XB_XGEN(b.x)], 1u);
            asm volatile("s_waitcnt vmcnt(0)" ::: "memory");
        } else {
            XB_SPIN(xb_ld(&bar[XB_XGEN(b.x)]) == gen, bar);
            __builtin_amdgcn_fence(__ATOMIC_ACQUIRE, "agent");
            asm volatile("s_waitcnt vmcnt(0)" ::: "memory");
        }
    }
    __syncthreads();
}

using pg8::bf16_t; using pg8::bf16x8; using pg8::f32x4; using pg8::u32x4;
using pg8::DM; using pg8::MP; using pg8::MS; using pg8::MT; using pg8::NIN; using pg8::DFF; using pg8::LDP; using pg8::SEQ; using pg8::DSEQ;
using pg8::NBATCH; using pg8::DBATCH; using pg8::DEPTH;
#define LAS __attribute__((address_space(3)))
typedef unsigned u32x2 __attribute__((ext_vector_type(2)));
typedef float f32x2 __attribute__((ext_vector_type(2)));

constexpr int NTHR = 512;
constexpr int LDS_BYTES = 147456;
constexpr size_t O_YP = 0, O_YS = (size_t)MP * DM, O_RETP = O_YS + (size_t)MS * DM, O_CONVP = O_RETP + (size_t)DEPTH * NBATCH * 4 * 16384,
                 O_RETS = O_CONVP + (size_t)DEPTH * NBATCH * 2 * 512, O_CONVS = O_RETS + (size_t)DEPTH * DBATCH * 4 * 16384;
constexpr size_t MiB = 1u << 20;
constexpr size_t WS_WIN = 0, WS_WOUT = 14 * MiB, WS_WUP = 18 * MiB, WS_WDN = 34 * MiB;
constexpr size_t WS_COS = 50 * MiB, WS_SIN = 51 * MiB, WS_SSP = 52 * MiB, WS_SSEG = 55 * MiB;
constexpr size_t WS_CTL = 54 * MiB + 512 * 1024;
constexpr int CTL_WORDS = 8192, CW_CNT = 4096;
constexpr size_t WS_PART = 400 * MiB;
constexpr size_t WS_XB = 71 * MiB;
constexpr size_t WS_PROJ = 136 * MiB;
constexpr size_t WS_MIX = WS_PROJ + (size_t)MT * LDP * 2;
constexpr size_t WS_H = WS_PROJ;
constexpr size_t WS_END = WS_MIX + (size_t)MT * DM * 2;
static_assert(WS_END <= WS_PART && WS_PART + 64 * MiB <= 512 * MiB && WS_XB + (size_t)MT * DM * 2 <= WS_PROJ && WS_END <= 512 * MiB && WS_H + (size_t)MT * DFF * 2 <= WS_END, "ws map");

__device__ __forceinline__ float bf2f(unsigned b) { return __uint_as_float(b << 16); }
__device__ __forceinline__ unsigned pk2(float lo, float hi) { return pg8::cvt_pk_bf16(lo, hi); }
__device__ __forceinline__ float ex2(float x) { return __builtin_amdgcn_exp2f(x); }
__device__ __forceinline__ f32x4 mma(const bf16x8 x, const bf16x8 y, const f32x4 c) { return __builtin_amdgcn_mfma_f32_16x16x32_bf16(x, y, c, 0, 0, 0); }
__device__ __forceinline__ bf16x8 frag(LAS unsigned char* base, int row, int stride, int kg, int kb) { return *(const LAS bf16x8*)(base + row * stride + 16 * kg + 64 * kb); }

constexpr int R_Q = 0, R_K = 17408, R_KT = 34816, R_VT = 53248, R_SP = 71680, R_RT = 80896, R_ST = 115712;
constexpr int SQ = 272, ST = 144;
#define LDS_BAR() do { asm volatile("s_waitcnt lgkmcnt(0)" ::: "memory"); __builtin_amdgcn_s_barrier(); asm volatile("" ::: "memory"); } while (0)
__device__ __forceinline__ void ret_item(LAS unsigned char* lds, const bf16_t* proj, bf16_t* mix, int row0, int nchunks, int CL, int h, float lg2, bool full,
                                         int rinit, const float* rsrc, int nprefix, float* rdst, const float* gnw) {
    int tid_o = threadIdx.x; asm volatile("" : "+v"(tid_o));
    const int tid = tid_o, w = __builtin_amdgcn_readfirstlane(tid >> 6), lane = tid & 63, j = lane & 15, ig = lane >> 4;
    f32x4 R[8];
#pragma unroll
    for (int dt = 0; dt < 8; ++dt) R[dt] = (f32x4){0.f, 0.f, 0.f, 0.f};
    if (rinit == 2) {
#pragma unroll
        for (int dt = 0; dt < 8; ++dt)
#pragma unroll
            for (int t = 0; t < 4; ++t) R[dt][t] = rsrc[(16 * dt + 4 * ig + t) * 128 + 16 * w + j];
    } else if (rinit == 1) {
#pragma unroll 1
        for (int s0 = 0; s0 < nprefix; s0 += 4) {
            f32x4 tv[4][8];
#pragma unroll
            for (int k = 0; k < 4; ++k) {
                const int s = s0 + k < nprefix ? s0 + k : nprefix - 1;
                const float* rp = rsrc + (size_t)s * 16384 + 16 * w + j;
#pragma unroll
                for (int dt = 0; dt < 8; ++dt)
#pragma unroll
                    for (int t = 0; t < 4; ++t) tv[k][dt][t] = rp[(16 * dt + 4 * ig + t) * 128];
            }
#pragma unroll
            for (int k = 0; k < 4; ++k) {
                const float sc = s0 + k < nprefix ? ex2(lg2 * 512.f * (float)(nprefix - 1 - s0 - k)) : 0.f;
#pragma unroll
                for (int dt = 0; dt < 8; ++dt) R[dt] += tv[k][dt] * sc;
            }
        }
    }
    if (full) {
#pragma unroll
        for (int dt = 0; dt < 8; ++dt) { u32x2 p; p.x = pk2(R[dt][0], R[dt][1]); p.y = pk2(R[dt][2], R[dt][3]); *(LAS u32x2*)(lds + R_RT + (16 * w + j) * SQ + (16 * dt + 4 * ig) * 2) = p; }
    }
    const float cdec = ex2(lg2 * (float)CL);
    const float kdec = ex2(lg2 * (float)(CL - 1 - lane));
    u32x4 qreg[2], kreg[2], vreg[2];
    const u32x4 zero4 = (u32x4){0u, 0u, 0u, 0u};
#define RET_LOAD(c) do { _Pragma("unroll") for (int it = 0; it < 2; ++it) { \
        const int qm = (tid + NTHR * it) >> 4, qd = (tid + NTHR * it) & 15, kd = w + 8 * it; \
        const bf16_t* rb = proj + (size_t)(row0 + (c) * 64) * LDP + h * 128; \
        qreg[it] = (full && qm < CL) ? *(const u32x4*)(rb + (size_t)qm * LDP + 8 * qd) : zero4; \
        kreg[it] = (lane < CL) ? *(const u32x4*)(rb + (size_t)lane * LDP + 512 + 8 * kd) : zero4; \
        vreg[it] = (lane < CL) ? *(const u32x4*)(rb + (size_t)lane * LDP + 1024 + 8 * kd) : zero4; } } while (0)
    RET_LOAD(0);
    for (int c = 0; c < nchunks; ++c) {
#pragma unroll
        for (int it = 0; it < 2; ++it) {
            const int qm = (tid + NTHR * it) >> 4, qd = (tid + NTHR * it) & 15, kd = w + 8 * it;
            if (full) { *(LAS u32x4*)(lds + R_Q + qm * SQ + 16 * qd) = qreg[it]; *(LAS u32x4*)(lds + R_K + lane * SQ + 16 * kd) = kreg[it]; }
#pragma unroll
            for (int e = 0; e < 4; ++e) {
                const unsigned kw = kreg[it][e], vw = vreg[it][e];
                const unsigned kp = pk2(bf2f(kw & 0xffffu) * kdec, bf2f(kw >> 16) * kdec);
                *(LAS unsigned short*)(lds + R_KT + (8 * kd + 2 * e) * ST + 2 * lane) = (unsigned short)(kp & 0xffffu);
                *(LAS unsigned short*)(lds + R_KT + (8 * kd + 2 * e + 1) * ST + 2 * lane) = (unsigned short)(kp >> 16);
                *(LAS unsigned short*)(lds + R_VT + (8 * kd + 2 * e) * ST + 2 * lane) = (unsigned short)(vw & 0xffffu);
                *(LAS unsigned short*)(lds + R_VT + (8 * kd + 2 * e + 1) * ST + 2 * lane) = (unsigned short)(vw >> 16);
            }
        }
        if (c + 1 < nchunks) RET_LOAD(c + 1);
        u32x2 sgr[4];
        if (full) {
#pragma unroll
            for (int nt = 0; nt < 4; ++nt) {
                const int n = 16 * nt + j;
                sgr[nt] = n < CL ? *(const u32x2*)(proj + (size_t)(row0 + c * 64 + n) * LDP + 1536 + h * 128 + 16 * w + 4 * ig) : (u32x2){0u, 0u};
            }
        }
        LDS_BAR();
        f32x4 o[4];
        if (full) {
            const int mt = w & 3;
#pragma unroll
            for (int q2 = 0; q2 < 2; ++q2) {
                const int nt = 2 * (w >> 2) + q2;
                f32x4 s = (f32x4){0.f, 0.f, 0.f, 0.f};
#pragma unroll
                for (int kb = 0; kb < 4; ++kb) s = mma(frag(lds + R_K, 16 * mt + j, SQ, ig, kb), frag(lds + R_Q, 16 * nt + j, SQ, ig, kb), s);
                const int n = 16 * nt + j, m0 = 16 * mt + 4 * ig;
#pragma unroll
                for (int t = 0; t < 4; ++t) { const int df = n - (m0 + t); s[t] = df >= 0 ? s[t] * ex2(lg2 * (float)df) : 0.f; }
                u32x2 p; p.x = pk2(s[0], s[1]); p.y = pk2(s[2], s[3]);
                *(LAS u32x2*)(lds + R_SP + n * ST + m0 * 2) = p;
            }
            LDS_BAR();
            bf16x8 rt[4], vt[2], qf[4][4], sf[4][2];
#pragma unroll
            for (int kb = 0; kb < 4; ++kb) rt[kb] = frag(lds + R_RT, 16 * w + j, SQ, ig, kb);
#pragma unroll
            for (int kb = 0; kb < 2; ++kb) vt[kb] = frag(lds + R_VT, 16 * w + j, ST, ig, kb);
#pragma unroll
            for (int nt = 0; nt < 4; ++nt) {
#pragma unroll
                for (int kb = 0; kb < 4; ++kb) qf[nt][kb] = frag(lds + R_Q, 16 * nt + j, SQ, ig, kb);
#pragma unroll
                for (int kb = 0; kb < 2; ++kb) sf[nt][kb] = frag(lds + R_SP, 16 * nt + j, ST, ig, kb);
            }
            f32x4 a[4], b[4];
#pragma unroll
            for (int nt = 0; nt < 4; ++nt) { a[nt] = (f32x4){0.f, 0.f, 0.f, 0.f}; b[nt] = (f32x4){0.f, 0.f, 0.f, 0.f}; }
#pragma unroll
            for (int kb = 0; kb < 4; ++kb)
#pragma unroll
                for (int nt = 0; nt < 4; ++nt) a[nt] = mma(rt[kb], qf[nt][kb], a[nt]);
#pragma unroll
            for (int kb = 0; kb < 2; ++kb)
#pragma unroll
                for (int nt = 0; nt < 4; ++nt) b[nt] = mma(vt[kb], sf[nt][kb], b[nt]);
#pragma unroll
            for (int nt = 0; nt < 4; ++nt) {
                const float qd = ex2(lg2 * (float)(16 * nt + j + 1));
                o[nt] = b[nt] + a[nt] * qd;
                float s1 = (o[nt][0] + o[nt][1]) + (o[nt][2] + o[nt][3]);
                float s2 = (o[nt][0] * o[nt][0] + o[nt][1] * o[nt][1]) + (o[nt][2] * o[nt][2] + o[nt][3] * o[nt][3]);
                s1 += __shfl_xor(s1, 16); s1 += __shfl_xor(s1, 32); s2 += __shfl_xor(s2, 16); s2 += __shfl_xor(s2, 32);
                if (ig == 0) *(LAS f32x2*)(lds + R_ST + ((16 * nt + j) * 8 + w) * 8) = (f32x2){s1, s2};
            }
        }
        {
            bf16x8 vt[2], kt[8][2];
#pragma unroll
            for (int kb = 0; kb < 2; ++kb) vt[kb] = frag(lds + R_VT, 16 * w + j, ST, ig, kb);
#pragma unroll
            for (int dt = 0; dt < 8; ++dt)
#pragma unroll
                for (int kb = 0; kb < 2; ++kb) kt[dt][kb] = frag(lds + R_KT, 16 * dt + j, ST, ig, kb);
#pragma unroll
            for (int dt = 0; dt < 8; ++dt) R[dt] = R[dt] * cdec;
#pragma unroll
            for (int kb = 0; kb < 2; ++kb)
#pragma unroll
                for (int dt = 0; dt < 8; ++dt) R[dt] = mma(kt[dt][kb], vt[kb], R[dt]);
        }
        if (full && c + 1 < nchunks) {
#pragma unroll
            for (int dt = 0; dt < 8; ++dt) { u32x2 p; p.x = pk2(R[dt][0], R[dt][1]); p.y = pk2(R[dt][2], R[dt][3]); *(LAS u32x2*)(lds + R_RT + (16 * w + j) * SQ + (16 * dt + 4 * ig) * 2) = p; }
        }
        LDS_BAR();
        if (full) {
            const f32x4 gw = *(const f32x4*)(gnw + h * 128 + 16 * w + 4 * ig);
#pragma unroll
            for (int nt = 0; nt < 4; ++nt) {
                const int n = 16 * nt + j;
                if (n < CL) {
                    const LAS f32x4* sp = (const LAS f32x4*)(lds + R_ST + n * 64);
                    const f32x4 p0 = sp[0], p1 = sp[1], p2 = sp[2], p3 = sp[3];
                    const float s1 = (p0[0] + p0[2]) + (p1[0] + p1[2]) + (p2[0] + p2[2]) + (p3[0] + p3[2]);
                    const float s2 = (p0[1] + p0[3]) + (p1[1] + p1[3]) + (p2[1] + p2[3]) + (p3[1] + p3[3]);
                    const float mean = s1 * (1.0f / 128.0f);
                    const float var = fmaxf(s2 * (1.0f / 128.0f) - mean * mean, 0.f);
                    const float rstd = __builtin_amdgcn_rsqf(var + pg8::GN_EPS);
                    const size_t row = (size_t)(row0 + c * 64 + n);
                    const u32x2 sg = sgr[nt];
                    const float g0 = bf2f(sg.x & 0xffffu), g1 = bf2f(sg.x >> 16), g2 = bf2f(sg.y & 0xffffu), g3 = bf2f(sg.y >> 16);
                    u32x2 p;
                    p.x = pk2((o[nt][0] - mean) * rstd * gw[0] * g0, (o[nt][1] - mean) * rstd * gw[1] * g1);
                    p.y = pk2((o[nt][2] - mean) * rstd * gw[2] * g2, (o[nt][3] - mean) * rstd * gw[3] * g3);
                    *(u32x2*)(mix + row * DM + h * 128 + 16 * w + 4 * ig) = p;
                }
            }
        }
    }
#undef RET_LOAD
    if (rdst) {
#pragma unroll
        for (int dt = 0; dt < 8; ++dt)
#pragma unroll
            for (int t = 0; t < 4; ++t) rdst[(16 * dt + 4 * ig + t) * 128 + 16 * w + j] = R[dt][t];
    }
    LDS_BAR();
}
__device__ __forceinline__ void seg_item(LAS unsigned char* lds, const bf16_t* proj, int row0, int h, float lg2, float* rdst) {
    int tid_o = threadIdx.x; asm volatile("" : "+v"(tid_o));
    const int tid = tid_o, w = __builtin_amdgcn_readfirstlane(tid >> 6), lane = tid & 63, j = lane & 15, ig = lane >> 4;
    const int m = tid & 127, d0 = tid >> 7;
    constexpr int S_KT = 0, S_VT = 128 * SQ;
    f32x4 R[8];
#pragma unroll
    for (int dt = 0; dt < 8; ++dt) R[dt] = (f32x4){0.f, 0.f, 0.f, 0.f};
    const float cdec = ex2(lg2 * 128.f), kdec = ex2(lg2 * (float)(127 - m));
    u32x4 kreg[4], vreg[4];
#define SEG_LOAD(c) do { const bf16_t* rb = proj + (size_t)(row0 + (c) * 128 + m) * LDP + h * 128; _Pragma("unroll") for (int it = 0; it < 4; ++it) { \
        kreg[it] = *(const u32x4*)(rb + 512 + 8 * (d0 + 4 * it)); vreg[it] = *(const u32x4*)(rb + 1024 + 8 * (d0 + 4 * it)); } } while (0)
    SEG_LOAD(0);
    for (int c = 0; c < 4; ++c) {
#pragma unroll
        for (int it = 0; it < 4; ++it) {
            const int kd = d0 + 4 * it;
#pragma unroll
            for (int e = 0; e < 4; ++e) {
                const unsigned kw = kreg[it][e], vw = vreg[it][e];
                const unsigned kp = pk2(bf2f(kw & 0xffffu) * kdec, bf2f(kw >> 16) * kdec);
                *(LAS unsigned short*)(lds + S_KT + (8 * kd + 2 * e) * SQ + 2 * m) = (unsigned short)(kp & 0xffffu);
                *(LAS unsigned short*)(lds + S_KT + (8 * kd + 2 * e + 1) * SQ + 2 * m) = (unsigned short)(kp >> 16);
                *(LAS unsigned short*)(lds + S_VT + (8 * kd + 2 * e) * SQ + 2 * m) = (unsigned short)(vw & 0xffffu);
                *(LAS unsigned short*)(lds + S_VT + (8 * kd + 2 * e + 1) * SQ + 2 * m) = (unsigned short)(vw >> 16);
            }
        }
        if (c + 1 < 4) SEG_LOAD(c + 1);
        LDS_BAR();
        bf16x8 vt[4];
#pragma unroll
        for (int kb = 0; kb < 4; ++kb) vt[kb] = frag(lds + S_VT, 16 * w + j, SQ, ig, kb);
#pragma unroll
        for (int dt = 0; dt < 8; ++dt) {
            R[dt] = R[dt] * cdec;
#pragma unroll
            for (int kb = 0; kb < 4; ++kb) R[dt] = mma(frag(lds + S_KT, 16 * dt + j, SQ, ig, kb), vt[kb], R[dt]);
        }
        LDS_BAR();
    }
#undef SEG_LOAD
#pragma unroll
    for (int dt = 0; dt < 8; ++dt)
#pragma unroll
        for (int t = 0; t < 4; ++t) rdst[(16 * dt + 4 * ig + t) * 128 + 16 * w + j] = R[dt][t];
}
__device__ __forceinline__ float head_lg2(int h) { return h == 0 ? -0.04580368961312479f : h == 1 ? -0.02272007650008353f : h == 2 ? -0.011315313227834146f : -0.005646563141142063f; }

__device__ __forceinline__ void conv_phase(const bf16_t* proj, bf16_t* mix, const float* conv_w  , const float* sconv  , int bx_, int nthr) {
    int tid_o = threadIdx.x; asm volatile("" : "+v"(tid_o));
    const int gtid = bx_ * NTHR + tid_o;
    const int nitems = (MT / 16) * 64;
    for (int it = gtid; it < nitems; it += nthr) {
        const int co = it & 63, rb = it >> 6, r0 = rb * 16, c0 = co * 8;
        float w0[8], w1[8], w2[8], um2[8], um1[8];
#pragma unroll
        for (int e = 0; e < 8; ++e) { w0[e] = conv_w[(c0 + e) * 3 + 0]; w1[e] = conv_w[(c0 + e) * 3 + 1]; w2[e] = conv_w[(c0 + e) * 3 + 2]; }
        const bool seq_start = r0 < MP ? ((r0 & (SEQ - 1)) == 0) : true;
        if (seq_start) {
            if (r0 < MP) {
#pragma unroll
                for (int e = 0; e < 8; ++e) { um2[e] = 0.f; um1[e] = 0.f; }
            } else {
                const float* sb = sconv + (size_t)((r0 - MP) >> 4) * 1024 + c0;
#pragma unroll
                for (int e = 0; e < 8; ++e) { um2[e] = sb[e]; um1[e] = sb[512 + e]; }
            }
        } else {
            const u32x4 a = *(const u32x4*)(proj + (size_t)(r0 - 2) * LDP + 2560 + c0), b = *(const u32x4*)(proj + (size_t)(r0 - 1) * LDP + 2560 + c0);
#pragma unroll
            for (int e = 0; e < 4; ++e) { um2[2 * e] = bf2f(a[e] & 0xffffu); um2[2 * e + 1] = bf2f(a[e] >> 16); um1[2 * e] = bf2f(b[e] & 0xffffu); um1[2 * e + 1] = bf2f(b[e] >> 16); }
        }
#pragma unroll 4
        for (int i = 0; i < 16; ++i) {
            const size_t row = (size_t)(r0 + i);
            const u32x4 uu = *(const u32x4*)(proj + row * LDP + 2560 + c0), bb = *(const u32x4*)(proj + row * LDP + 2048 + c0);
            float res[8];
#pragma unroll
            for (int e = 0; e < 4; ++e) {
                const float u0 = bf2f(uu[e] & 0xffffu), u1 = bf2f(uu[e] >> 16), b0 = bf2f(bb[e] & 0xffffu), b1 = bf2f(bb[e] >> 16);
                res[2 * e] = b0 * (w0[2 * e] * um2[2 * e] + w1[2 * e] * um1[2 * e] + w2[2 * e] * u0);
                res[2 * e + 1] = b1 * (w0[2 * e + 1] * um2[2 * e + 1] + w1[2 * e + 1] * um1[2 * e + 1] + w2[2 * e + 1] * u1);
                um2[2 * e] = um1[2 * e]; um1[2 * e] = u0; um2[2 * e + 1] = um1[2 * e + 1]; um1[2 * e + 1] = u1;
            }
            u32x4 o; o.x = pk2(res[0], res[1]); o.y = pk2(res[2], res[3]); o.z = pk2(res[4], res[5]); o.w = pk2(res[6], res[7]);
            *(u32x4*)(mix + row * DM + 512 + c0) = o;
        }
    }
}

__device__ __forceinline__ void conv_weight(const float* W, int K, int N, bf16_t* Wt, const float* ksc, int mode, int gtid, int nthr, int p0 = 0, int p1 = 1, int np = 1) {
    const int nall = (K / 8) * N, it0 = (int)((long)nall * p0 / np), nitems = (int)((long)nall * p1 / np);
    for (int it = it0 + gtid; it < nitems; it += nthr) {
        const int ko = it / N, np = it - ko * N, k0 = ko * 8;
        int col = np; float cs = 1.f;
        if (mode == 1) {
            const int pn = np >> 8, bj = (np >> 7) & 1, t = np & 127;
            if (pn < 4) { col = (pn < 2 ? 0 : 512) + 128 * (2 * (pn & 1) + (t >> 6)) + 64 * bj + (t & 63); if (pn >= 2) cs = 0.08838834764831845f; }
            else if (pn >= 10) col = (bj ? 3072 : 2560) + 128 * (pn - 10) + t;
        }
        float v[8];
#pragma unroll
        for (int e = 0; e < 8; ++e) v[e] = W[(size_t)(k0 + e) * N + col] * (ksc ? ksc[k0 + e] : 1.f) * cs;
        u32x4 o; o.x = pk2(v[0], v[1]); o.y = pk2(v[2], v[3]); o.z = pk2(v[4], v[5]); o.w = pk2(v[6], v[7]);
        *(u32x4*)(Wt + (size_t)np * K + k0) = o;
    }
}
__device__ __forceinline__ float wave_sum(float v) {
#pragma unroll
    for (int o = 1; o < 64; o <<= 1) v += __shfl_xor(v, o);
    return v;
}

#define BG_IDS(P) int bg_t_ = threadIdx.x; asm volatile("" : "+v"(bg_t_)); const int bg_gtid = (bx - (P)) * NTHR + bg_t_, bg_n = (G - (P)) * NTHR
struct Args { const float* in[13]; float* out; unsigned char* ws; };

__global__ void __launch_bounds__(NTHR, 2) hymba_fwd(Args args) {
    extern __shared__ __attribute__((aligned(16))) unsigned char lds_raw[];
    LAS unsigned char* lds = (LAS unsigned char*)lds_raw;
    cg::grid_group grid = cg::this_grid();
    const int tid = threadIdx.x, lane = tid & 63, wave = __builtin_amdgcn_readfirstlane(tid >> 6);
    const int G = gridDim.x, bx = blockIdx.x;
    const int gtid = bx * NTHR + tid, nthr = G * NTHR, gw = bx * 8 + wave, ngw = G * 8;
    unsigned char* ws = args.ws;
    const float* x_prompt = args.in[0]; const float* x_sample = args.in[1]; const float* state_ret = args.in[2]; const float* state_conv = args.in[3];
    const float* ln1_w = args.in[4]; const float* w_in = args.in[5]; const float* conv_w = args.in[6]; const float* ret_norm_w = args.in[7];
    const float* w_out = args.in[8]; const float* ln2_w = args.in[9]; const float* w_up = args.in[10]; const float* w_dn = args.in[11]; const float* ln_f_w = args.in[12];
    float* out = args.out;
    bf16_t* WtIn = (bf16_t*)(ws + WS_WIN); bf16_t* WtOut = (bf16_t*)(ws + WS_WOUT); bf16_t* WtUp = (bf16_t*)(ws + WS_WUP); bf16_t* WtDn = (bf16_t*)(ws + WS_WDN);
    float* ssp = (float*)(ws + WS_SSP); float* sseg = (float*)(ws + WS_SSEG);
    bf16_t* xb = (bf16_t*)(ws + WS_XB); bf16_t* proj = (bf16_t*)(ws + WS_PROJ); bf16_t* mix = (bf16_t*)(ws + WS_MIX); bf16_t* Hb = (bf16_t*)(ws + WS_H);
    unsigned* ctl = (unsigned*)(ws + WS_CTL); float* part = (float*)(ws + WS_PART);
    volatile LAS unsigned* MISC = (volatile LAS unsigned*)(lds + 131072 + 512);
    if (tid < 64) MISC[tid] = 0u;
    if (bx == 0) { for (int i = tid; i < CTL_WORDS; i += NTHR) ctl[i] = 0u; }
    __syncthreads();
    int kslice = 256; asm volatile("" : "+s"(kslice));
    LAS float* rbuf = (LAS float*)(lds + 131072 + 1024);
    float* X = out;

    conv_weight(w_in, DM, NIN, WtIn, ln1_w, 1, gtid, nthr);
    for (int r = gw; r < MT; r += ngw) {
        const float* xr = r < MP ? x_prompt + (size_t)r * DM : x_sample + (size_t)(r - MP) * DM;
        float s = 0.f;
#pragma unroll
        for (int q = 0; q < 4; ++q) {
            const f32x4 v = *(const f32x4*)(xr + 256 * q + 4 * lane);
            u32x2 p; p.x = pk2(v[0], v[1]); p.y = pk2(v[2], v[3]);
            *(u32x2*)(xb + (size_t)r * DM + 256 * q + 4 * lane) = p;
            s += (v[0] * v[0] + v[1] * v[1]) + (v[2] * v[2] + v[3] * v[3]);
        }
        s = wave_sum(s);
        if (lane < 16) ssp[(size_t)r * 16 + lane] = lane == 0 ? s : 0.f;
    }
    grid.sync();
    XcdBarrier bar = xcd_barrier_post(ctl, MISC + 8);

#pragma unroll 1
    for (int l = 0; l < DEPTH; ++l) {
        {
            const bf16_t* Bw = WtIn + (size_t)l * NIN * DM;
            pg8::EpiIn E{proj, rbuf, out + O_CONVP + (size_t)l * NBATCH * 1024, out + O_CONVS + (size_t)l * DBATCH * 1024};
            { pg8::Gemm g{xb, Bw, MP, NIN, DM, DM}; pg8::StaticOrder S; S.init(MP, NIN, G, bx); pg8::rstd_prepass(rbuf, ssp, S); pg8::gemm_phase<pg8::EpiIn, pg8::StaticOrder, true, true>(lds, g, S, E); }
#pragma unroll 1
            for (int s = 0; s < DM / 256; ++s) {
                pg8::Gemm g{xb + s * 256, Bw + s * 256, MT, NIN, DM, kslice}; pg8::SliceOrder S{s * (NIN / 256), NIN / 256, bx}; pg8::rstd_prepass(rbuf, ssp, S);
                pg8::SplitEpi<pg8::EpiIn, 4> E2{E, part, ctl + CW_CNT + (l * 4 + 0) * 128, ctl + 16, s};
                pg8::gemm_phase<pg8::SplitEpi<pg8::EpiIn, 4>, pg8::SliceOrder, false, true>(lds, g, S, E2);
            }
            if (bx >= 56 && G > 56) { BG_IDS(56);
                conv_weight(w_out + (size_t)l * DM * DM, DM, DM, WtOut + (size_t)l * DM * DM, nullptr, 0, bg_gtid, bg_n);
                conv_weight(w_up + (size_t)l * DM * DFF, DM, DFF, WtUp + (size_t)l * DFF * DM, ln2_w + l * DM, 0, bg_gtid, bg_n, 0, 1, 2); }
        }
        xcd_barrier(bar);
        for (int k2 = 0; ; ++k2) {
            int it;
            if (G == 256) { if (k2 == 0) it = bx; else if (k2 == 1 && bx >= 224) it = bx + 32; else break; }
            else { it = bx + k2 * G; if (it >= 288) break; }
            if (it < 224) {
                const int b = it / 28, rem = it - b * 28, h = rem / 7, sg = rem - h * 7;
                seg_item(lds, proj, b * SEQ + sg * 512, h, head_lg2(h), sseg + (size_t)((b * 4 + h) * 8 + sg) * 16384);
            } else {
                const int si = it - 224, b = si >> 2, h = si & 3;
                ret_item(lds, proj, mix, MP + b * DSEQ, 1, DSEQ, h, head_lg2(h), true, 2, state_ret + (size_t)((l * DBATCH + b) * 4 + h) * 16384, 0,
                         out + O_RETS + (size_t)((l * DBATCH + b) * 4 + h) * 16384, ret_norm_w + l * 512);
            }
        }
        conv_phase(proj, mix, conv_w + (size_t)l * 512 * 3, state_conv + (size_t)l * DBATCH * 1024, bx, nthr);
        xcd_barrier(bar);
        for (int it = bx; it < 256; it += G) {
            const int b = it >> 5, h = (it >> 3) & 3, sg = it & 7;
            ret_item(lds, proj, mix, b * SEQ + sg * 512, 8, 64, h, head_lg2(h), true, sg > 0 ? 1 : 0, sseg + (size_t)((b * 4 + h) * 8) * 16384, sg,
                     sg == 7 ? out + O_RETP + (size_t)((l * NBATCH + b) * 4 + h) * 16384 : nullptr, ret_norm_w + l * 512);
        }
        xcd_barrier(bar);
        {
            const bf16_t* Bw = WtOut + (size_t)l * DM * DM;
            pg8::EpiRes E{l == 0 ? x_prompt : X, l == 0 ? x_sample : X + (size_t)MP * DM, X, xb, ssp};
            { pg8::Gemm g{mix, Bw, MP, DM, DM, DM}; pg8::StaticOrder S; S.init(MP, DM, G, bx); pg8::gemm_phase<pg8::EpiRes, pg8::StaticOrder, true, true>(lds, g, S, E); }
#pragma unroll 1
            for (int s = 0; s < DM / 256; ++s) {
                pg8::Gemm g{mix + s * 256, Bw + s * 256, MT, DM, DM, kslice}; pg8::SliceOrder S{s * (DM / 256), DM / 256, bx};
                pg8::SplitEpi<pg8::EpiRes, 4> E2{E, part, ctl + CW_CNT + (l * 4 + 1) * 128, ctl + 16, s};
                pg8::gemm_phase<pg8::SplitEpi<pg8::EpiRes, 4>, pg8::SliceOrder, false, true>(lds, g, S, E2);
            }
            if (bx >= 16 && G > 16) { BG_IDS(16);
                conv_weight(w_up + (size_t)l * DM * DFF, DM, DFF, WtUp + (size_t)l * DFF * DM, ln2_w + l * DM, 0, bg_gtid, bg_n, 1, 2, 2);
                conv_weight(w_dn + (size_t)l * DFF * DM, DFF, DM, WtDn + (size_t)l * DM * DFF, nullptr, 0, bg_gtid, bg_n, 0, 1, 4); }
        }
        xcd_barrier(bar);
        {
            const bf16_t* Bw = WtUp + (size_t)l * DFF * DM;
            pg8::EpiUp E{Hb, rbuf};
            { pg8::Gemm g{xb, Bw, MP, DFF, DM, DM}; pg8::StaticOrder S; S.init(MP, DFF, G, bx); pg8::rstd_prepass(rbuf, ssp, S); pg8::gemm_phase<pg8::EpiUp, pg8::StaticOrder, true, true>(lds, g, S, E); }
#pragma unroll 1
            for (int s = 0; s < DM / 256; ++s) {
                pg8::Gemm g{xb + s * 256, Bw + s * 256, MT, DFF, DM, kslice}; pg8::SliceOrder S{s * (DFF / 256), DFF / 256, bx}; pg8::rstd_prepass(rbuf, ssp, S);
                pg8::SplitEpi<pg8::EpiUp, 4> E2{E, part, ctl + CW_CNT + (l * 4 + 2) * 128, ctl + 16, s};
                pg8::gemm_phase<pg8::SplitEpi<pg8::EpiUp, 4>, pg8::SliceOrder, false, true>(lds, g, S, E2);
            }
            if (bx >= 64 && G > 64) { BG_IDS(64); conv_weight(w_dn + (size_t)l * DFF * DM, DFF, DM, WtDn + (size_t)l * DM * DFF, nullptr, 0, bg_gtid, bg_n, 1, 4, 4); }
        }
        xcd_barrier(bar);
        {
            const bf16_t* Bw = WtDn + (size_t)l * DM * DFF;
            pg8::EpiRes E{X, X + (size_t)MP * DM, X, xb, ssp};
            { pg8::Gemm g{Hb, Bw, MP, DM, DFF, DFF}; pg8::StaticOrder S; S.init(MP, DM, G, bx); pg8::gemm_phase<pg8::EpiRes, pg8::StaticOrder, true, true>(lds, g, S, E); }
#pragma unroll 1
            for (int s = 0; s < 8; ++s) {
                pg8::Gemm g{Hb + s * 512, Bw + s * 512, MT, DM, DFF, 2 * kslice}; pg8::SliceOrder S{s * (DM / 256), DM / 256, bx};
                pg8::SplitEpi<pg8::EpiRes, 8> E2{E, part, ctl + CW_CNT + (l * 4 + 3) * 128, ctl + 16, s};
                pg8::gemm_phase<pg8::SplitEpi<pg8::EpiRes, 8>, pg8::SliceOrder, false, true>(lds, g, S, E2);
            }
            if (l == 0 && bx >= 32 && G > 32) { BG_IDS(32); conv_weight(w_in + (size_t)DM * NIN, DM, NIN, WtIn + (size_t)NIN * DM, ln1_w + DM, 1, bg_gtid, bg_n); }
        }
        xcd_barrier(bar);
    }
    int tid2 = threadIdx.x; asm volatile("" : "+v"(tid2));
    const int lane2 = tid2 & 63, gw2 = bx * 8 + __builtin_amdgcn_readfirstlane(tid2 >> 6);
    for (int r = gw2; r < MT; r += ngw) {
        const float rs = pg8::row_rstd(ssp, r);
        float* xr = X + (size_t)r * DM;
#pragma unroll
        for (int q = 0; q < 4; ++q) {
            const f32x4 v = *(const f32x4*)(xr + 256 * q + 4 * lane2), wv = *(const f32x4*)(ln_f_w + 256 * q + 4 * lane2);
            *(f32x4*)(xr + 256 * q + 4 * lane2) = v * rs * wv;
        }
    }
}

extern "C" void kernel_launch(void* const* d_in, const int* in_sizes, int n_in, void* d_out, int out_size, void* d_ws, size_t ws_size, hipStream_t stream) {
    static int grid = 0;
    if (grid == 0) {
        int dev = 0, cus = 0, per_cu = 0;
        if (n_in != 13 || ws_size < WS_END) { fprintf(stderr, "kernel_launch: unexpected n_in %d / ws_size %zu (need %zu)\n", n_in, ws_size, (size_t)WS_END); grid = -1; return; }
        hipGetDevice(&dev);
        hipDeviceGetAttribute(&cus, hipDeviceAttributeMultiprocessorCount, dev);
        hipFuncSetAttribute((const void*)hymba_fwd, hipFuncAttributeMaxDynamicSharedMemorySize, LDS_BYTES);
        hipOccupancyMaxActiveBlocksPerMultiprocessor(&per_cu, (const void*)hymba_fwd, NTHR, LDS_BYTES);
        if (per_cu < 1) { fprintf(stderr, "kernel_launch: occupancy query says %d blocks/CU\n", per_cu); per_cu = 1; }
        (void)hipGetLastError();
        grid = cus;
    }
    if (grid < 0) return;
    Args a{};
    for (int i = 0; i < 13; ++i) a.in[i] = (const float*)d_in[i];
    a.out = (float*)d_out; a.ws = (unsigned char*)d_ws;
    void* kargs[] = {&a};
    hipError_t e = hipLaunchCooperativeKernel((const void*)hymba_fwd, dim3(grid), dim3(NTHR), kargs, LDS_BYTES, stream);
    if (e != hipSuccess) fprintf(stderr, "cooperative launch failed: %s (grid %d)\n", hipGetErrorString(e), grid);
}
```
